# Optimizing an MI355X kernel written in HIP

```python
import math
import jax, jax.numpy as jnp
from jax import lax
import numpy as np

D_MODEL = 2048
BATCH = 4
SEQ = 2048
DEPTH = 1

CHUNK = 64
N_META = 16
HEAD_DIM = 128
N_HEADS_FOX = 8
N_HEADS_SB = 8
D_FOX = N_HEADS_FOX * HEAD_DIM
D_SB = N_HEADS_SB * HEAD_DIM
D_MIX = D_FOX + D_SB
D_IN_PROJ = 4 * D_FOX + 3 * D_SB + N_HEADS_FOX
Q_BLOCK = 128
N_GROUPS = 8
EXPERTS_PER_GROUP = 8
N_EXPERTS = N_GROUPS * EXPERTS_PER_GROUP
TOP_K = 2
D_EXPERT = 512
EXPERT_BLOCK = 128
EPS = 1e-6

kernel_name = "hymba_fox_stickbreak_hiermoe"


def rmsnorm(x, g):
    xf = x.astype(jnp.float32)
    y = xf * lax.rsqrt(jnp.mean(xf * xf, axis=-1, keepdims=True) + EPS)
    return (y * g.astype(jnp.float32)).astype(x.dtype)


def _split_heads(t, n_heads):
    b, l, _ = t.shape
    return t.reshape(b, l, n_heads, HEAD_DIM).transpose(0, 2, 1, 3)


def _pad_seq(t, pad):
    widths = [(0, 0)] * t.ndim
    widths[2] = (0, pad)
    return jnp.pad(t, widths)


def parallel_mixer(u, w_in, b_f, q_gain, k_gain, fox_out_gain, sb_out_gain, w_out):
    bsz, seq_len, _ = u.shape
    proj = u @ w_in
    cuts = [D_FOX, 2 * D_FOX, 3 * D_FOX, 4 * D_FOX,
            4 * D_FOX + D_SB, 4 * D_FOX + 2 * D_SB, 4 * D_FOX + 3 * D_SB]
    q_a, k_a, v_a, g_a, q_b, k_b, v_b, f_a = jnp.split(proj, cuts, axis=-1)
    q_a = rmsnorm(_split_heads(q_a, N_HEADS_FOX), q_gain)
    k_a = rmsnorm(_split_heads(k_a, N_HEADS_FOX), k_gain)
    v_a = _split_heads(v_a, N_HEADS_FOX)
    log_f = jax.nn.log_sigmoid((f_a + b_f).astype(jnp.float32)).transpose(0, 2, 1)
    cum_f = jnp.cumsum(log_f, axis=-1)
    q_b = _split_heads(q_b, N_HEADS_SB)
    k_b = _split_heads(k_b, N_HEADS_SB)
    v_b = _split_heads(v_b, N_HEADS_SB)

    n_blocks = -(-seq_len // Q_BLOCK)
    pad = n_blocks * Q_BLOCK - seq_len
    q_a, k_a, v_a, q_b, k_b, v_b, cum_f = (
        _pad_seq(t, pad) for t in (q_a, k_a, v_a, q_b, k_b, v_b, cum_f))
    pos = jnp.arange(n_blocks * Q_BLOCK)
    scale = HEAD_DIM ** -0.5

    outs_a, outs_b = [], []
    for blk in range(n_blocks):
        q0, q1 = blk * Q_BLOCK, (blk + 1) * Q_BLOCK
        qpos, kpos = pos[q0:q1], pos[:q1]
        causal = kpos[None, :] <= qpos[:, None]
        strict = kpos[None, :] < qpos[:, None]
        s = jnp.einsum('bhqd,bhkd->bhqk', q_a[:, :, q0:q1], k_a[:, :, :q1]).astype(jnp.float32) * scale
        s = s + cum_f[:, :, q0:q1, None] - cum_f[:, :, None, :q1]
        p = jax.nn.softmax(jnp.where(causal, s, -jnp.inf), axis=-1)
        outs_a.append(jnp.einsum('bhqk,bhkd->bhqd', p.astype(v_a.dtype), v_a[:, :, :q1]))
        z = jnp.einsum('bhqd,bhkd->bhqk', q_b[:, :, q0:q1], k_b[:, :, :q1]).astype(jnp.float32) * scale
        log_keep = jnp.where(strict, jax.nn.log_sigmoid(-z), 0.0)
        later = lax.cumsum(log_keep, axis=3, reverse=True) - log_keep
        a = jnp.where(strict, jnp.exp(jax.nn.log_sigmoid(z) + later), 0.0)
        outs_b.append(jnp.einsum('bhqk,bhkd->bhqd', a.astype(v_b.dtype), v_b[:, :, :q1]))

    o_a = jnp.concatenate(outs_a, axis=2)[:, :, :seq_len].transpose(0, 2, 1, 3)
    o_b = jnp.concatenate(outs_b, axis=2)[:, :, :seq_len].transpose(0, 2, 1, 3)
    gate = jax.nn.sigmoid(g_a.reshape(bsz, seq_len, N_HEADS_FOX, HEAD_DIM))
    o_a = rmsnorm(o_a, fox_out_gain) * gate
    o_b = rmsnorm(o_b, sb_out_gain)
    mixed = jnp.concatenate([o_a.reshape(bsz, seq_len, D_FOX),
                             o_b.reshape(bsz, seq_len, D_SB)], axis=-1)
    return mixed @ w_out


def _swiglu(xb, w1, w3, w2):
    return (jax.nn.silu(xb @ w1) * (xb @ w3)) @ w2


def expert_dispatch(xf, eid, wts, w1, w3, w2):
    n_tok, d = xf.shape
    n_assign = n_tok * TOP_K
    flat_e = eid.reshape(-1)
    flat_w = wts.reshape(-1)
    order = jnp.argsort(flat_e)
    sorted_e = flat_e[order]
    sorted_tok = order // TOP_K
    sorted_w = flat_w[order]
    counts = jnp.zeros((N_EXPERTS,), jnp.int32).at[flat_e].add(1)
    padded = (counts + EXPERT_BLOCK - 1) // EXPERT_BLOCK * EXPERT_BLOCK
    padded_ends = jnp.cumsum(padded)
    padded_starts = padded_ends - padded
    starts = jnp.cumsum(counts) - counts
    dest = padded_starts[sorted_e] + (jnp.arange(n_assign) - starts[sorted_e])
    n_rows = -(-(n_assign + N_EXPERTS * (EXPERT_BLOCK - 1)) // EXPERT_BLOCK) * EXPERT_BLOCK
    n_blk = n_rows // EXPERT_BLOCK
    row_tok = jnp.full((n_rows,), n_tok, jnp.int32).at[dest].set(sorted_tok)
    xpad = jnp.concatenate([xf, jnp.zeros((1, d), xf.dtype)], axis=0)
    xbuf = xpad[row_tok].reshape(n_blk, EXPERT_BLOCK, d)
    block_e = jnp.minimum(
        jnp.searchsorted(padded_ends, jnp.arange(n_blk) * EXPERT_BLOCK, side='right'),
        N_EXPERTS - 1)
    ybuf = lax.map(lambda a: _swiglu(a[0], w1[a[1]], w3[a[1]], w2[a[1]]), (xbuf, block_e))
    ybuf = ybuf.reshape(n_rows, d)
    contrib = ybuf[dest] * sorted_w[:, None].astype(ybuf.dtype)
    return jax.ops.segment_sum(contrib, sorted_tok, num_segments=n_tok)


def hier_moe(u, w_coarse, b_coarse, w_fine, b_fine, w1, w3, w2):
    bsz, seq_len, d = u.shape
    xf = u.reshape(-1, d)
    coarse = (xf @ w_coarse).astype(jnp.float32) + b_coarse
    p_group = jax.nn.softmax(coarse, axis=-1)
    g_sel = jnp.argmax(coarse, axis=-1)
    g_gate = jnp.take_along_axis(p_group, g_sel[:, None], axis=-1)
    fine_all = ((xf @ w_fine).astype(jnp.float32) + b_fine).reshape(-1, N_GROUPS, EXPERTS_PER_GROUP)
    fine = jnp.take_along_axis(fine_all, g_sel[:, None, None], axis=1)[:, 0]
    top_val, top_idx = lax.top_k(fine, TOP_K)
    wts = g_gate * jax.nn.softmax(top_val, axis=-1)
    eid = (g_sel[:, None] * EXPERTS_PER_GROUP + top_idx).astype(jnp.int32)
    y = expert_dispatch(xf, eid, wts, w1, w3, w2)
    return y.reshape(bsz, seq_len, d)


def setup_inputs(seed: int = 0) -> dict:
    key = jax.random.key(seed)
    ks = jax.random.split(key, 20)
    nrm = jax.random.normal
    f32 = jnp.float32
    return {
        "x": nrm(ks[0], (BATCH, SEQ, D_MODEL), f32),
        "meta_tokens": nrm(ks[1], (N_META, D_MODEL), f32),
        "norm1_g": 1.0 + 0.02 * nrm(ks[2], (DEPTH, D_MODEL), f32),
        "w_in": nrm(ks[3], (DEPTH, D_MODEL, D_IN_PROJ), f32) * D_MODEL ** -0.5,
        "b_f": 0.1 * nrm(ks[4], (DEPTH, N_HEADS_FOX), f32),
        "q_gain": 1.0 + 0.02 * nrm(ks[5], (DEPTH, HEAD_DIM), f32),
        "k_gain": 1.0 + 0.02 * nrm(ks[6], (DEPTH, HEAD_DIM), f32),
        "fox_out_gain": 1.0 + 0.02 * nrm(ks[7], (DEPTH, N_HEADS_FOX, HEAD_DIM), f32),
        "sb_out_gain": 1.0 + 0.02 * nrm(ks[8], (DEPTH, N_HEADS_SB, HEAD_DIM), f32),
        "w_out": nrm(ks[9], (DEPTH, D_MIX, D_MODEL), f32) * D_MIX ** -0.5,
        "norm2_g": 1.0 + 0.02 * nrm(ks[10], (DEPTH, D_MODEL), f32),
        "w_coarse": nrm(ks[11], (DEPTH, D_MODEL, N_GROUPS), f32) * D_MODEL ** -0.5,
        "b_coarse": 0.01 * nrm(ks[12], (DEPTH, N_GROUPS), f32),
        "w_fine": nrm(ks[13], (DEPTH, D_MODEL, N_EXPERTS), f32) * D_MODEL ** -0.5,
        "b_fine": 0.01 * nrm(ks[14], (DEPTH, N_EXPERTS), f32),
        "w1": nrm(ks[15], (DEPTH, N_EXPERTS, D_MODEL, D_EXPERT), f32) * D_MODEL ** -0.5,
        "w3": nrm(ks[16], (DEPTH, N_EXPERTS, D_MODEL, D_EXPERT), f32) * D_MODEL ** -0.5,
        "w2": nrm(ks[17], (DEPTH, N_EXPERTS, D_EXPERT, D_MODEL), f32) * D_EXPERT ** -0.5,
    }


def reference(x, meta_tokens, norm1_g, w_in, b_f, q_gain, k_gain, fox_out_gain, sb_out_gain,
              w_out, norm2_g, w_coarse, b_coarse, w_fine, b_fine, w1, w3, w2):
    bsz = x.shape[0]
    meta = jnp.broadcast_to(meta_tokens.astype(x.dtype)[None], (bsz, N_META, D_MODEL))
    h = jnp.concatenate([meta, x], axis=1)
    for layer in range(DEPTH):
        h = h + parallel_mixer(rmsnorm(h, norm1_g[layer]), w_in[layer], b_f[layer],
                               q_gain[layer], k_gain[layer], fox_out_gain[layer],
                               sb_out_gain[layer], w_out[layer])
        h = h + hier_moe(rmsnorm(h, norm2_g[layer]), w_coarse[layer], b_coarse[layer],
                         w_fine[layer], b_fine[layer], w1[layer], w3[layer], w2[layer])
    return h[:, N_META:]
```

```cpp
#include <hip/hip_runtime.h>
#include <hip/hip_bf16.h>
#include <cstdio>
#include <cstdint>

#ifndef MK_N_LAUNCHES
#define MK_N_LAUNCHES 1
#endif

constexpr int DM = 2048, NB = 4, SEQ = 2048, NMETA = 16, HD = 128, NH = 8;
constexpr int TF = NB * SEQ;
constexpr int ROW_META = TF;
constexpr int NKEYROWS = TF + NMETA;
constexpr int MROWS = 8448;
constexpr int NPROJ = 7168, LDW_IN = 7176;
constexpr int NE = 64, DE = 512;
constexpr int LPOS = SEQ + NMETA;
constexpr int CUMLD = 2112;
constexpr float EPS = 1e-6f;
constexpr float LOG2E = 1.4426950408889634f;
constexpr float QSCALE2 = 0.08838834764831845f * 1.4426950408889634f;
constexpr int NPHASE = 9;

constexpr size_t MiB = 1u << 20;
constexpr size_t WS_CTL = 0, CTL_ZERO_BYTES = 1 * MiB;
constexpr size_t WS_WIN_T = 2 * MiB;
constexpr size_t WS_WOUT_T = 30 * MiB;
constexpr size_t WS_U1 = 38 * MiB;
constexpr size_t WS_PROJ = 72 * MiB;
constexpr size_t PROJ_TS = (size_t)MROWS * 1024;
constexpr size_t WS_F = 188 * MiB;
constexpr size_t WS_CUM = 189 * MiB;
constexpr size_t WS_SS = 190 * MiB;
constexpr size_t WS_RK = 194 * MiB;
constexpr size_t WS_MT = 195 * MiB;
constexpr size_t WS_MIX = 196 * MiB;
constexpr size_t WS_U2 = 228 * MiB;
constexpr size_t WS_ROUTE = 262 * MiB;
constexpr size_t WS_TOK = 263 * MiB;
constexpr int TOKLD = 16512;
constexpr size_t WS_RB = 268 * MiB;
constexpr size_t WS_W13T = 272 * MiB;
constexpr size_t WS_W2T = 528 * MiB;
constexpr size_t WS_HID = 656 * MiB;
constexpr size_t WS_Y = 690 * MiB;
constexpr size_t WS_END = 820 * MiB;
constexpr int MAXTILES = 129;
constexpr int CW_TMO = 0;
constexpr int CW_CNT = 1024;
constexpr int CW_BAR = 8192;

constexpr int RING_BYTES = 131072;
constexpr int TAB_OFF = RING_BYTES, TAB_BYTES = 16 * 1024;
constexpr int TPRE_OFF = TAB_OFF + TAB_BYTES;
constexpr int MISC_OFF = TPRE_OFF + 512;
constexpr int LDS_BYTES = MISC_OFF + 128;

#define GAS __attribute__((address_space(1)))
#define LAS __attribute__((address_space(3)))
typedef unsigned short bf16;
typedef unsigned v4u __attribute__((ext_vector_type(4)));
typedef unsigned v2u __attribute__((ext_vector_type(2)));
typedef float f32x4 __attribute__((ext_vector_type(4)));
typedef float f32x2 __attribute__((ext_vector_type(2)));
typedef float f32x16 __attribute__((ext_vector_type(16)));
typedef short bf16x8 __attribute__((ext_vector_type(8)));
typedef short s16x4 __attribute__((ext_vector_type(4)));
typedef GAS unsigned gu32;
#define RLX_AGENT __ATOMIC_RELAXED, __HIP_MEMORY_SCOPE_AGENT
#define LDS_WAIT() asm volatile("s_waitcnt lgkmcnt(0)" ::: "memory")
#define VM_WAIT() asm volatile("s_waitcnt vmcnt(0)" ::: "memory")
__device__ __forceinline__ unsigned cvtpk(float lo, float hi) { unsigned r; asm volatile("v_cvt_pk_bf16_f32 %0, %1, %2" : "=v"(r) : "v"(lo), "v"(hi)); return r; }
__device__ __forceinline__ float bf2f(unsigned short h) { return __uint_as_float(((unsigned)h) << 16); }
__device__ __forceinline__ float wave_sum(float v) {
#pragma unroll
    for (int o = 1; o < 64; o <<= 1) v += __shfl_xor(v, o);
    return v;
}
__device__ __forceinline__ float fast_exp2(float x) { return __builtin_amdgcn_exp2f(x); }
__device__ __forceinline__ float fast_log2(float x) { return __builtin_amdgcn_logf(x); }
__device__ __forceinline__ float fast_rcp(float x) { return __builtin_amdgcn_rcpf(x); }

namespace pg8 {
#define PG8_LAS __attribute__((address_space(3)))
typedef unsigned short bf16_t;
typedef unsigned u32x4 __attribute__((ext_vector_type(4)));
constexpr int BM = 256, BK = 64, HALF = 128, HTB = HALF * BK * 2, STAGE_BYTES = 8 * HTB, NXCD = 8, WGM = 8;
__host__ __device__ __forceinline__ int lds_byte(int r, int c) { const int st = (r >> 4) * 2 + (c >> 5), rr = r & 15, cc = c & 31, ob = rr * 64 + cc * 2; return st * 1024 + (ob ^ (((ob >> 9) & 1) << 5)); }
__host__ __device__ __forceinline__ void stage_rc(int b, int& R, int& C) { const int st = b / 1024, sb = b % 1024, swz = sb ^ (((sb >> 9) & 1) << 5); R = (st >> 1) * 16 + swz / 64; C = (st & 1) * 32 + (swz % 64) / 2; }
__host__ __device__ __forceinline__ int perm32(int rho) { const int n = rho >> 4, i = rho & 15; return 8 * (i >> 2) + 4 * n + (i & 3); }

struct Unit { int pm, pn, li; const char* A; const char* B; };

struct DenseOrder {
    int nM, nN, nwg, G, c; const char* A; const char* B; size_t tstep;
    __device__ void init(const void* A_, const void* B_, int M, int N, int K, int G_, int c_) { nM = M / BM; nN = N / BM; nwg = nM * nN; G = G_; c = c_; A = (const char*)A_; B = (const char*)B_; tstep = (size_t)BM * K * 2; }
    __device__ bool next(int i, Unit& u) const {
        const long L = (long)i * G + c; if (L >= nwg) return false;
        int wgid = (int)L; { const int q = nwg / NXCD, r = nwg % NXCD, xcd = wgid % NXCD, off = wgid / NXCD; wgid = (xcd < r ? xcd * (q + 1) : r * (q + 1) + (xcd - r) * q) + off; }
        const int nig = WGM * nN, gid = wgid / nig, fm = gid * WGM, gsz = (nM - fm) < WGM ? (nM - fm) : WGM;
        u.pm = fm + ((wgid % nig) % gsz); u.pn = (wgid % nig) / gsz; u.li = 0;
        u.A = A + (size_t)u.pm * tstep; u.B = B + (size_t)u.pn * tstep; return true;
    }
};

template <class Epi, class Sched, bool GATHER>
__device__ __forceinline__ void gemm_phase(PG8_LAS unsigned char* lds, const int K, const Sched& S, const Epi& E, const PG8_LAS int* tab) {
    const int tid = threadIdx.x, wid = __builtin_amdgcn_readfirstlane(tid >> 6), lane = tid & 63, wr = wid >> 2, wc = wid & 3, fr = lane & 15, fq = lane >> 4;
    const int nt = K / BK;
    unsigned voffA[2], voffB[2]; int RA[2], CA[2];
#pragma unroll
    for (int i = 0; i < 2; ++i) { int R, C; stage_rc(tid * 16 + i * 8192, R, C); const int Rb = Epi::PERM ? ((R & ~31) + perm32(R & 31)) : R;
        voffA[i] = (unsigned)(R * K + C) * 2u; voffB[i] = (unsigned)(Rb * K + C) * 2u; RA[i] = R; CA[i] = C; }
    const size_t kstep = (size_t)(BK * 2);
    const size_t hstep = (size_t)HALF * K * 2;
    const unsigned ldsw = (unsigned)wid * 1024u;
    const int aoff = lds_byte(wr * 64 + fr, fq * 8), boff = lds_byte(wc * 32 + fr, fq * 8);
    unsigned gA[2][2], gAn[2][2];
#define PG8_SA(b, h) (((b) * 2 + (h)) * HTB)
#define PG8_SB(b, h) ((4 + (b) * 2 + (h)) * HTB)
#define PG8_GL(gptr, ldsoff) __builtin_amdgcn_global_load_lds((const unsigned*)(gptr), (PG8_LAS unsigned*)(lds + (ldsoff)), 16, 0, 0)
#define PG8_STAGE_B(bufoff, gbase) do { _Pragma("unroll") for (int _i = 0; _i < 2; ++_i) PG8_GL((const char*)(gbase) + voffB[_i], (bufoff) + ldsw + _i * 8192); } while (0)
#define PG8_STAGE_A(bufoff, gbase, h, NX) do { _Pragma("unroll") for (int _i = 0; _i < 2; ++_i) { \
        if constexpr (GATHER) { const unsigned _vo = (NX) ? gAn[h][_i] : gA[h][_i]; PG8_GL((const char*)(gbase) + _vo, (bufoff) + ldsw + _i * 8192); } \
        else { PG8_GL((const char*)(gbase) + (size_t)(h) * hstep + voffA[_i], (bufoff) + ldsw + _i * 8192); } } } while (0)
#define PG8_GIDX(dst, li) do { if constexpr (GATHER) { _Pragma("unroll") for (int _h = 0; _h < 2; ++_h) _Pragma("unroll") for (int _i = 0; _i < 2; ++_i) \
        dst[_h][_i] = ((unsigned)tab[(li) * 256 + _h * 128 + RA[_i]] * (unsigned)K + (unsigned)CA[_i]) * 2u; } } while (0)
#define PG8_LDA(dst, b, h) do { _Pragma("unroll") for (int m = 0; m < 4; ++m) _Pragma("unroll") for (int k = 0; k < 2; ++k) dst[m][k] = *(const PG8_LAS bf16x8*)(lds + PG8_SA(b, h) + aoff + m * 2048 + k * 1024); } while (0)
#define PG8_LDB(dst, b, h) do { _Pragma("unroll") for (int n = 0; n < 2; ++n) _Pragma("unroll") for (int k = 0; k < 2; ++k) dst[n][k] = *(const PG8_LAS bf16x8*)(lds + PG8_SB(b, h) + boff + n * 2048 + k * 1024); } while (0)
#define PG8_MMA(ai, bj, At, Bt) do { __builtin_amdgcn_s_setprio(1); _Pragma("unroll") for (int m = 0; m < 4; ++m) _Pragma("unroll") for (int n = 0; n < 2; ++n) _Pragma("unroll") for (int k = 0; k < 2; ++k) \
        acc[ai][bj][m][n] = __builtin_amdgcn_mfma_f32_16x16x32_bf16(Bt[n][k], At[m][k], acc[ai][bj][m][n], 0, 0, 0); __builtin_amdgcn_s_setprio(0); } while (0)
#define PG8_WAIT_V(n) asm volatile("s_waitcnt vmcnt(" #n ")" ::: "memory")
#define PG8_WAIT_L(n) asm volatile("s_waitcnt lgkmcnt(" #n ")" ::: "memory")
#define PG8_BAR __builtin_amdgcn_s_barrier()
#define PG8_SCHED __builtin_amdgcn_sched_barrier(0)
    Unit cur, nxt; int ui = 0;
    if (!S.next(0, cur)) return;
    f32x4 acc[2][2][4][2];
#pragma unroll
    for (int a = 0; a < 2; ++a)
#pragma unroll
        for (int b = 0; b < 2; ++b)
#pragma unroll
            for (int m = 0; m < 4; ++m)
#pragma unroll
                for (int n = 0; n < 2; ++n) acc[a][b][m][n] = (f32x4){0.f, 0.f, 0.f, 0.f};
    bf16x8 At[4][2], B0[2][2], B1[2][2];
    const char* cA = cur.A; const char* cB = cur.B;
    PG8_GIDX(gA, cur.li);
    PG8_STAGE_B(PG8_SB(0, 0), cB); PG8_STAGE_B(PG8_SB(0, 1), cB + hstep); PG8_STAGE_A(PG8_SA(0, 0), cA, 0, false); PG8_STAGE_A(PG8_SA(0, 1), cA, 1, false);
    if (wr == 1) PG8_BAR;
    PG8_WAIT_V(2); PG8_BAR;
    PG8_STAGE_B(PG8_SB(1, 0), cB + kstep); PG8_STAGE_A(PG8_SA(1, 0), cA + kstep, 0, false); PG8_STAGE_B(PG8_SB(1, 1), cB + hstep + kstep);
    PG8_WAIT_V(6); PG8_BAR;
    for (;;) {
        const bool has_next = S.next(ui + 1, nxt);
        const char* nA = has_next ? nxt.A : cA; const char* nB = has_next ? nxt.B : cB;
        if constexpr (GATHER) { if (has_next) { PG8_GIDX(gAn, nxt.li); } else {
#pragma unroll
            for (int _h = 0; _h < 2; ++_h)
#pragma unroll
                for (int _i = 0; _i < 2; ++_i) gAn[_h][_i] = gA[_h][_i]; } }
        for (int t = 0; t < nt; t += 2) {
            const bool last = (t == nt - 2);
            const char* a1 = cA + (size_t)(t + 1) * kstep;
            const char* a2 = last ? nA : cA + (size_t)(t + 2) * kstep; const char* b2 = last ? nB : cB + (size_t)(t + 2) * kstep;
            const char* a3 = a2 + kstep; const char* b3 = b2 + kstep;
            PG8_LDB(B0, 0, 0); PG8_LDB(B1, 0, 1); PG8_SCHED; PG8_LDA(At, 0, 0); PG8_STAGE_A(PG8_SA(1, 1), a1, 1, false);
            PG8_WAIT_V(8); PG8_WAIT_L(0); PG8_BAR; PG8_MMA(0, 0, At, B0); PG8_MMA(0, 1, At, B1); PG8_BAR; PG8_SCHED;
            PG8_LDA(At, 0, 1); PG8_STAGE_B(PG8_SB(0, 0), b2); PG8_STAGE_B(PG8_SB(0, 1), b2 + hstep); PG8_STAGE_A(PG8_SA(0, 0), a2, 0, last);
            PG8_WAIT_V(8); PG8_WAIT_L(0); PG8_BAR; PG8_MMA(1, 0, At, B0); PG8_MMA(1, 1, At, B1); PG8_BAR; PG8_SCHED;
            PG8_LDB(B0, 1, 0); PG8_LDB(B1, 1, 1); PG8_SCHED; PG8_LDA(At, 1, 0); PG8_STAGE_A(PG8_SA(0, 1), a2, 1, last);
            PG8_WAIT_V(8); PG8_WAIT_L(0); PG8_BAR; PG8_MMA(0, 0, At, B0); PG8_MMA(0, 1, At, B1); PG8_BAR; PG8_SCHED;
            PG8_LDA(At, 1, 1); PG8_STAGE_B(PG8_SB(1, 0), b3); PG8_STAGE_B(PG8_SB(1, 1), b3 + hstep); PG8_STAGE_A(PG8_SA(1, 0), a3, 0, last);
            PG8_WAIT_V(8); PG8_WAIT_L(0); PG8_BAR; PG8_MMA(1, 0, At, B0); PG8_MMA(1, 1, At, B1); PG8_BAR; PG8_SCHED;
        }
        if (wr == 0) PG8_BAR;
        E(acc, cur, wr, wc, fr, fq);
        if (!has_next) break;
#pragma unroll
        for (int a = 0; a < 2; ++a)
#pragma unroll
            for (int b = 0; b < 2; ++b)
#pragma unroll
                for (int m = 0; m < 4; ++m)
#pragma unroll
                    for (int n = 0; n < 2; ++n) acc[a][b][m][n] = (f32x4){0.f, 0.f, 0.f, 0.f};
        cur = nxt; cA = nA; cB = nB; ++ui;
        if constexpr (GATHER) {
#pragma unroll
            for (int _h = 0; _h < 2; ++_h)
#pragma unroll
                for (int _i = 0; _i < 2; ++_i) gA[_h][_i] = gAn[_h][_i]; }
        if (wr == 1) PG8_BAR;
    }
    PG8_WAIT_V(0);
    PG8_BAR;
#undef PG8_SA
#undef PG8_SB
#undef PG8_GL
#undef PG8_STAGE_A
#undef PG8_STAGE_B
#undef PG8_GIDX
#undef PG8_LDA
#undef PG8_LDB
#undef PG8_MMA
#undef PG8_WAIT_V
#undef PG8_WAIT_L
#undef PG8_BAR
#undef PG8_SCHED
}

struct EpiProj {
    static constexpr bool PERM = true;
    bf16_t* P; float* SS;
    __device__ __forceinline__ void operator()(const f32x4 (&acc)[2][2][4][2], const Unit& u, int wr, int wc, int fr, int fq) const {
        const int t = u.pn >> 2, colt = (u.pn & 3) * BM;
        bf16_t* base = P + (size_t)t * PROJ_TS;
        const int row0 = u.pm * BM + wr * 64 + fr, col0 = colt + wc * 32 + 8 * fq;
        if (t <= 1) {
#pragma unroll
            for (int ai = 0; ai < 2; ++ai)
#pragma unroll
                for (int m = 0; m < 4; ++m)
#pragma unroll
                    for (int bj = 0; bj < 2; ++bj) {
                        const f32x4 a = acc[ai][bj][m][0], b = acc[ai][bj][m][1];
                        float s = (a[0] * a[0] + a[1] * a[1]) + (a[2] * a[2] + a[3] * a[3]) + (b[0] * b[0] + b[1] * b[1]) + (b[2] * b[2] + b[3] * b[3]);
                        s += __shfl_xor(s, 16); s += __shfl_xor(s, 32);
                        if (fq == 0) SS[(((size_t)t * MROWS + (row0 + ai * HALF + m * 16)) * 8 + ((u.pn & 3) * 2 + bj)) * 4 + wc] = s;
                    }
        }
#pragma unroll
        for (int ai = 0; ai < 2; ++ai)
#pragma unroll
            for (int m = 0; m < 4; ++m) { bf16_t* rowp = base + (size_t)(row0 + ai * HALF + m * 16) * 1024 + col0;
#pragma unroll
                for (int bj = 0; bj < 2; ++bj) { f32x4 v0 = acc[ai][bj][m][0], v1 = acc[ai][bj][m][1];
                    if (t == 3) {
#pragma unroll
                        for (int j = 0; j < 4; ++j) { v0[j] = fast_rcp(1.f + fast_exp2(-v0[j] * LOG2E)); v1[j] = fast_rcp(1.f + fast_exp2(-v1[j] * LOG2E)); } }
                    if (t == 4) { v0 = v0 * QSCALE2; v1 = v1 * QSCALE2; }
                    u32x4 w; w.x = cvtpk(v0[0], v0[1]); w.y = cvtpk(v0[2], v0[3]); w.z = cvtpk(v1[0], v1[1]); w.w = cvtpk(v1[2], v1[3]);
                    *(u32x4*)(rowp + bj * HALF) = w; } }
    }
};
struct EpiOut {
    static constexpr bool PERM = false;
    const float* X; float* O;
    __device__ __forceinline__ void operator()(const f32x4 (&acc)[2][2][4][2], const Unit& u, int wr, int wc, int fr, int fq) const {
        const int row0 = u.pm * BM + wr * 64 + fr, col0 = u.pn * BM + wc * 32 + 4 * fq;
#pragma unroll
        for (int ai = 0; ai < 2; ++ai)
#pragma unroll
            for (int m = 0; m < 4; ++m) { const size_t off = (size_t)(row0 + ai * HALF + m * 16) * DM + col0;
#pragma unroll
                for (int bj = 0; bj < 2; ++bj)
#pragma unroll
                    for (int n = 0; n < 2; ++n) { const f32x4 xv = *(const f32x4*)(X + off + bj * HALF + n * 16); *(f32x4*)(O + off + bj * HALF + n * 16) = xv + acc[ai][bj][m][n]; } }
    }
};
struct EpiMoe1 {
    static constexpr bool PERM = true;
    bf16_t* Hd;
    __device__ __forceinline__ void operator()(const f32x4 (&acc)[2][2][4][2], const Unit& u, int wr, int wc, int fr, int fq) const {
        const int row0 = u.pm * BM + wr * 64 + fr, col0 = u.pn * HALF + wc * 32 + 8 * fq;
#pragma unroll
        for (int ai = 0; ai < 2; ++ai)
#pragma unroll
            for (int m = 0; m < 4; ++m) { bf16_t* rowp = Hd + (size_t)(row0 + ai * HALF + m * 16) * DE + col0;
                float r[8];
#pragma unroll
                for (int n = 0; n < 2; ++n)
#pragma unroll
                    for (int j = 0; j < 4; ++j) { const float a = acc[ai][0][m][n][j], b = acc[ai][1][m][n][j]; r[n * 4 + j] = a * fast_rcp(1.f + fast_exp2(-a * LOG2E)) * b; }
                u32x4 w; w.x = cvtpk(r[0], r[1]); w.y = cvtpk(r[2], r[3]); w.z = cvtpk(r[4], r[5]); w.w = cvtpk(r[6], r[7]);
                *(u32x4*)rowp = w; }
    }
};
struct EpiMoe2 {
    static constexpr bool PERM = true;
    bf16_t* Y; const PG8_LAS float* wtab;
    __device__ __forceinline__ void operator()(const f32x4 (&acc)[2][2][4][2], const Unit& u, int wr, int wc, int fr, int fq) const {
        const int rl0 = wr * 64 + fr, col0 = u.pn * BM + wc * 32 + 8 * fq;
#pragma unroll
        for (int ai = 0; ai < 2; ++ai)
#pragma unroll
            for (int m = 0; m < 4; ++m) { const int rl = rl0 + ai * HALF + m * 16; const float w8 = wtab[u.li * 256 + rl];
                bf16_t* rowp = Y + (size_t)(u.pm * BM + rl) * DM + col0;
#pragma unroll
                for (int bj = 0; bj < 2; ++bj) { const f32x4 v0 = acc[ai][bj][m][0] * w8, v1 = acc[ai][bj][m][1] * w8;
                    u32x4 w; w.x = cvtpk(v0[0], v0[1]); w.y = cvtpk(v0[2], v0[3]); w.z = cvtpk(v1[0], v1[1]); w.w = cvtpk(v1[2], v1[3]);
                    *(u32x4*)(rowp + bj * HALF) = w; } }
    }
};
struct MoeOrder {
    int G, c, npn, total; const char* A; const char* Bb; size_t a_tstep, b_estep, b_tstep; const PG8_LAS int* tpre; bool gather;
    __device__ bool decode(int i, int& e, int& mt, int& pn) const {
        const int L = i * G + c; if (L >= total) return false;
        int lo = 0, hi = NE;
        while (hi - lo > 1) { const int mid = (lo + hi) >> 1; const int v = __builtin_amdgcn_readfirstlane(tpre[mid]); if (npn * v <= L) lo = mid; else hi = mid; }
        e = lo; const int t0 = __builtin_amdgcn_readfirstlane(tpre[e]), t1 = __builtin_amdgcn_readfirstlane(tpre[e + 1]), te = t1 - t0, r = L - npn * t0;
        pn = r / te; mt = r - pn * te; return true;
    }
    __device__ bool next(int i, Unit& u) const {
        int e, mt, pn; if (!decode(i, e, mt, pn)) return false;
        u.pm = __builtin_amdgcn_readfirstlane(tpre[e]) + mt; u.pn = pn; u.li = i;
        u.B = Bb + (size_t)e * b_estep + (size_t)pn * b_tstep; u.A = gather ? A : A + (size_t)u.pm * a_tstep; return true;
    }
};
}

namespace att {
#define KSWZ(row, colB) ((row) * 256 + ((colB) ^ (((row) & 7) << 4)))
#define SBAR() __builtin_amdgcn_sched_barrier(0)
constexpr int SHM_V = 16384, SHM_K = 16384;
constexpr int KS_OFF = 32768, WSF_OFF = 33792, WSF_FLOATS = 1152;
__device__ __forceinline__ int v_st(int k, int c) { const int kk = (k & ~0xC) | ((k & 4) << 1) | ((k & 8) >> 1); return ((kk >> 3) * 4 + (c >> 5)) * 512 + ((kk & 7) * 32 + (c & 31)) * 2; }
__device__ __forceinline__ int v_rd_base(int lane) { return ((lane & 3) << 3) | (((lane >> 2) & 3) << 6) | (((lane >> 4) & 1) << 5) | (((lane >> 5) & 1) << 8); }
constexpr int v_rd_off(int d0, int ks, int half) { return d0 * 512 + ks * 4096 + half * 2048; }
__device__ __forceinline__ int crow(int r, int hi) { return (r & 3) + 8 * (r >> 2) + 4 * hi; }

__device__ __forceinline__ void qkt(f32x16& p0, f32x16& p1, const char* K_lds, int r32, int hi, const bf16x8* qr) {
    p0 = f32x16{}; p1 = f32x16{};
    const char* kb[4];
#pragma unroll
    for (int dd = 0; dd < 4; ++dd) kb[dd] = K_lds + KSWZ(r32, (dd * 16 + hi * 8) * 2);
#pragma unroll
    for (int d0 = 0; d0 < 8; ++d0) { const char* a = kb[d0 & 3] + (d0 >> 2) * 128;
        bf16x8 b0 = *reinterpret_cast<const bf16x8*>(a);
        bf16x8 b1 = *reinterpret_cast<const bf16x8*>(a + 32 * 256);
        p0 = __builtin_amdgcn_mfma_f32_32x32x16_bf16(b0, qr[d0], p0, 0, 0, 0);
        p1 = __builtin_amdgcn_mfma_f32_32x32x16_bf16(b1, qr[d0], p1, 0, 0, 0); }
}
__device__ __forceinline__ void pv_tile(f32x16* o, int vb0, bf16x8 pa0, bf16x8 pa1, bf16x8 pa2, bf16x8 pa3) {
#define TRRD(dst, off) asm volatile("ds_read_b64_tr_b16 %0, %1 offset:%2" : "=&v"(dst) : "v"(vb0), "i"(off) : "memory")
#define PV_D0(d0) do { s16x4 l0, l1, l2, l3, h0, h1, h2, h3; constexpr int b_ = v_rd_off(d0, 0, 0); \
        TRRD(l0, b_); TRRD(h0, b_ + 2048); TRRD(l1, b_ + 4096); TRRD(h1, b_ + 6144); TRRD(l2, b_ + 8192); TRRD(h2, b_ + 10240); TRRD(l3, b_ + 12288); TRRD(h3, b_ + 14336); \
        asm volatile("s_waitcnt lgkmcnt(0)" ::: "memory"); SBAR(); \
        o[d0] = __builtin_amdgcn_mfma_f32_32x32x16_bf16(pa0, (bf16x8){l0[0], l0[1], l0[2], l0[3], h0[0], h0[1], h0[2], h0[3]}, o[d0], 0, 0, 0); \
        o[d0] = __builtin_amdgcn_mfma_f32_32x32x16_bf16(pa1, (bf16x8){l1[0], l1[1], l1[2], l1[3], h1[0], h1[1], h1[2], h1[3]}, o[d0], 0, 0, 0); \
        o[d0] = __builtin_amdgcn_mfma_f32_32x32x16_bf16(pa2, (bf16x8){l2[0], l2[1], l2[2], l2[3], h2[0], h2[1], h2[2], h2[3]}, o[d0], 0, 0, 0); \
        o[d0] = __builtin_amdgcn_mfma_f32_32x32x16_bf16(pa3, (bf16x8){l3[0], l3[1], l3[2], l3[3], h3[0], h3[1], h3[2], h3[3]}, o[d0], 0, 0, 0); } while (0)
    PV_D0(0); PV_D0(1); PV_D0(2); PV_D0(3);
#undef PV_D0
#undef TRRD
}
#define PK4(P, B_, OUT) do { unsigned a0 = cvtpk(P[B_+0], P[B_+1]), a1 = cvtpk(P[B_+2], P[B_+3]); \
        unsigned b0 = cvtpk(P[B_+4], P[B_+5]), b1 = cvtpk(P[B_+6], P[B_+7]); \
        auto r0 = __builtin_amdgcn_permlane32_swap(a0, b0, false, false); auto r1 = __builtin_amdgcn_permlane32_swap(a1, b1, false, false); \
        v4u w = {r0[0], r1[0], r0[1], r1[1]}; OUT = *reinterpret_cast<bf16x8*>(&w); } while (0)

struct Tensors {
    const bf16* QA; const bf16* KA; const bf16* VA; const bf16* GA; const bf16* QB; const bf16* KB; const bf16* VB;
    const float* RK; const float* MT; const float* CUM;
    const float* fox_gain; const float* sb_gain;
    bf16* MIX;
};

template <int TYP>
__device__ __forceinline__ void attn_unit(char* lds, const Tensors& T, const int b, const int h, const int qb) {
    const int tid = threadIdx.x, wid = __builtin_amdgcn_readfirstlane(tid >> 6), lane = tid & 63, r32 = lane & 31, hi = lane >> 5;
    char* V_lds = lds; char* K_lds = lds + SHM_V;
    float* ks_rk = (float*)(lds + KS_OFF); float* ks_nc = ks_rk + 64;
    float* wsf = (float*)(lds + WSF_OFF) + wid * WSF_FLOATS; float* part = wsf; float* li_l = wsf + 1056; float* rs_l = wsf + 1088;
    const bf16* Qp = TYP == 0 ? T.QA : T.QB; const bf16* Kp = TYP == 0 ? T.KA : T.KB; const bf16* Vp = TYP == 0 ? T.VA : T.VB;
    const int frow0 = b * SEQ + qb * 256 + wid * 32;
    const int cbase = (b * NH + h) * CUMLD;
    bf16x8 qr[8];
#pragma unroll
    for (int d0 = 0; d0 < 8; ++d0) qr[d0] = *reinterpret_cast<const bf16x8*>(Qp + (size_t)(frow0 + r32) * 1024 + h * HD + d0 * 16 + hi * 8);
    const int qp = 64 + qb * 256 + wid * 32 + r32;
    const int qpmin = 64 + qb * 256 + wid * 32, qpmax = qpmin + 31;
    float bias_t = 0.f, Rrun = 0.f, l_reg = 0.f;
    if (TYP == 0) bias_t = T.CUM[cbase + qp - 48] - T.MT[(size_t)(frow0 + r32) * 8 + h];
    f32x16 o[4] = {};
    const int sr = tid >> 4, sc = (tid & 15) * 8;
    const int vst0 = v_st(sr, sc), vst1 = v_st(32 + sr, sc), kws = KSWZ(sr, sc * 2);
    const int vb0 = (int)(uintptr_t)V_lds + v_rd_base(lane);
    bf16x8 st_k0, st_k1, st_v0, st_v1; float st_rk = 0.f, st_nc = 0.f;
#define KEYROW(j, i) ((j) == 0 ? ((i) >= 48 ? ROW_META + (i) - 48 : ROW_META) : b * SEQ + 64 * ((j) - 1) + (i))
#define TLOAD(j) do { const size_t r0_ = (size_t)KEYROW(j, sr) * 1024 + h * HD + sc, r1_ = (size_t)KEYROW(j, 32 + sr) * 1024 + h * HD + sc; \
        st_k0 = *reinterpret_cast<const bf16x8*>(Kp + r0_); st_k1 = *reinterpret_cast<const bf16x8*>(Kp + r1_); \
        st_v0 = *reinterpret_cast<const bf16x8*>(Vp + r0_); st_v1 = *reinterpret_cast<const bf16x8*>(Vp + r1_); \
        if (TYP == 0 && tid < 64) { const int kr_ = KEYROW(j, tid); const int pos_ = (j) == 0 ? (tid >= 48 ? tid - 48 : 0) : 16 + 64 * ((j) - 1) + tid; \
            st_rk = T.RK[(size_t)kr_ * 8 + h]; st_nc = -T.CUM[cbase + pos_]; } } while (0)
    int j = 4 * qb + 4;
    TLOAD(j);
    for (; j >= 0; --j) {
        __syncthreads();
        *(bf16x8*)(K_lds + kws) = st_k0; *(bf16x8*)(K_lds + kws + 32 * 256) = st_k1;
        *(bf16x8*)(V_lds + vst0) = st_v0; *(bf16x8*)(V_lds + vst1) = st_v1;
        if (TYP == 0 && tid < 64) { ks_rk[tid] = st_rk; ks_nc[tid] = st_nc; }
        __syncthreads();
        if (j > 0) TLOAD(j - 1);
        if (64 * j > qpmax) continue;
        f32x16 p0, p1;
        qkt(p0, p1, K_lds, r32, hi, qr);
        const bool need_mask = (j == 0) || (64 * j + 63 > qpmin - (TYP == 1 ? 1 : 0));
        const int kp0 = 64 * j + 4 * hi;
        bf16x8 pa0, pa1, pa2, pa3;
        if (TYP == 0) {
#pragma unroll
            for (int q = 0; q < 8; ++q) {
                const f32x4 rkv = *(const f32x4*)(ks_rk + 8 * q + 4 * hi), ncv = *(const f32x4*)(ks_nc + 8 * q + 4 * hi);
                if (q < 4) {
#pragma unroll
                    for (int i = 0; i < 4; ++i) p0[4 * q + i] = fmaf(p0[4 * q + i], rkv[i], ncv[i]) + bias_t;
                } else {
#pragma unroll
                    for (int i = 0; i < 4; ++i) p1[4 * (q - 4) + i] = fmaf(p1[4 * (q - 4) + i], rkv[i], ncv[i]) + bias_t;
                }
                asm volatile("" ::: "memory");
            }
            if (need_mask) {
#pragma unroll
                for (int r = 0; r < 16; ++r) { const int kp = kp0 + (r & 3) + 8 * (r >> 2);
                    if (!(kp <= qp && kp >= 48)) p0[r] = -__builtin_inff();
                    if (!(kp + 32 <= qp && kp + 32 >= 48)) p1[r] = -__builtin_inff(); }
            }
            float ps = 0.f;
#pragma unroll
            for (int r = 0; r < 16; ++r) { p0[r] = fast_exp2(p0[r]); p1[r] = fast_exp2(p1[r]); ps += p0[r] + p1[r]; }
            l_reg += ps;
        } else {
            f32x16 k0, k1;
#pragma unroll
            for (int r = 0; r < 16; ++r) {
                { const float z = p0[r], sp = fmaxf(z, 0.f) + fast_log2(1.f + fast_exp2(-fabsf(z))); k0[r] = -sp; p0[r] = z - sp; }
                { const float z = p1[r], sp = fmaxf(z, 0.f) + fast_log2(1.f + fast_exp2(-fabsf(z))); k1[r] = -sp; p1[r] = z - sp; }
            }
            if (need_mask) {
#pragma unroll
                for (int r = 0; r < 16; ++r) { const int kp = kp0 + (r & 3) + 8 * (r >> 2);
                    if (!(kp < qp && kp >= 48)) { p0[r] = -__builtin_inff(); k0[r] = 0.f; }
                    if (!(kp + 32 < qp && kp + 32 >= 48)) { p1[r] = -__builtin_inff(); k1[r] = 0.f; } }
            }
            float so = 0.f, spi = 0.f;
#pragma unroll
            for (int i = 7; i >= 0; --i) {
                const float g = (i < 4) ? (k0[4 * (i & 3)] + k0[4 * (i & 3) + 1]) + (k0[4 * (i & 3) + 2] + k0[4 * (i & 3) + 3]) : (k1[4 * (i & 3)] + k1[4 * (i & 3) + 1]) + (k1[4 * (i & 3) + 2] + k1[4 * (i & 3) + 3]);
                const float spn = spi + __shfl_xor(g, 32);
                const float off = Rrun + so + (hi ? spi : spn);
                if (i < 4) { const float l3 = off, l2 = l3 + k0[4 * i + 3], l1 = l2 + k0[4 * i + 2], l0 = l1 + k0[4 * i + 1];
                    p0[4 * i + 3] = fast_exp2(p0[4 * i + 3] + l3); p0[4 * i + 2] = fast_exp2(p0[4 * i + 2] + l2); p0[4 * i + 1] = fast_exp2(p0[4 * i + 1] + l1); p0[4 * i] = fast_exp2(p0[4 * i] + l0); }
                else { const int ii = i - 4; const float l3 = off, l2 = l3 + k1[4 * ii + 3], l1 = l2 + k1[4 * ii + 2], l0 = l1 + k1[4 * ii + 1];
                    p1[4 * ii + 3] = fast_exp2(p1[4 * ii + 3] + l3); p1[4 * ii + 2] = fast_exp2(p1[4 * ii + 2] + l2); p1[4 * ii + 1] = fast_exp2(p1[4 * ii + 1] + l1); p1[4 * ii] = fast_exp2(p1[4 * ii] + l0); }
                so += g; spi = spn;
            }
            Rrun += so + spi;
        }
        PK4(p0, 0, pa0); PK4(p0, 8, pa1); PK4(p1, 0, pa2); PK4(p1, 8, pa3);
        pv_tile(o, vb0, pa0, pa1, pa2, pa3);
    }
#undef TLOAD
#undef KEYROW
    int lane_e = lane, frow_e = frow0;
    asm volatile("" : "+v"(lane_e), "+s"(frow_e));
    const int r32e = lane_e & 31, hie = lane_e >> 5;
    if (TYP == 0) {
        l_reg += __shfl_xor(l_reg, 32);
        if (hie == 0) li_l[r32e] = fast_rcp(l_reg);
        LDS_WAIT();
#pragma unroll
        for (int r = 0; r < 16; ++r) { const float il = li_l[crow(r, hie)];
#pragma unroll
            for (int d0 = 0; d0 < 4; ++d0) o[d0][r] *= il; }
    }
#pragma unroll
    for (int r = 0; r < 16; ++r) { float s = 0.f;
#pragma unroll
        for (int d0 = 0; d0 < 4; ++d0) s += o[d0][r] * o[d0][r];
        part[crow(r, hie) * 33 + r32e] = s; }
    LDS_WAIT();
    { float s = 0.f;
#pragma unroll
      for (int c = 0; c < 16; ++c) s += part[r32e * 33 + hie * 16 + c];
      s += __shfl_xor(s, 32);
      if (hie == 0) rs_l[r32e] = 1.0f / sqrtf(s * (1.f / HD) + EPS); }
    LDS_WAIT();
    const float* gain = (TYP == 0 ? T.fox_gain : T.sb_gain) + h * HD;
    float gn[4];
#pragma unroll
    for (int d0 = 0; d0 < 4; ++d0) gn[d0] = gain[d0 * 32 + r32e];
#pragma unroll
    for (int r = 0; r < 16; ++r) { const int orow = crow(r, hie); const float rs = rs_l[orow];
        bf16* orp = T.MIX + (size_t)(frow_e + orow) * DM + TYP * 1024 + h * HD;
#pragma unroll
        for (int d0 = 0; d0 < 4; ++d0) { float v = o[d0][r] * rs * gn[d0];
            if (TYP == 0) v *= bf2f(T.GA[(size_t)(frow_e + orow) * 1024 + h * HD + d0 * 32 + r32e]);
            const float vn = __shfl_xor(v, 1);
            if ((r32e & 1) == 0) *(unsigned*)(orp + d0 * 32 + r32e) = cvtpk(v, vn); } }
    LDS_WAIT();
}
#undef PK4
#undef SBAR
#undef KSWZ
}

struct Frame {
    LAS unsigned char* lds; char* ldsg;
    volatile LAS unsigned* MISC;
    gu32* ctl;
    int tid, lane, wave, vcu, G;
    unsigned char* ws;
    const float *x, *meta, *g1, *w_in, *b_f, *q_gain, *k_gain, *fox_gain, *sb_gain, *w_out, *g2, *w_coarse, *b_coarse, *w_fine, *b_fine, *w1, *w3, *w2;
    float* out;
};

__device__ __forceinline__ void transpose_item(const float* W, size_t ldw, int k0, int n0, bf16* WT, size_t Kd, size_t drow0, LAS float* scr, int lane) {
#pragma unroll 8
    for (int i = 0; i < 64; ++i) scr[i * 65 + lane] = W[(size_t)(k0 + i) * ldw + n0 + lane];
    LDS_WAIT(); asm volatile("" ::: "memory");
    const int c = lane & 7;
#pragma unroll
    for (int j = 0; j < 8; ++j) { const int n = (lane >> 3) + 8 * j; const LAS float* s = scr + (8 * c) * 65 + n;
        v4u o; o.x = cvtpk(s[0 * 65], s[1 * 65]); o.y = cvtpk(s[2 * 65], s[3 * 65]); o.z = cvtpk(s[4 * 65], s[5 * 65]); o.w = cvtpk(s[6 * 65], s[7 * 65]);
        *(GAS v4u*)(WT + (drow0 + n) * Kd + k0 + 8 * c) = o; }
    LDS_WAIT(); asm volatile("" ::: "memory");
}

__device__ __forceinline__ void p0_prologue(Frame& F) {
    const int gw = F.vcu * 8 + F.wave, NGW = F.G * 8;
    LAS float* wf = (LAS float*)F.lds;
    for (int e = F.tid; e < 8 * DM; e += 512) { const int k = e >> 3, jj = e & 7; wf[jj * DM + k] = F.w_in[(size_t)k * LDW_IN + NPROJ + jj]; }
    __syncthreads();
    bf16* U1 = (bf16*)(F.ws + WS_U1); float* Fp = (float*)(F.ws + WS_F);
    for (int m = gw; m < MROWS; m += NGW) {
        GAS v2u* o8 = (GAS v2u*)(U1 + (size_t)m * DM) + F.lane;
        if (m >= NKEYROWS) {
#pragma unroll
            for (int j = 0; j < 8; ++j) o8[64 * j] = (v2u){0u, 0u};
            continue; }
        const float* xrow = m < TF ? F.x + (size_t)m * DM : F.meta + (size_t)(m - TF) * DM;
        const GAS f32x4* xr = (const GAS f32x4*)xrow + F.lane;
        f32x4 v[8]; float s = 0.f;
#pragma unroll
        for (int j = 0; j < 8; ++j) { v[j] = xr[64 * j]; s += (v[j].x * v[j].x + v[j].y * v[j].y) + (v[j].z * v[j].z + v[j].w * v[j].w); }
        const float rstd = 1.0f / sqrtf(wave_sum(s) * (1.f / DM) + EPS);
        float fa[8] = {0.f, 0.f, 0.f, 0.f, 0.f, 0.f, 0.f, 0.f};
#pragma unroll
        for (int j = 0; j < 8; ++j) { const f32x4 g = *((const GAS f32x4*)F.g1 + F.lane + 64 * j); v[j] = v[j] * rstd * g;
            o8[64 * j] = (v2u){cvtpk(v[j].x, v[j].y), cvtpk(v[j].z, v[j].w)};
#pragma unroll
            for (int jj = 0; jj < 8; ++jj) { const f32x4 w = *(const LAS f32x4*)(wf + jj * DM + 256 * j + 4 * F.lane); fa[jj] += (v[j].x * w.x + v[j].y * w.y) + (v[j].z * w.z + v[j].w * w.w); } }
#pragma unroll
        for (int jj = 0; jj < 8; ++jj) fa[jj] = wave_sum(fa[jj]);
        if (F.lane == 0) {
#pragma unroll
            for (int jj = 0; jj < 8; ++jj) Fp[(size_t)m * 8 + jj] = fa[jj]; }
    }
    { bf16* U2 = (bf16*)(F.ws + WS_U2);
      for (int m = TF + gw; m < MROWS; m += NGW) { GAS v2u* o8 = (GAS v2u*)(U2 + (size_t)m * DM) + F.lane;
#pragma unroll
          for (int j = 0; j < 8; ++j) o8[64 * j] = (v2u){0u, 0u}; } }
    { v4u* RB = (v4u*)(F.ws + WS_RB);
      for (int it = gw * 64 + F.lane; it < 64 * 5 * 64; it += NGW * 64) { const int ln = it & 63, kc = it >> 6, ks = kc / 5, cb = kc % 5, col = 16 * cb + (ln & 15), k0 = 32 * ks + 8 * (ln >> 4);
          float w[8], lo[8]; unsigned hb[4], lb[4];
#pragma unroll
          for (int i = 0; i < 8; ++i) { w[i] = col < 8 ? F.w_coarse[(size_t)(k0 + i) * 8 + col] : (col < 72 ? F.w_fine[(size_t)(k0 + i) * 64 + col - 8] : 0.f); }
#pragma unroll
          for (int i = 0; i < 4; ++i) { hb[i] = cvtpk(w[2 * i], w[2 * i + 1]); lo[2 * i] = w[2 * i] - __uint_as_float(hb[i] << 16); lo[2 * i + 1] = w[2 * i + 1] - __uint_as_float(hb[i] & 0xffff0000u); lb[i] = cvtpk(lo[2 * i], lo[2 * i + 1]); }
          RB[(size_t)(kc * 2 + 0) * 64 + ln] = (v4u){hb[0], hb[1], hb[2], hb[3]}; RB[(size_t)(kc * 2 + 1) * 64 + ln] = (v4u){lb[0], lb[1], lb[2], lb[3]}; } }
    __syncthreads();
    LAS float* scr = (LAS float*)(F.lds + F.wave * 16640);
    bf16* WinT = (bf16*)(F.ws + WS_WIN_T); bf16* WoutT = (bf16*)(F.ws + WS_WOUT_T); bf16* W13T = (bf16*)(F.ws + WS_W13T); bf16* W2T = (bf16*)(F.ws + WS_W2T);
    constexpr int I_IN = (DM / 64) * (NPROJ / 64), I_OUT = (DM / 64) * (DM / 64), I_E13 = (DM / 64) * (DE / 64), I_E2 = (DE / 64) * (DM / 64);
    constexpr int NITEMS = I_IN + I_OUT + NE * (2 * I_E13 + I_E2);
    for (int it = gw; it < NITEMS; it += NGW) {
        int r = it;
        if (r < I_IN) { const int kb = r / (NPROJ / 64), nb = r % (NPROJ / 64); transpose_item(F.w_in, LDW_IN, kb * 64, nb * 64, WinT, DM, nb * 64, scr, F.lane); continue; } r -= I_IN;
        if (r < I_OUT) { const int kb = r / (DM / 64), nb = r % (DM / 64); transpose_item(F.w_out, DM, kb * 64, nb * 64, WoutT, DM, nb * 64, scr, F.lane); continue; } r -= I_OUT;
        const int e = r / (2 * I_E13 + I_E2); r -= e * (2 * I_E13 + I_E2);
        if (r < 2 * I_E13) { const int which = r / I_E13, rr = r % I_E13, kb = rr / (DE / 64), nb = rr % (DE / 64), n0 = nb * 64;
            const float* W = (which == 0 ? F.w1 : F.w3) + (size_t)e * DM * DE;
            transpose_item(W, DE, kb * 64, n0, W13T + (size_t)e * 1024 * DM, DM, (size_t)((n0 >> 7) * 256 + (n0 & 127) + which * 128), scr, F.lane); continue; }
        r -= 2 * I_E13;
        { const int kb = r / (DM / 64), nb = r % (DM / 64); transpose_item(F.w2 + (size_t)e * DE * DM, DM, kb * 64, nb * 64, W2T + (size_t)e * DM * DE, DE, nb * 64, scr, F.lane); }
    }
}

__device__ __forceinline__ void p2_norms(Frame& F) {
    const int gw = F.wave * F.G + (int)blockIdx.x, NGW = F.G * 8;
    const float* Fp = (const float*)(F.ws + WS_F); float* CUM = (float*)(F.ws + WS_CUM);
    const float* SS = (const float*)(F.ws + WS_SS); float* RK = (float*)(F.ws + WS_RK); float* MT = (float*)(F.ws + WS_MT);
    if (gw < NB * NH) {
        const int b = gw >> 3, h = gw & 7; const float bf = F.b_f[h]; float carry = 0.f;
        for (int c0 = 0; c0 < LPOS; c0 += 64) { const int pos = c0 + F.lane; float v = 0.f;
            if (pos < LPOS) { const int row = pos < NMETA ? ROW_META + pos : b * SEQ + pos - NMETA; const float xv = Fp[(size_t)row * 8 + h] + bf;
                v = (fminf(xv, 0.f) - log1pf(expf(-fabsf(xv)))) * LOG2E; }
#pragma unroll
            for (int o = 1; o < 64; o <<= 1) { const float t = __shfl_up(v, o); if (F.lane >= o) v += t; }
            v += carry;
            if (pos < LPOS) CUM[(size_t)gw * CUMLD + pos] = v;
            carry = __shfl(v, 63); }
    }
    for (int e = gw * 64 + F.lane; e < NKEYROWS * 8; e += NGW * 64) { const f32x4 p = *(const f32x4*)(SS + ((size_t)MROWS * 8 + e) * 4);
        RK[e] = 1.0f / sqrtf(((p.x + p.y) + (p.z + p.w)) * (1.f / HD) + EPS); }
    bf16* QA = (bf16*)(F.ws + WS_PROJ);
    const int dbase = (F.lane & 7) * 16;
    float gq[16];
#pragma unroll
    for (int i = 0; i < 16; ++i) gq[i] = F.q_gain[dbase + i] * F.k_gain[dbase + i] * QSCALE2;
    for (int m = gw; m < TF; m += NGW) { const int h = F.lane >> 3;
        const f32x4 p = *(const f32x4*)(SS + ((size_t)m * 8 + h) * 4);
        const float rstd = 1.0f / sqrtf(((p.x + p.y) + (p.z + p.w)) * (1.f / HD) + EPS);
        v4u* qp = (v4u*)(QA + (size_t)m * 1024 + F.lane * 16); v4u a = qp[0], b2 = qp[1];
        unsigned w[8] = {a.x, a.y, a.z, a.w, b2.x, b2.y, b2.z, b2.w}; float n2 = 0.f;
#pragma unroll
        for (int i = 0; i < 8; ++i) { const float lo = __uint_as_float(w[i] << 16) * rstd * gq[2 * i], hi2 = __uint_as_float(w[i] & 0xffff0000u) * rstd * gq[2 * i + 1]; n2 += lo * lo + hi2 * hi2; w[i] = cvtpk(lo, hi2); }
        qp[0] = (v4u){w[0], w[1], w[2], w[3]}; qp[1] = (v4u){w[4], w[5], w[6], w[7]};
        n2 += __shfl_xor(n2, 1); n2 += __shfl_xor(n2, 2); n2 += __shfl_xor(n2, 4);
        if ((F.lane & 7) == 0) MT[(size_t)m * 8 + h] = sqrtf(n2 * (float)HD);
    }
}

__device__ __forceinline__ void p5_router(Frame& F) {
    const int ntask = TF / 16;
    const float* H1 = F.out; bf16* U2 = (bf16*)(F.ws + WS_U2); const v4u* RB = (const v4u*)(F.ws + WS_RB);
    int* RE = (int*)(F.ws + WS_ROUTE); int* RP = RE + TF * 2; float* RW = (float*)(RP + TF * 2); int* TOK = (int*)(F.ws + WS_TOK);
    LAS float* lg = (LAS float*)(F.lds + F.wave * 5632);
    const int i = F.lane & 15, kq = F.lane >> 4;
    for (int task = F.wave * F.G + (int)blockIdx.x; task < ntask; task += F.G * 8) {
        const int row0 = task * 16; const float* hrow = H1 + (size_t)(row0 + i) * DM + 8 * kq;
        float ss = 0.f;
#pragma unroll 8
        for (int ks = 0; ks < 64; ++ks) { const f32x4 a = *(const f32x4*)(hrow + 32 * ks), b = *(const f32x4*)(hrow + 32 * ks + 4);
            ss += (a.x * a.x + a.y * a.y) + (a.z * a.z + a.w * a.w) + (b.x * b.x + b.y * b.y) + (b.z * b.z + b.w * b.w); }
        ss += __shfl_xor(ss, 16); ss += __shfl_xor(ss, 32);
        const float rstd = 1.0f / sqrtf(ss * (1.f / DM) + EPS);
        f32x4 acc[5];
#pragma unroll
        for (int cb = 0; cb < 5; ++cb) acc[cb] = (f32x4){0.f, 0.f, 0.f, 0.f};
#pragma unroll 2
        for (int ks = 0; ks < 64; ++ks) {
            const f32x4 a = *(const f32x4*)(hrow + 32 * ks), b = *(const f32x4*)(hrow + 32 * ks + 4);
            const f32x4 ga = *(const f32x4*)(F.g2 + 32 * ks + 8 * kq), gb = *(const f32x4*)(F.g2 + 32 * ks + 8 * kq + 4);
            float u[8] = {a.x * rstd * ga.x, a.y * rstd * ga.y, a.z * rstd * ga.z, a.w * rstd * ga.w, b.x * rstd * gb.x, b.y * rstd * gb.y, b.z * rstd * gb.z, b.w * rstd * gb.w};
            unsigned hb[4], lb[4];
#pragma unroll
            for (int q = 0; q < 4; ++q) { hb[q] = cvtpk(u[2 * q], u[2 * q + 1]); lb[q] = cvtpk(u[2 * q] - __uint_as_float(hb[q] << 16), u[2 * q + 1] - __uint_as_float(hb[q] & 0xffff0000u)); }
            v4u hv = {hb[0], hb[1], hb[2], hb[3]}, lv = {lb[0], lb[1], lb[2], lb[3]};
            *(v4u*)(U2 + (size_t)(row0 + i) * DM + 32 * ks + 8 * kq) = hv;
            const bf16x8 Ah = *reinterpret_cast<bf16x8*>(&hv), Al = *reinterpret_cast<bf16x8*>(&lv);
#pragma unroll
            for (int cb = 0; cb < 5; ++cb) { v4u bh = RB[(size_t)((ks * 5 + cb) * 2 + 0) * 64 + F.lane], bl = RB[(size_t)((ks * 5 + cb) * 2 + 1) * 64 + F.lane];
                const bf16x8 Bh = *reinterpret_cast<bf16x8*>(&bh), Bl = *reinterpret_cast<bf16x8*>(&bl);
                acc[cb] = __builtin_amdgcn_mfma_f32_16x16x32_bf16(Ah, Bh, acc[cb], 0, 0, 0);
                acc[cb] = __builtin_amdgcn_mfma_f32_16x16x32_bf16(Ah, Bl, acc[cb], 0, 0, 0);
                acc[cb] = __builtin_amdgcn_mfma_f32_16x16x32_bf16(Al, Bh, acc[cb], 0, 0, 0); }
        }
#pragma unroll
        for (int cb = 0; cb < 5; ++cb)
#pragma unroll
            for (int j = 0; j < 4; ++j) lg[(4 * kq + j) * 88 + 16 * cb + i] = acc[cb][j];
        LDS_WAIT(); asm volatile("" ::: "memory");
        if (F.lane < 16) { const LAS float* L = lg + F.lane * 88; const int row = row0 + F.lane;
            float cmax = L[0] + F.b_coarse[0]; int gs = 0; float cv[8]; cv[0] = cmax;
#pragma unroll
            for (int g = 1; g < 8; ++g) { cv[g] = L[g] + F.b_coarse[g]; if (cv[g] > cmax) { cmax = cv[g]; gs = g; } }
            float den = 0.f;
#pragma unroll
            for (int g = 0; g < 8; ++g) den += expf(cv[g] - cmax);
            const float ggate = 1.0f / den;
            float f1 = -__builtin_inff(), f2 = -__builtin_inff(); int i1 = 0, i2 = 0;
#pragma unroll
            for (int jx = 0; jx < 8; ++jx) { const float fv = L[8 + gs * 8 + jx] + F.b_fine[gs * 8 + jx];
                if (fv > f1) { f2 = f1; i2 = i1; f1 = fv; i1 = jx; } else if (fv > f2) { f2 = fv; i2 = jx; } }
            const float e2 = expf(f2 - f1), w1 = ggate / (1.f + e2), w2 = ggate * e2 / (1.f + e2);
            const int ea = gs * 8 + i1, eb = gs * 8 + i2;
            const int pa = (int)__hip_atomic_fetch_add(F.ctl + CW_CNT + 64 * ea, 1u, RLX_AGENT), pb = (int)__hip_atomic_fetch_add(F.ctl + CW_CNT + 64 * eb, 1u, RLX_AGENT);
            TOK[(size_t)ea * TOKLD + pa] = row * 2; TOK[(size_t)eb * TOKLD + pb] = row * 2 + 1;
            RE[row * 2] = ea; RE[row * 2 + 1] = eb; RP[row * 2] = pa; RP[row * 2 + 1] = pb; RW[row * 2] = w1; RW[row * 2 + 1] = w2; }
        LDS_WAIT(); asm volatile("" ::: "memory");
    }
}

__device__ __forceinline__ int moe_tile_prefix(Frame& F) {
    LAS int* tpre = (LAS int*)(F.lds + TPRE_OFF);
    if (F.tid < 64) { const int c = (int)__hip_atomic_load(F.ctl + CW_CNT + 64 * F.tid, RLX_AGENT); int t = (c + 255) >> 8, v = t;
#pragma unroll
        for (int o = 1; o < 64; o <<= 1) { const int y = __shfl_up(v, o); if (F.lane >= o) v += y; }
        tpre[F.tid + 1] = v; if (F.tid == 0) tpre[0] = 0; }
    __syncthreads();
    return tpre[64];
}

__device__ __forceinline__ void p8_combine(Frame& F) {
    const LAS int* tpre = (const LAS int*)(F.lds + TPRE_OFF);
    const int* RE = (const int*)(F.ws + WS_ROUTE); const int* RP = RE + TF * 2; const bf16* Y = (const bf16*)(F.ws + WS_Y);
    for (int m = F.vcu * 8 + F.wave; m < TF; m += F.G * 8) {
        const int e0 = RE[m * 2], e1 = RE[m * 2 + 1], p0 = RP[m * 2], p1 = RP[m * 2 + 1];
        const size_t s0 = (size_t)tpre[e0] * 256 + p0, s1 = (size_t)tpre[e1] * 256 + p1;
        GAS f32x4* op = (GAS f32x4*)(F.out + (size_t)m * DM) + 2 * F.lane;
        const GAS v4u* y0 = (const GAS v4u*)(Y + s0 * DM) + F.lane; const GAS v4u* y1 = (const GAS v4u*)(Y + s1 * DM) + F.lane;
#pragma unroll
        for (int j = 0; j < 4; ++j) { f32x4 a = op[128 * j], b = op[128 * j + 1]; const v4u u0 = y0[64 * j], u1 = y1[64 * j];
            a.x += __uint_as_float(u0.x << 16) + __uint_as_float(u1.x << 16); a.y += __uint_as_float(u0.x & 0xffff0000u) + __uint_as_float(u1.x & 0xffff0000u);
            a.z += __uint_as_float(u0.y << 16) + __uint_as_float(u1.y << 16); a.w += __uint_as_float(u0.y & 0xffff0000u) + __uint_as_float(u1.y & 0xffff0000u);
            b.x += __uint_as_float(u0.z << 16) + __uint_as_float(u1.z << 16); b.y += __uint_as_float(u0.z & 0xffff0000u) + __uint_as_float(u1.z & 0xffff0000u);
            b.z += __uint_as_float(u0.w << 16) + __uint_as_float(u1.w << 16); b.w += __uint_as_float(u0.w & 0xffff0000u) + __uint_as_float(u1.w & 0xffff0000u);
            op[128 * j] = a; op[128 * j + 1] = b; }
    }
}

#define XB_TMO      128
#define XB_XCNT(j)  (256  + 64 * (j))
#define XB_XSUB(j)  (1280 + 64 * (j))
#define XB_XGEN(j)  (2304 + 64 * (j))
#define XB_TOP      3328
#define XB_TOPGEN   3392
#define XCD_BAR_WORDS 3456
#define XB_SPIN_CAP (1u << 18)

__device__ __forceinline__ unsigned xb_ld(unsigned* p)              { return __hip_atomic_load(p, __ATOMIC_RELAXED, __HIP_MEMORY_SCOPE_AGENT); }
__device__ __forceinline__ unsigned xb_add(unsigned* p, unsigned v) { return __hip_atomic_fetch_add(p, v, __ATOMIC_RELAXED, __HIP_MEMORY_SCOPE_AGENT); }
__device__ __forceinline__ unsigned xb_xcc_id() { return (unsigned)__builtin_amdgcn_s_getreg((3 << 11) | 20) & 0xFu; }
#define XB_SPIN(cond, bar) do { unsigned _sp = 0; while (cond) { __builtin_amdgcn_s_sleep(1); \
    if ((++_sp & 255u) == 0u) { if (xb_ld(&(bar)[XB_TMO])) break; if (_sp > XB_SPIN_CAP) { atomicAdd(&(bar)[XB_TMO], 1u); break; } } } } while (0)

struct XcdBarrier {
    unsigned* bar; unsigned x;
    volatile LAS unsigned* st;
};

__device__ __forceinline__ XcdBarrier xcd_barrier_post(unsigned* bar, volatile LAS unsigned* st) {
    XcdBarrier b; b.bar = bar; b.x = xb_xcc_id(); b.st = st;
    if (threadIdx.x == 0) (void)xb_add(&bar[XB_XCNT(b.x)], 1u);
    return b;
}
__device__ __forceinline__ void xcd_barrier_complete(unsigned* bar, unsigned x, unsigned& nloc, unsigned& nx) {
    const unsigned G = gridDim.x * gridDim.y * gridDim.z;
    unsigned sum, cnt, mine, sp = 0u;
    for (;;) {
        sum = 0u; cnt = 0u; mine = 0u;
#pragma unroll
        for (unsigned j = 0; j < 16; ++j) { const unsigned c = xb_ld(&bar[XB_XCNT(j)]); sum += c; cnt += (c > 0u) ? 1u : 0u; mine = (j == x) ? c : mine; }
        if (sum == G) break;
        __builtin_amdgcn_s_sleep(1);
        if ((++sp & 255u) == 0u) { if (xb_ld(&bar[XB_TMO])) break; if (sp > XB_SPIN_CAP) { atomicAdd(&bar[XB_TMO], 1u); break; } }
    }
    nloc = mine > 0u ? mine : 1u; nx = cnt > 0u ? cnt : 1u;
}

__device__ __forceinline__ void xcd_barrier(const XcdBarrier& b) {
    asm volatile("s_waitcnt vmcnt(0)" ::: "memory");
    __syncthreads();
    if (threadIdx.x == 0) {
        unsigned* bar = b.bar;
        __builtin_amdgcn_s_waitcnt(0);
        unsigned nloc = b.st[0], nx = b.st[1];
        if (nloc == 0u) { xcd_barrier_complete(bar, b.x, nloc, nx); b.st[0] = nloc; b.st[1] = nx; }
        const unsigned old = xb_add(&bar[XB_XSUB(b.x)], 1u);
        const unsigned gen = old / nloc;
        if (old + 1u == (gen + 1u) * nloc) {
            __builtin_amdgcn_fence(__ATOMIC_RELEASE, "agent");
            asm volatile("s_waitcnt vmcnt(0)" ::: "memory");
            const unsigned og = xb_add(&bar[XB_TOP], 1u);
            const unsigned tg = og / nx;
            if (og + 1u == (tg + 1u) * nx) xb_add(&bar[XB_TOPGEN], 1u);
            else XB_SPIN(xb_ld(&bar[XB_TOPGEN]) == tg, bar);
            __builtin_amdgcn_fence(__ATOMIC_ACQUIRE, "agent");
            xb_add(&bar[XB_XGEN(b.x)], 1u);
            asm volatile("s_waitcnt vmcnt(0)" ::: "memory");
        } else {
            XB_SPIN(xb_ld(&bar[XB_XGEN(b.x)]) == gen, bar);
            __builtin_amdgcn_fence(__ATOMIC_ACQUIRE, "agent");
            asm volatile("s_waitcnt vmcnt(0)" ::: "memory");
        }
    }
    __syncthreads();
}

struct Args { const float* in[18]; float* out; unsigned char* ws; int ph_lo, ph_hi; };
__global__ void __launch_bounds__(512, 2) fwd(Args args) {
    extern __shared__ __attribute__((aligned(16))) unsigned char lds[];
    Frame F;
    F.lds = (LAS unsigned char*)lds; F.ldsg = (char*)lds;
    F.MISC = (volatile LAS unsigned*)(F.lds + MISC_OFF);
    F.tid = threadIdx.x; F.lane = F.tid & 63; F.wave = __builtin_amdgcn_readfirstlane(F.tid >> 6);
    F.G = gridDim.x; { const int bx = blockIdx.x; F.vcu = (F.G % 8 == 0) ? (bx % 8) * (F.G / 8) + bx / 8 : bx; }
    F.ws = args.ws; F.ctl = (gu32*)(args.ws + WS_CTL); F.out = args.out;
    F.x = args.in[0]; F.meta = args.in[1]; F.g1 = args.in[2]; F.w_in = args.in[3]; F.b_f = args.in[4]; F.q_gain = args.in[5]; F.k_gain = args.in[6];
    F.fox_gain = args.in[7]; F.sb_gain = args.in[8]; F.w_out = args.in[9]; F.g2 = args.in[10]; F.w_coarse = args.in[11]; F.b_coarse = args.in[12];
    F.w_fine = args.in[13]; F.b_fine = args.in[14]; F.w1 = args.in[15]; F.w3 = args.in[16]; F.w2 = args.in[17];
    for (int u = F.tid; u < 32; u += 512) F.MISC[u] = 0u;
    __syncthreads();
    const int lo = args.ph_lo, hi = args.ph_hi;
    XcdBarrier bar; bar.bar = (unsigned*)(F.ctl + CW_BAR); bar.x = 0; bar.st = nullptr;
    if (hi - lo > 1) bar = xcd_barrier_post((unsigned*)(F.ctl + CW_BAR), F.MISC + 8);
#define IN(k) (lo <= (k) && (k) < hi)
#define SEAM(k) do { if (IN(k) && IN((k) + 1)) xcd_barrier(bar); } while (0)
    bf16* PROJ = (bf16*)(F.ws + WS_PROJ);

    if (IN(0)) { p0_prologue(F); SEAM(0); }

    if (IN(1)) {
        pg8::DenseOrder S; S.init(F.ws + WS_U1, F.ws + WS_WIN_T, MROWS, NPROJ, DM, F.G, (int)blockIdx.x);
        pg8::EpiProj E{PROJ, (float*)(F.ws + WS_SS)};
        pg8::gemm_phase<pg8::EpiProj, pg8::DenseOrder, false>(F.lds, DM, S, E, nullptr);
        SEAM(1);
    }
    if (IN(2)) { p2_norms(F); SEAM(2); }

    if (IN(3)) {
        att::Tensors T{PROJ, PROJ + PROJ_TS, PROJ + 2 * PROJ_TS, PROJ + 3 * PROJ_TS, PROJ + 4 * PROJ_TS, PROJ + 5 * PROJ_TS, PROJ + 6 * PROJ_TS,
                       (const float*)(F.ws + WS_RK), (const float*)(F.ws + WS_MT), (const float*)(F.ws + WS_CUM), F.fox_gain, F.sb_gain, (bf16*)(F.ws + WS_MIX)};
        for (int w = F.vcu; w < 256; w += F.G) { const int bh = w >> 3, s = w & 7;
#ifndef NO_FOX
            att::attn_unit<0>(F.ldsg, T, bh >> 3, bh & 7, s);
#endif
#ifndef NO_SB
            att::attn_unit<1>(F.ldsg, T, bh >> 3, bh & 7, 7 - s);
#endif
        }
        __syncthreads();
        SEAM(3);
    }
    if (IN(4)) {
        pg8::DenseOrder S; S.init(F.ws + WS_MIX, F.ws + WS_WOUT_T, TF, DM, DM, F.G, (int)blockIdx.x);
        pg8::EpiOut E{F.x, F.out};
        pg8::gemm_phase<pg8::EpiOut, pg8::DenseOrder, false>(F.lds, DM, S, E, nullptr);
        SEAM(4);
    }
    if (IN(5)) { p5_router(F); SEAM(5); }

    if (IN(6)) {
        const int ntile = moe_tile_prefix(F);
        const LAS int* tpre = (const LAS int*)(F.lds + TPRE_OFF);
        pg8::MoeOrder S{F.G, (int)blockIdx.x, 4, ntile * 4, (const char*)(F.ws + WS_U2), (const char*)(F.ws + WS_W13T), 0, (size_t)1024 * DM * 2, (size_t)256 * DM * 2, tpre, true};
        LAS int* tab = (LAS int*)(F.lds + TAB_OFF); const int* TOK = (const int*)(F.ws + WS_TOK);
        for (int i = 0; i < 16; ++i) { int e, mt, pn; if (!S.decode(i, e, mt, pn)) break;
            const int cnt = (int)__hip_atomic_load(F.ctl + CW_CNT + 64 * e, RLX_AGENT);
            if (F.tid < 256) { const int p = mt * 256 + F.tid; tab[i * 256 + F.tid] = p < cnt ? (TOK[(size_t)e * TOKLD + p] >> 1) : TF; } }
        __syncthreads();
        pg8::EpiMoe1 E{(bf16*)(F.ws + WS_HID)};
        pg8::gemm_phase<pg8::EpiMoe1, pg8::MoeOrder, true>(F.lds, DM, S, E, tab);
        SEAM(6);
    }
    if (IN(7)) {
        const int ntile = moe_tile_prefix(F);
        const LAS int* tpre = (const LAS int*)(F.lds + TPRE_OFF);
        pg8::MoeOrder S{F.G, (int)blockIdx.x, 8, ntile * 8, (const char*)(F.ws + WS_HID), (const char*)(F.ws + WS_W2T), (size_t)256 * DE * 2, (size_t)DM * DE * 2, (size_t)256 * DE * 2, tpre, false};
        LAS float* wtab = (LAS float*)(F.lds + TAB_OFF); const int* TOK = (const int*)(F.ws + WS_TOK); const float* RW = (const float*)(F.ws + WS_ROUTE) + TF * 4;
        for (int i = 0; i < 16; ++i) { int e, mt, pn; if (!S.decode(i, e, mt, pn)) break;
            const int cnt = (int)__hip_atomic_load(F.ctl + CW_CNT + 64 * e, RLX_AGENT);
            if (F.tid < 256) { const int p = mt * 256 + F.tid; wtab[i * 256 + F.tid] = p < cnt ? RW[TOK[(size_t)e * TOKLD + p]] : 0.f; } }
        __syncthreads();
        pg8::EpiMoe2 E{(bf16*)(F.ws + WS_Y), wtab};
        pg8::gemm_phase<pg8::EpiMoe2, pg8::MoeOrder, false>(F.lds, DE, S, E, nullptr);
        SEAM(7);
    }
    if (IN(8)) { (void)moe_tile_prefix(F); p8_combine(F); }
#undef IN
#undef SEAM
}

extern "C" void kernel_launch(void* const* d_in, const int* in_sizes, int n_in, void* d_out, int out_size, void* d_ws, size_t ws_size, hipStream_t stream) {
    static int grid = 0;
    if (grid == 0) {
        if (n_in != 18 || out_size != TF * DM || ws_size < WS_END) { fprintf(stderr, "kernel_launch: unexpected shapes (n_in %d, out %d, ws %zu); nothing launched\n", n_in, out_size, ws_size); grid = -1; return; }
        int dev = 0, cus = 0, per_cu = 0;
        if (hipGetDevice(&dev) != hipSuccess || hipDeviceGetAttribute(&cus, hipDeviceAttributeMultiprocessorCount, dev) != hipSuccess) { grid = -1; return; }
        if (hipFuncSetAttribute((const void*)fwd, hipFuncAttributeMaxDynamicSharedMemorySize, LDS_BYTES) != hipSuccess) { fprintf(stderr, "kernel_launch: hipFuncSetAttribute failed\n"); grid = -1; return; }
        if (hipOccupancyMaxActiveBlocksPerMultiprocessor(&per_cu, (const void*)fwd, 512, LDS_BYTES) != hipSuccess || per_cu < 1) fprintf(stderr, "kernel_launch: occupancy query reports %d\n", per_cu);
        (void)hipGetLastError();
        grid = cus > 0 ? cus : 256;
    }
    if (grid < 0) return;
    (void)hipMemsetAsync((char*)d_ws + WS_CTL, 0, CTL_ZERO_BYTES, stream);
    Args a{};
    for (int i = 0; i < 18; ++i) a.in[i] = (const float*)d_in[i];
    a.out = (float*)d_out; a.ws = (unsigned char*)d_ws;
    constexpr int NL = MK_N_LAUNCHES;
    for (int li = 0; li < NL; ++li) {
        a.ph_lo = (NL == 1) ? 0 : li; a.ph_hi = (NL == 1) ? NPHASE : li + 1;
        hipLaunchKernelGGL(fwd, dim3(grid), dim3(512), LDS_BYTES, stream, a);
    }
}
```

```cpp
#include <hip/hip_runtime.h>
#include <hip/hip_bf16.h>
#include <cstdio>
#include <cstdint>

#ifndef REP_PHASE
#define REP_PHASE -1
#endif
#ifndef MK_N_LAUNCHES
#define MK_N_LAUNCHES 1
#endif

constexpr int DM = 2048, NB = 4, SEQ = 2048, NMETA = 16, HD = 128, NH = 8;
constexpr int TF = NB * SEQ;
constexpr int ROW_META = TF;
constexpr int NKEYROWS = TF + NMETA;
constexpr int MROWS = 8448;
constexpr int NPROJ = 7168, LDW_IN = 7176;
constexpr int NE = 64, DE = 512;
constexpr int LPOS = SEQ + NMETA;
constexpr int CUMLD = 2112;
constexpr float EPS = 1e-6f;
constexpr float LOG2E = 1.4426950408889634f;
constexpr float QSCALE2 = 0.08838834764831845f * 1.4426950408889634f;
constexpr int NPHASE = 9;

constexpr size_t MiB = 1u << 20;
constexpr size_t WS_CTL = 0, CTL_ZERO_BYTES = 1 * MiB;
constexpr size_t WS_WIN_T = 2 * MiB;
constexpr size_t WS_WOUT_T = 30 * MiB;
constexpr size_t WS_U1 = 38 * MiB;
constexpr size_t WS_PROJ = 72 * MiB;
constexpr size_t PROJ_TS = (size_t)MROWS * 1024;
constexpr size_t WS_F = 188 * MiB;
constexpr size_t WS_CUM = 189 * MiB;
constexpr size_t WS_SS = 190 * MiB;
constexpr size_t WS_RK = 194 * MiB;
constexpr size_t WS_MT = 195 * MiB;
constexpr size_t WS_MIX = 196 * MiB;
constexpr size_t WS_U2 = 228 * MiB;
constexpr size_t WS_ROUTE = 262 * MiB;
constexpr size_t WS_TOK = 263 * MiB;
constexpr int TOKLD = 16512;
constexpr size_t WS_RB = 268 * MiB;
constexpr int NASSIGN = TF * 2;
constexpr size_t WS_HID = 272 * MiB;
constexpr size_t WS_Y = 292 * MiB;
constexpr size_t WS_END = 360 * MiB;
constexpr int CW_TMO = 0;
constexpr int CW_CNT = 1024;
constexpr int CW_BAR = 8192;

constexpr int RING_BYTES = 139264;
constexpr int TAB_OFF = RING_BYTES, TAB_BYTES = 8 * 384 * 4;
constexpr int TPRE_OFF = TAB_OFF + TAB_BYTES;
constexpr int MISC_OFF = TPRE_OFF + 1024;
constexpr int LDS_BYTES = MISC_OFF + 128;

#define GAS __attribute__((address_space(1)))
#define LAS __attribute__((address_space(3)))
typedef unsigned short bf16;
typedef unsigned v4u __attribute__((ext_vector_type(4)));
typedef unsigned v2u __attribute__((ext_vector_type(2)));
typedef float f32x4 __attribute__((ext_vector_type(4)));
typedef float f32x2 __attribute__((ext_vector_type(2)));
typedef float f32x16 __attribute__((ext_vector_type(16)));
typedef short bf16x8 __attribute__((ext_vector_type(8)));
typedef short s16x4 __attribute__((ext_vector_type(4)));
typedef GAS unsigned gu32;
#define RLX_AGENT __ATOMIC_RELAXED, __HIP_MEMORY_SCOPE_AGENT
#define LDS_WAIT() asm volatile("s_waitcnt lgkmcnt(0)" ::: "memory")
#define VM_WAIT() asm volatile("s_waitcnt vmcnt(0)" ::: "memory")
__device__ __forceinline__ unsigned cvtpk(float lo, float hi) { unsigned r; asm volatile("v_cvt_pk_bf16_f32 %0, %1, %2" : "=v"(r) : "v"(lo), "v"(hi)); return r; }
__device__ __forceinline__ float bf2f(unsigned short h) { return __uint_as_float(((unsigned)h) << 16); }
__device__ __forceinline__ float wave_sum(float v) {
#pragma unroll
    for (int o = 1; o < 64; o <<= 1) v += __shfl_xor(v, o);
    return v;
}
__device__ __forceinline__ float fast_exp2(float x) { return __builtin_amdgcn_exp2f(x); }
__device__ __forceinline__ float fast_log2(float x) { return __builtin_amdgcn_logf(x); }
__device__ __forceinline__ float fast_rcp(float x) { return __builtin_amdgcn_rcpf(x); }

namespace pg8 {
#define PG8_LAS __attribute__((address_space(3)))
typedef unsigned short bf16_t;
typedef unsigned u32x4 __attribute__((ext_vector_type(4)));
constexpr int BM = 256, BK = 64, HALF = 128, HTB = HALF * BK * 2, STAGE_BYTES = 8 * HTB, NXCD = 8, WGM = 8;
__host__ __device__ __forceinline__ int lds_byte(int r, int c) { const int st = (r >> 4) * 2 + (c >> 5), rr = r & 15, cc = c & 31, ob = rr * 64 + cc * 2; return st * 1024 + (ob ^ (((ob >> 9) & 1) << 5)); }
__host__ __device__ __forceinline__ void stage_rc(int b, int& R, int& C) { const int st = b / 1024, sb = b % 1024, swz = sb ^ (((sb >> 9) & 1) << 5); R = (st >> 1) * 16 + swz / 64; C = (st & 1) * 32 + (swz % 64) / 2; }
__host__ __device__ __forceinline__ int perm32(int rho) { const int n = rho >> 4, i = rho & 15; return 8 * (i >> 2) + 4 * n + (i & 3); }

struct Unit { int pm, pn, li; const char* A; const char* B; };

struct DenseOrder {
    int nM, nN, nwg, G, c; const char* A; const char* B; size_t tstep;
    __device__ void init(const void* A_, const void* B_, int M, int N, int K, int G_, int c_) { nM = M / BM; nN = N / BM; nwg = nM * nN; G = G_; c = c_; A = (const char*)A_; B = (const char*)B_; tstep = (size_t)BM * K * 2; }
    __device__ bool next(int i, Unit& u) const {
        const long L = (long)i * G + c; if (L >= nwg) return false;
        int wgid = (int)L; { const int q = nwg / NXCD, r = nwg % NXCD, xcd = wgid % NXCD, off = wgid / NXCD; wgid = (xcd < r ? xcd * (q + 1) : r * (q + 1) + (xcd - r) * q) + off; }
        const int nig = WGM * nN, gid = wgid / nig, fm = gid * WGM, gsz = (nM - fm) < WGM ? (nM - fm) : WGM;
        u.pm = fm + ((wgid % nig) % gsz); u.pn = (wgid % nig) / gsz; u.li = 0;
        u.A = A + (size_t)u.pm * tstep; u.B = B + (size_t)u.pn * tstep; return true;
    }
};

template <class Epi, class Sched, bool GATHER>
__device__ __forceinline__ void gemm_phase(PG8_LAS unsigned char* lds, const int K, const Sched& S, const Epi& E, const PG8_LAS int* tab) {
    const int tid = threadIdx.x, wid = __builtin_amdgcn_readfirstlane(tid >> 6), lane = tid & 63, wr = wid >> 2, wc = wid & 3, fr = lane & 15, fq = lane >> 4;
    const int nt = K / BK;
    unsigned voffA[2], voffB[2]; int RA[2], CA[2];
#pragma unroll
    for (int i = 0; i < 2; ++i) { int R, C; stage_rc(tid * 16 + i * 8192, R, C); const int Rb = Epi::PERM ? ((R & ~31) + perm32(R & 31)) : R;
        voffA[i] = (unsigned)(R * K + C) * 2u; voffB[i] = (unsigned)(Rb * K + C) * 2u; RA[i] = R; CA[i] = C; }
    const size_t kstep = (size_t)(BK * 2);
    const size_t hstep = (size_t)HALF * K * 2;
    const unsigned ldsw = (unsigned)wid * 1024u;
    const int aoff = lds_byte(wr * 64 + fr, fq * 8), boff = lds_byte(wc * 32 + fr, fq * 8);
    unsigned gA[2][2], gAn[2][2];
#define PG8_SA(b, h) (((b) * 2 + (h)) * HTB)
#define PG8_SB(b, h) ((4 + (b) * 2 + (h)) * HTB)
#define PG8_GL(gptr, ldsoff) __builtin_amdgcn_global_load_lds((const unsigned*)(gptr), (PG8_LAS unsigned*)(lds + (ldsoff)), 16, 0, 0)
#define PG8_STAGE_B(bufoff, gbase) do { _Pragma("unroll") for (int _i = 0; _i < 2; ++_i) PG8_GL((const char*)(gbase) + voffB[_i], (bufoff) + ldsw + _i * 8192); } while (0)
#define PG8_STAGE_A(bufoff, gbase, h, NX) do { _Pragma("unroll") for (int _i = 0; _i < 2; ++_i) { \
        if constexpr (GATHER) { const unsigned _vo = (NX) ? gAn[h][_i] : gA[h][_i]; PG8_GL((const char*)(gbase) + _vo, (bufoff) + ldsw + _i * 8192); } \
        else { PG8_GL((const char*)(gbase) + (size_t)(h) * hstep + voffA[_i], (bufoff) + ldsw + _i * 8192); } } } while (0)
#define PG8_GIDX(dst, li) do { if constexpr (GATHER) { _Pragma("unroll") for (int _h = 0; _h < 2; ++_h) _Pragma("unroll") for (int _i = 0; _i < 2; ++_i) \
        dst[_h][_i] = ((unsigned)tab[(li) * 256 + _h * 128 + RA[_i]] * (unsigned)K + (unsigned)CA[_i]) * 2u; } } while (0)
#define PG8_LDA(dst, b, h) do { _Pragma("unroll") for (int m = 0; m < 4; ++m) _Pragma("unroll") for (int k = 0; k < 2; ++k) dst[m][k] = *(const PG8_LAS bf16x8*)(lds + PG8_SA(b, h) + aoff + m * 2048 + k * 1024); } while (0)
#define PG8_LDB(dst, b, h) do { _Pragma("unroll") for (int n = 0; n < 2; ++n) _Pragma("unroll") for (int k = 0; k < 2; ++k) dst[n][k] = *(const PG8_LAS bf16x8*)(lds + PG8_SB(b, h) + boff + n * 2048 + k * 1024); } while (0)
#define PG8_MMA(ai, bj, At, Bt) do { __builtin_amdgcn_s_setprio(1); _Pragma("unroll") for (int m = 0; m < 4; ++m) _Pragma("unroll") for (int n = 0; n < 2; ++n) _Pragma("unroll") for (int k = 0; k < 2; ++k) \
        acc[ai][bj][m][n] = __builtin_amdgcn_mfma_f32_16x16x32_bf16(Bt[n][k], At[m][k], acc[ai][bj][m][n], 0, 0, 0); __builtin_amdgcn_s_setprio(0); } while (0)
#define PG8_WAIT_V(n) asm volatile("s_waitcnt vmcnt(" #n ")" ::: "memory")
#define PG8_WAIT_L(n) asm volatile("s_waitcnt lgkmcnt(" #n ")" ::: "memory")
#define PG8_BAR __builtin_amdgcn_s_barrier()
#define PG8_SCHED __builtin_amdgcn_sched_barrier(0)
    Unit cur, nxt; int ui = 0;
    if (!S.next(0, cur)) return;
    f32x4 acc[2][2][4][2];
#pragma unroll
    for (int a = 0; a < 2; ++a)
#pragma unroll
        for (int b = 0; b < 2; ++b)
#pragma unroll
            for (int m = 0; m < 4; ++m)
#pragma unroll
                for (int n = 0; n < 2; ++n) acc[a][b][m][n] = (f32x4){0.f, 0.f, 0.f, 0.f};
    bf16x8 At[4][2], B0[2][2], B1[2][2];
    const char* cA = cur.A; const char* cB = cur.B;
    PG8_GIDX(gA, cur.li);
    PG8_STAGE_B(PG8_SB(0, 0), cB); PG8_STAGE_B(PG8_SB(0, 1), cB + hstep); PG8_STAGE_A(PG8_SA(0, 0), cA, 0, false); PG8_STAGE_A(PG8_SA(0, 1), cA, 1, false);
    if (wr == 1) PG8_BAR;
    PG8_WAIT_V(2); PG8_BAR;
    PG8_STAGE_B(PG8_SB(1, 0), cB + kstep); PG8_STAGE_A(PG8_SA(1, 0), cA + kstep, 0, false); PG8_STAGE_B(PG8_SB(1, 1), cB + hstep + kstep);
    PG8_WAIT_V(6); PG8_BAR;
    for (;;) {
        const bool has_next = S.next(ui + 1, nxt);
        const char* nA = has_next ? nxt.A : cA; const char* nB = has_next ? nxt.B : cB;
        if constexpr (GATHER) { if (has_next) { PG8_GIDX(gAn, nxt.li); } else {
#pragma unroll
            for (int _h = 0; _h < 2; ++_h)
#pragma unroll
                for (int _i = 0; _i < 2; ++_i) gAn[_h][_i] = gA[_h][_i]; } }
        for (int t = 0; t < nt; t += 2) {
            const bool last = (t == nt - 2);
            const char* a1 = cA + (size_t)(t + 1) * kstep;
            const char* a2 = last ? nA : cA + (size_t)(t + 2) * kstep; const char* b2 = last ? nB : cB + (size_t)(t + 2) * kstep;
            const char* a3 = a2 + kstep; const char* b3 = b2 + kstep;
            PG8_LDB(B0, 0, 0); PG8_LDB(B1, 0, 1); PG8_SCHED; PG8_LDA(At, 0, 0); PG8_STAGE_A(PG8_SA(1, 1), a1, 1, false);
            PG8_WAIT_V(8); PG8_WAIT_L(0); PG8_BAR; PG8_MMA(0, 0, At, B0); PG8_MMA(0, 1, At, B1); PG8_BAR; PG8_SCHED;
            PG8_LDA(At, 0, 1); PG8_STAGE_B(PG8_SB(0, 0), b2); PG8_STAGE_B(PG8_SB(0, 1), b2 + hstep); PG8_STAGE_A(PG8_SA(0, 0), a2, 0, last);
            PG8_WAIT_V(8); PG8_WAIT_L(0); PG8_BAR; PG8_MMA(1, 0, At, B0); PG8_MMA(1, 1, At, B1); PG8_BAR; PG8_SCHED;
            PG8_LDB(B0, 1, 0); PG8_LDB(B1, 1, 1); PG8_SCHED; PG8_LDA(At, 1, 0); PG8_STAGE_A(PG8_SA(0, 1), a2, 1, last);
            PG8_WAIT_V(8); PG8_WAIT_L(0); PG8_BAR; PG8_MMA(0, 0, At, B0); PG8_MMA(0, 1, At, B1); PG8_BAR; PG8_SCHED;
            PG8_LDA(At, 1, 1); PG8_STAGE_B(PG8_SB(1, 0), b3); PG8_STAGE_B(PG8_SB(1, 1), b3 + hstep); PG8_STAGE_A(PG8_SA(1, 0), a3, 0, last);
            PG8_WAIT_V(8); PG8_WAIT_L(0); PG8_BAR; PG8_MMA(1, 0, At, B0); PG8_MMA(1, 1, At, B1); PG8_BAR; PG8_SCHED;
        }
        if (wr == 0) PG8_BAR;
        E(acc, cur, wr, wc, fr, fq);
        if (!has_next) break;
#pragma unroll
        for (int a = 0; a < 2; ++a)
#pragma unroll
            for (int b = 0; b < 2; ++b)
#pragma unroll
                for (int m = 0; m < 4; ++m)
#pragma unroll
                    for (int n = 0; n < 2; ++n) acc[a][b][m][n] = (f32x4){0.f, 0.f, 0.f, 0.f};
        cur = nxt; cA = nA; cB = nB; ++ui;
        if constexpr (GATHER) {
#pragma unroll
            for (int _h = 0; _h < 2; ++_h)
#pragma unroll
                for (int _i = 0; _i < 2; ++_i) gA[_h][_i] = gAn[_h][_i]; }
        if (wr == 1) PG8_BAR;
    }
    PG8_WAIT_V(0);
    PG8_BAR;
#undef PG8_SA
#undef PG8_SB
#undef PG8_GL
#undef PG8_STAGE_A
#undef PG8_STAGE_B
#undef PG8_GIDX
#undef PG8_LDA
#undef PG8_LDB
#undef PG8_MMA
#undef PG8_WAIT_V
#undef PG8_WAIT_L
#undef PG8_BAR
#undef PG8_SCHED
}

struct EpiProj {
    static constexpr bool PERM = true;
    bf16_t* P; float* SS;
    __device__ __forceinline__ void operator()(const f32x4 (&acc)[2][2][4][2], const Unit& u, int wr, int wc, int fr, int fq) const {
        const int t = u.pn >> 2, colt = (u.pn & 3) * BM;
        bf16_t* base = P + (size_t)t * PROJ_TS;
        const int row0 = u.pm * BM + wr * 64 + fr, col0 = colt + wc * 32 + 8 * fq;
        if (t <= 1) {
#pragma unroll
            for (int ai = 0; ai < 2; ++ai)
#pragma unroll
                for (int m = 0; m < 4; ++m)
#pragma unroll
                    for (int bj = 0; bj < 2; ++bj) {
                        const f32x4 a = acc[ai][bj][m][0], b = acc[ai][bj][m][1];
                        float s = (a[0] * a[0] + a[1] * a[1]) + (a[2] * a[2] + a[3] * a[3]) + (b[0] * b[0] + b[1] * b[1]) + (b[2] * b[2] + b[3] * b[3]);
                        s += __shfl_xor(s, 16); s += __shfl_xor(s, 32);
                        if (fq == 0) SS[(((size_t)t * MROWS + (row0 + ai * HALF + m * 16)) * 8 + ((u.pn & 3) * 2 + bj)) * 4 + wc] = s;
                    }
        }
#pragma unroll
        for (int ai = 0; ai < 2; ++ai)
#pragma unroll
            for (int m = 0; m < 4; ++m) { bf16_t* rowp = base + (size_t)(row0 + ai * HALF + m * 16) * 1024 + col0;
#pragma unroll
                for (int bj = 0; bj < 2; ++bj) { f32x4 v0 = acc[ai][bj][m][0], v1 = acc[ai][bj][m][1];
                    if (t == 3) {
#pragma unroll
                        for (int j = 0; j < 4; ++j) { v0[j] = fast_rcp(1.f + fast_exp2(-v0[j] * LOG2E)); v1[j] = fast_rcp(1.f + fast_exp2(-v1[j] * LOG2E)); } }
                    if (t == 4) { v0 = v0 * QSCALE2; v1 = v1 * QSCALE2; }
                    u32x4 w; w.x = cvtpk(v0[0], v0[1]); w.y = cvtpk(v0[2], v0[3]); w.z = cvtpk(v1[0], v1[1]); w.w = cvtpk(v1[2], v1[3]);
                    *(u32x4*)(rowp + bj * HALF) = w; } }
    }
};
struct EpiOut {
    static constexpr bool PERM = false;
    const float* X; float* O;
    __device__ __forceinline__ void operator()(const f32x4 (&acc)[2][2][4][2], const Unit& u, int wr, int wc, int fr, int fq) const {
        const int row0 = u.pm * BM + wr * 64 + fr, col0 = u.pn * BM + wc * 32 + 4 * fq;
#pragma unroll
        for (int ai = 0; ai < 2; ++ai)
#pragma unroll
            for (int m = 0; m < 4; ++m) { const size_t off = (size_t)(row0 + ai * HALF + m * 16) * DM + col0;
#pragma unroll
                for (int bj = 0; bj < 2; ++bj)
#pragma unroll
                    for (int n = 0; n < 2; ++n) { const f32x4 xv = *(const f32x4*)(X + off + bj * HALF + n * 16); *(f32x4*)(O + off + bj * HALF + n * 16) = xv + acc[ai][bj][m][n]; } }
    }
};
}

namespace moe {
constexpr int MT = 384, BKT = 64, A_BYTES = MT * BKT * 2, B_PITCH = 320, B_BYTES = BKT * B_PITCH;
constexpr int OFF_A = 0, OFF_B = 2 * A_BYTES, STAGE_END = 2 * A_BYTES + 2 * B_BYTES;
typedef short v4i16_t __attribute__((ext_vector_type(4)));
__device__ __forceinline__ s16x4 vtr(const LAS unsigned char* p) { return __builtin_bit_cast(s16x4, __builtin_amdgcn_ds_read_tr16_b64_v4i16((LAS v4i16_t*)p)); }

struct Order {
    int G, c, ncs; const LAS int* upre; const LAS int* cpre;
    __device__ bool decode(int i, int& e, int& cs, int& mt, int& cnt, int& cbase) const {
        const int L = i * G + c; if (L >= __builtin_amdgcn_readfirstlane(upre[NE])) return false;
        int lo = 0, hi = NE;
        while (hi - lo > 1) { const int mid = (lo + hi) >> 1; const int v = __builtin_amdgcn_readfirstlane(upre[mid]); if (v <= L) lo = mid; else hi = mid; }
        e = lo; const int u0 = __builtin_amdgcn_readfirstlane(upre[e]), u1 = __builtin_amdgcn_readfirstlane(upre[e + 1]), ntm = (u1 - u0) / ncs, r = L - u0;
        cs = r / ntm; mt = r - cs * ntm; cbase = __builtin_amdgcn_readfirstlane(cpre[e]); cnt = __builtin_amdgcn_readfirstlane(cpre[e + 1]) - cbase; return true;
    }
};

template <int KDIM, bool G1>
__device__ __forceinline__ void phase(LAS unsigned char* lds, const Order& S, const LAS int* tab, const char* Abase, const float* Wa, const float* Wb, bf16* Out) {
    const int tid = threadIdx.x, wid = __builtin_amdgcn_readfirstlane(tid >> 6), lane = tid & 63, r32 = lane & 31, hi = lane >> 5, wr = wid >> 1, wc = wid & 1;
    constexpr int NTK = KDIM / BKT;
    constexpr int LDB = G1 ? DE : DM;
    for (int ui = 0;; ++ui) {
        int e, cs, mt, cnt, cbase; if (!S.decode(ui, e, cs, mt, cnt, cbase)) break;
        const int rows_valid = cnt - MT * mt;
        unsigned aoff[6];
#pragma unroll
        for (int q = 0; q < 6; ++q) { const int row = 8 * (6 * wid + q) + (lane >> 3); const int arow = G1 ? tab[ui * MT + row] : cbase + MT * mt + row;
            aoff[q] = (unsigned)arow * (unsigned)(KDIM * 2) + (unsigned)(((lane & 7) ^ (row & 7)) * 16); }
        const int bn = (tid & 31) * 4, bk = tid >> 5;
        const float* bsrc = G1 ? ((bn < 64 ? Wa : Wb) + (size_t)e * DM * DE + 64 * cs + (bn & 63) + (size_t)bk * LDB)
                               : (Wa + (size_t)e * DE * DM + 128 * cs + bn + (size_t)bk * LDB);
        const unsigned bwr = (unsigned)(bk * B_PITCH + (tid & 31) * 8);
        const LAS unsigned char* trb = lds + OFF_B + (8 * hi + ((lane & 15) >> 2)) * B_PITCH + (16 * ((lane >> 4) & 1) + 4 * (lane & 3)) * 2 + wc * 64;
        const LAS unsigned char* xa[4];
#pragma unroll
        for (int ks = 0; ks < 4; ++ks) xa[ks] = lds + OFF_A + (32 * wr + r32) * 128 + (((2 * ks + hi) ^ (r32 & 7)) * 16);
        const bool rbv1 = 32 * (wr + 4) < rows_valid, rbv2 = 32 * (wr + 8) < rows_valid, rbv0 = 32 * wr < rows_valid;
        f32x16 acc[3][2];
#pragma unroll
        for (int j = 0; j < 3; ++j) { acc[j][0] = f32x16{}; acc[j][1] = f32x16{}; }
        f32x4 R0[4], R1[4];
#define MOE_DMA_A(t, buf) do { _Pragma("unroll") for (int q = 0; q < 6; ++q) \
            __builtin_amdgcn_global_load_lds((const unsigned*)(Abase + aoff[q] + (size_t)(t) * (BKT * 2)), (LAS unsigned*)(lds + OFF_A + (buf) * A_BYTES + (6 * wid + q) * 1024), 16, 0, 0); } while (0)
#define MOE_LDB(R, t) do { const int t_ = (t) < NTK ? (t) : NTK - 1; _Pragma("unroll") for (int i = 0; i < 4; ++i) R[i] = *(const f32x4*)(bsrc + (size_t)(t_ * BKT + 16 * i) * LDB); } while (0)
#define MOE_WRB(R, buf) do { _Pragma("unroll") for (int i = 0; i < 4; ++i) *(LAS v2u*)(lds + OFF_B + (buf) * B_BYTES + bwr + i * 16 * B_PITCH) = (v2u){cvtpk(R[i].x, R[i].y), cvtpk(R[i].z, R[i].w)}; } while (0)
#define MOE_COMPUTE(buf) do { _Pragma("unroll") for (int ks = 0; ks < 4; ++ks) { \
            bf16x8 wf[2], xf[3]; \
            _Pragma("unroll") for (int nbi = 0; nbi < 2; ++nbi) { const s16x4 lo_ = vtr(trb + (buf) * B_BYTES + ks * 16 * B_PITCH + nbi * 128), hi_ = vtr(trb + (buf) * B_BYTES + ks * 16 * B_PITCH + 4 * B_PITCH + nbi * 128); \
                wf[nbi] = (bf16x8){lo_[0], lo_[1], lo_[2], lo_[3], hi_[0], hi_[1], hi_[2], hi_[3]}; } \
            _Pragma("unroll") for (int j = 0; j < 3; ++j) xf[j] = *(const LAS bf16x8*)(xa[ks] + (buf) * A_BYTES + j * 16384); \
            if (rbv0) { acc[0][0] = __builtin_amdgcn_mfma_f32_32x32x16_bf16(wf[0], xf[0], acc[0][0], 0, 0, 0); acc[0][1] = __builtin_amdgcn_mfma_f32_32x32x16_bf16(wf[1], xf[0], acc[0][1], 0, 0, 0); } \
            if (rbv1) { acc[1][0] = __builtin_amdgcn_mfma_f32_32x32x16_bf16(wf[0], xf[1], acc[1][0], 0, 0, 0); acc[1][1] = __builtin_amdgcn_mfma_f32_32x32x16_bf16(wf[1], xf[1], acc[1][1], 0, 0, 0); } \
            if (rbv2) { acc[2][0] = __builtin_amdgcn_mfma_f32_32x32x16_bf16(wf[0], xf[2], acc[2][0], 0, 0, 0); acc[2][1] = __builtin_amdgcn_mfma_f32_32x32x16_bf16(wf[1], xf[2], acc[2][1], 0, 0, 0); } } } while (0)
#define MOE_WAITV(n) asm volatile("s_waitcnt vmcnt(" #n ")" ::: "memory")
        __syncthreads();
        MOE_LDB(R0, 0); MOE_LDB(R1, 1); MOE_DMA_A(0, 0);
        MOE_WAITV(10); MOE_WRB(R0, 0); MOE_LDB(R0, 2);
        MOE_WAITV(4); LDS_WAIT(); __builtin_amdgcn_s_barrier();
        for (int t = 0; t < NTK; t += 2) {
            MOE_DMA_A(t + 1 < NTK ? t + 1 : t, 1);
            MOE_WAITV(10); MOE_WRB(R1, 1); MOE_LDB(R1, t + 3);
            MOE_COMPUTE(0);
            MOE_WAITV(4); LDS_WAIT(); __builtin_amdgcn_s_barrier();
            MOE_DMA_A(t + 2 < NTK ? t + 2 : t, 0);
            MOE_WAITV(10); MOE_WRB(R0, 0); MOE_LDB(R0, t + 4);
            MOE_COMPUTE(1);
            MOE_WAITV(4); LDS_WAIT(); __builtin_amdgcn_s_barrier();
        }
        MOE_WAITV(0);
#undef MOE_DMA_A
#undef MOE_LDB
#undef MOE_WRB
#undef MOE_COMPUTE
#undef MOE_WAITV
#pragma unroll
        for (int j = 0; j < 3; ++j) { const int row = 32 * (wr + 4 * j) + r32;
            if (row < rows_valid) { const size_t orow = (size_t)(cbase + MT * mt + row);
                if (G1) { bf16* op = Out + orow * DE + 64 * cs + 32 * wc + 4 * hi;
#pragma unroll
                    for (int g = 0; g < 4; ++g) { float h4[4];
#pragma unroll
                        for (int i2 = 0; i2 < 4; ++i2) { const float a = acc[j][0][4 * g + i2], b = acc[j][1][4 * g + i2]; h4[i2] = a * fast_rcp(1.f + fast_exp2(-a * LOG2E)) * b; }
                        *(v2u*)(op + 8 * g) = (v2u){cvtpk(h4[0], h4[1]), cvtpk(h4[2], h4[3])}; } }
                else { const float w = ((const LAS float*)tab)[ui * MT + row]; bf16* op = Out + orow * DM + 128 * cs + 32 * wc + 4 * hi;
#pragma unroll
                    for (int nbi = 0; nbi < 2; ++nbi)
#pragma unroll
                        for (int g = 0; g < 4; ++g) *(v2u*)(op + 64 * nbi + 8 * g) = (v2u){cvtpk(acc[j][nbi][4 * g] * w, acc[j][nbi][4 * g + 1] * w), cvtpk(acc[j][nbi][4 * g + 2] * w, acc[j][nbi][4 * g + 3] * w)}; } } }
    }
}
}

namespace att {
#define KSWZ(row, colB) ((row) * 256 + ((colB) ^ (((row) & 7) << 4)))
#define SBAR() __builtin_amdgcn_sched_barrier(0)
constexpr int SHM_V = 16384, SHM_K = 16384;
constexpr int KS_OFF = 32768, WSF_OFF = 33792, WSF_FLOATS = 1152;
__device__ __forceinline__ int v_st(int k, int c) { const int kk = (k & ~0xC) | ((k & 4) << 1) | ((k & 8) >> 1); return ((kk >> 3) * 4 + (c >> 5)) * 512 + ((kk & 7) * 32 + (c & 31)) * 2; }
__device__ __forceinline__ int v_rd_base(int lane) { return ((lane & 3) << 3) | (((lane >> 2) & 3) << 6) | (((lane >> 4) & 1) << 5) | (((lane >> 5) & 1) << 8); }
constexpr int v_rd_off(int d0, int ks, int half) { return d0 * 512 + ks * 4096 + half * 2048; }
__device__ __forceinline__ int crow(int r, int hi) { return (r & 3) + 8 * (r >> 2) + 4 * hi; }

__device__ __forceinline__ void qkt(f32x16& p0, f32x16& p1, const char* K_lds, int r32, int hi, const bf16x8* qr) {
    p0 = f32x16{}; p1 = f32x16{};
    const char* kb[4];
#pragma unroll
    for (int dd = 0; dd < 4; ++dd) kb[dd] = K_lds + KSWZ(r32, (dd * 16 + hi * 8) * 2);
#pragma unroll
    for (int d0 = 0; d0 < 8; ++d0) { const char* a = kb[d0 & 3] + (d0 >> 2) * 128;
        bf16x8 b0 = *reinterpret_cast<const bf16x8*>(a);
        bf16x8 b1 = *reinterpret_cast<const bf16x8*>(a + 32 * 256);
        p0 = __builtin_amdgcn_mfma_f32_32x32x16_bf16(b0, qr[d0], p0, 0, 0, 0);
        p1 = __builtin_amdgcn_mfma_f32_32x32x16_bf16(b1, qr[d0], p1, 0, 0, 0); }
}
__device__ __forceinline__ void pv_tile(f32x16* o, int vb0, bf16x8 pa0, bf16x8 pa1, bf16x8 pa2, bf16x8 pa3) {
#define TRRD(dst, off) asm volatile("ds_read_b64_tr_b16 %0, %1 offset:%2" : "=&v"(dst) : "v"(vb0), "i"(off) : "memory")
#define PV_D0(d0) do { s16x4 l0, l1, l2, l3, h0, h1, h2, h3; constexpr int b_ = v_rd_off(d0, 0, 0); \
        TRRD(l0, b_); TRRD(h0, b_ + 2048); TRRD(l1, b_ + 4096); TRRD(h1, b_ + 6144); TRRD(l2, b_ + 8192); TRRD(h2, b_ + 10240); TRRD(l3, b_ + 12288); TRRD(h3, b_ + 14336); \
        asm volatile("s_waitcnt lgkmcnt(0)" ::: "memory"); SBAR(); \
        o[d0] = __builtin_amdgcn_mfma_f32_32x32x16_bf16(pa0, (bf16x8){l0[0], l0[1], l0[2], l0[3], h0[0], h0[1], h0[2], h0[3]}, o[d0], 0, 0, 0); \
        o[d0] = __builtin_amdgcn_mfma_f32_32x32x16_bf16(pa1, (bf16x8){l1[0], l1[1], l1[2], l1[3], h1[0], h1[1], h1[2], h1[3]}, o[d0], 0, 0, 0); \
        o[d0] = __builtin_amdgcn_mfma_f32_32x32x16_bf16(pa2, (bf16x8){l2[0], l2[1], l2[2], l2[3], h2[0], h2[1], h2[2], h2[3]}, o[d0], 0, 0, 0); \
        o[d0] = __builtin_amdgcn_mfma_f32_32x32x16_bf16(pa3, (bf16x8){l3[0], l3[1], l3[2], l3[3], h3[0], h3[1], h3[2], h3[3]}, o[d0], 0, 0, 0); } while (0)
    PV_D0(0); PV_D0(1); PV_D0(2); PV_D0(3);
#undef PV_D0
#undef TRRD
}
#define PK4(P, B_, OUT) do { unsigned a0 = cvtpk(P[B_+0], P[B_+1]), a1 = cvtpk(P[B_+2], P[B_+3]); \
        unsigned b0 = cvtpk(P[B_+4], P[B_+5]), b1 = cvtpk(P[B_+6], P[B_+7]); \
        auto r0 = __builtin_amdgcn_permlane32_swap(a0, b0, false, false); auto r1 = __builtin_amdgcn_permlane32_swap(a1, b1, false, false); \
        v4u w = {r0[0], r1[0], r0[1], r1[1]}; OUT = *reinterpret_cast<bf16x8*>(&w); } while (0)

struct Tensors {
    const bf16* QA; const bf16* KA; const bf16* VA; const bf16* GA; const bf16* QB; const bf16* KB; const bf16* VB;
    const float* RK; const float* MT; const float* CUM;
    const float* fox_gain; const float* sb_gain;
    bf16* MIX;
};

template <int TYP>
__device__ __forceinline__ void attn_unit(char* lds, const Tensors& T, const int b, const int h, const int qb) {
    const int tid = threadIdx.x, wid = __builtin_amdgcn_readfirstlane(tid >> 6), lane = tid & 63, r32 = lane & 31, hi = lane >> 5;
    char* V_lds = lds; char* K_lds = lds + SHM_V;
    float* ks_rk = (float*)(lds + KS_OFF); float* ks_nc = ks_rk + 64; int* wdone = (int*)(lds + KS_OFF + 512);
    float* wsf = (float*)(lds + WSF_OFF) + wid * WSF_FLOATS; float* part = wsf; float* li_l = wsf + 1056; float* rs_l = wsf + 1088;
    const bf16* Qp = TYP == 0 ? T.QA : T.QB; const bf16* Kp = TYP == 0 ? T.KA : T.KB; const bf16* Vp = TYP == 0 ? T.VA : T.VB;
    const int frow0 = b * SEQ + qb * 256 + wid * 32;
    const int cbase = (b * NH + h) * CUMLD;
    bf16x8 qr[8];
#pragma unroll
    for (int d0 = 0; d0 < 8; ++d0) qr[d0] = *reinterpret_cast<const bf16x8*>(Qp + (size_t)(frow0 + r32) * 1024 + h * HD + d0 * 16 + hi * 8);
    const int qp = 64 + qb * 256 + wid * 32 + r32;
    const int qpmin = 64 + qb * 256 + wid * 32, qpmax = qpmin + 31;
    float bias_t = 0.f, cum_t = 0.f, Rrun = 0.f, l_reg = 0.f;
    if (TYP == 0) { cum_t = T.CUM[cbase + qp - 48]; bias_t = cum_t - T.MT[(size_t)(frow0 + r32) * 8 + h]; }
    bool wave_done = false;
    if (lane == 0) wdone[wid] = 0;
    f32x16 o[4] = {};
    const int sr = tid >> 4, sc = (tid & 15) * 8;
    const int vst0 = v_st(sr, sc), vst1 = v_st(32 + sr, sc), kws = KSWZ(sr, sc * 2);
    const int vb0 = (int)(uintptr_t)V_lds + v_rd_base(lane);
    bf16x8 st_k0, st_k1, st_v0, st_v1; float st_rk = 0.f, st_nc = 0.f;
#define KEYROW(j, i) ((j) == 0 ? ((i) >= 48 ? ROW_META + (i) - 48 : ROW_META) : b * SEQ + 64 * ((j) - 1) + (i))
#define TLOAD(j) do { const size_t r0_ = (size_t)KEYROW(j, sr) * 1024 + h * HD + sc, r1_ = (size_t)KEYROW(j, 32 + sr) * 1024 + h * HD + sc; \
        st_k0 = *reinterpret_cast<const bf16x8*>(Kp + r0_); st_k1 = *reinterpret_cast<const bf16x8*>(Kp + r1_); \
        st_v0 = *reinterpret_cast<const bf16x8*>(Vp + r0_); st_v1 = *reinterpret_cast<const bf16x8*>(Vp + r1_); \
        if (TYP == 0 && tid < 64) { const int kr_ = KEYROW(j, tid); const int pos_ = (j) == 0 ? (tid >= 48 ? tid - 48 : 0) : 16 + 64 * ((j) - 1) + tid; \
            st_rk = T.RK[(size_t)kr_ * 8 + h]; st_nc = -T.CUM[cbase + pos_]; } } while (0)
    int j = 4 * qb + 4;
    TLOAD(j);
    for (; j >= 0; --j) {
        __syncthreads();
        { const v4u d0 = *(const v4u*)wdone, d1 = *((const v4u*)wdone + 1);
          if (__builtin_amdgcn_readfirstlane((d0.x & d0.y & d0.z & d0.w) & (d1.x & d1.y & d1.z & d1.w)) != 0u) break; }
        *(bf16x8*)(K_lds + kws) = st_k0; *(bf16x8*)(K_lds + kws + 32 * 256) = st_k1;
        *(bf16x8*)(V_lds + vst0) = st_v0; *(bf16x8*)(V_lds + vst1) = st_v1;
        if (TYP == 0 && tid < 64) { ks_rk[tid] = st_rk; ks_nc[tid] = st_nc; }
        __syncthreads();
        if (j > 0) TLOAD(j - 1);
        if (wave_done || 64 * j > qpmax) continue;
        f32x16 p0, p1;
        qkt(p0, p1, K_lds, r32, hi, qr);
        const bool need_mask = (j == 0) || (64 * j + 63 > qpmin - (TYP == 1 ? 1 : 0));
        const int kp0 = 64 * j + 4 * hi;
        bf16x8 pa0, pa1, pa2, pa3;
        if (TYP == 0) {
#pragma unroll
            for (int q = 0; q < 8; ++q) {
                const f32x4 rkv = *(const f32x4*)(ks_rk + 8 * q + 4 * hi), ncv = *(const f32x4*)(ks_nc + 8 * q + 4 * hi);
                if (q < 4) {
#pragma unroll
                    for (int i = 0; i < 4; ++i) p0[4 * q + i] = fmaf(p0[4 * q + i], rkv[i], ncv[i]) + bias_t;
                } else {
#pragma unroll
                    for (int i = 0; i < 4; ++i) p1[4 * (q - 4) + i] = fmaf(p1[4 * (q - 4) + i], rkv[i], ncv[i]) + bias_t;
                }
                asm volatile("" ::: "memory");
            }
            if (need_mask) {
#pragma unroll
                for (int r = 0; r < 16; ++r) { const int kp = kp0 + (r & 3) + 8 * (r >> 2);
                    if (!(kp <= qp && kp >= 48)) p0[r] = -__builtin_inff();
                    if (!(kp + 32 <= qp && kp + 32 >= 48)) p1[r] = -__builtin_inff(); }
            }
            float ps = 0.f;
#pragma unroll
            for (int r = 0; r < 16; ++r) { p0[r] = fast_exp2(p0[r]); p1[r] = fast_exp2(p1[r]); ps += p0[r] + p1[r]; }
            l_reg += ps;
        } else {
            f32x16 k0, k1;
#pragma unroll
            for (int r = 0; r < 16; ++r) {
                { const float z = p0[r], sp = fmaxf(z, 0.f) + fast_log2(1.f + fast_exp2(-fabsf(z))); k0[r] = -sp; p0[r] = z - sp; }
                { const float z = p1[r], sp = fmaxf(z, 0.f) + fast_log2(1.f + fast_exp2(-fabsf(z))); k1[r] = -sp; p1[r] = z - sp; }
            }
            if (need_mask) {
#pragma unroll
                for (int r = 0; r < 16; ++r) { const int kp = kp0 + (r & 3) + 8 * (r >> 2);
                    if (!(kp < qp && kp >= 48)) { p0[r] = -__builtin_inff(); k0[r] = 0.f; }
                    if (!(kp + 32 < qp && kp + 32 >= 48)) { p1[r] = -__builtin_inff(); k1[r] = 0.f; } }
            }
            float so = 0.f, spi = 0.f;
#pragma unroll
            for (int i = 7; i >= 0; --i) {
                const float g = (i < 4) ? (k0[4 * (i & 3)] + k0[4 * (i & 3) + 1]) + (k0[4 * (i & 3) + 2] + k0[4 * (i & 3) + 3]) : (k1[4 * (i & 3)] + k1[4 * (i & 3) + 1]) + (k1[4 * (i & 3) + 2] + k1[4 * (i & 3) + 3]);
                const float spn = spi + __shfl_xor(g, 32);
                const float off = Rrun + so + (hi ? spi : spn);
                if (i < 4) { const float l3 = off, l2 = l3 + k0[4 * i + 3], l1 = l2 + k0[4 * i + 2], l0 = l1 + k0[4 * i + 1];
                    p0[4 * i + 3] = fast_exp2(p0[4 * i + 3] + l3); p0[4 * i + 2] = fast_exp2(p0[4 * i + 2] + l2); p0[4 * i + 1] = fast_exp2(p0[4 * i + 1] + l1); p0[4 * i] = fast_exp2(p0[4 * i] + l0); }
                else { const int ii = i - 4; const float l3 = off, l2 = l3 + k1[4 * ii + 3], l1 = l2 + k1[4 * ii + 2], l0 = l1 + k1[4 * ii + 1];
                    p1[4 * ii + 3] = fast_exp2(p1[4 * ii + 3] + l3); p1[4 * ii + 2] = fast_exp2(p1[4 * ii + 2] + l2); p1[4 * ii + 1] = fast_exp2(p1[4 * ii + 1] + l1); p1[4 * ii] = fast_exp2(p1[4 * ii] + l0); }
                so += g; spi = spn;
            }
            Rrun += so + spi;
        }
        PK4(p0, 0, pa0); PK4(p0, 8, pa1); PK4(p1, 0, pa2); PK4(p1, 8, pa3);
        pv_tile(o, vb0, pa0, pa1, pa2, pa3);
        if (j > 0) { bool conv;
            if (TYP == 0) { const float lt = l_reg + __shfl_xor(l_reg, 32); conv = (cum_t + ks_nc[0]) <= fast_log2(lt) - 41.f; }
            else conv = Rrun <= -30.f;
            if (__all(conv)) { wave_done = true; if (lane == 0) wdone[wid] = 1; } }
    }
#undef TLOAD
#undef KEYROW
    __syncthreads();
    int lane_e = lane, frow_e = frow0;
    asm volatile("" : "+v"(lane_e), "+s"(frow_e));
    const int r32e = lane_e & 31, hie = lane_e >> 5;
    if (TYP == 0) {
        l_reg += __shfl_xor(l_reg, 32);
        if (hie == 0) li_l[r32e] = fast_rcp(l_reg);
        LDS_WAIT();
#pragma unroll
        for (int r = 0; r < 16; ++r) { const float il = li_l[crow(r, hie)];
#pragma unroll
            for (int d0 = 0; d0 < 4; ++d0) o[d0][r] *= il; }
    }
#pragma unroll
    for (int r = 0; r < 16; ++r) { float s = 0.f;
#pragma unroll
        for (int d0 = 0; d0 < 4; ++d0) s += o[d0][r] * o[d0][r];
        part[crow(r, hie) * 33 + r32e] = s; }
    LDS_WAIT();
    { float s = 0.f;
#pragma unroll
      for (int c = 0; c < 16; ++c) s += part[r32e * 33 + hie * 16 + c];
      s += __shfl_xor(s, 32);
      if (hie == 0) rs_l[r32e] = 1.0f / sqrtf(s * (1.f / HD) + EPS); }
    LDS_WAIT();
    const float* gain = (TYP == 0 ? T.fox_gain : T.sb_gain) + h * HD;
    float gn[4];
#pragma unroll
    for (int d0 = 0; d0 < 4; ++d0) gn[d0] = gain[d0 * 32 + r32e];
#pragma unroll
    for (int r = 0; r < 16; ++r) { const int orow = crow(r, hie); const float rs = rs_l[orow];
        bf16* orp = T.MIX + (size_t)(frow_e + orow) * DM + TYP * 1024 + h * HD;
#pragma unroll
        for (int d0 = 0; d0 < 4; ++d0) { float v = o[d0][r] * rs * gn[d0];
            if (TYP == 0) v *= bf2f(T.GA[(size_t)(frow_e + orow) * 1024 + h * HD + d0 * 32 + r32e]);
            const float vn = __shfl_xor(v, 1);
            if ((r32e & 1) == 0) *(unsigned*)(orp + d0 * 32 + r32e) = cvtpk(v, vn); } }
    LDS_WAIT();
}
#undef PK4
#undef SBAR
#undef KSWZ
}

struct Frame {
    LAS unsigned char* lds; char* ldsg;
    volatile LAS unsigned* MISC;
    gu32* ctl;
    int tid, lane, wave, vcu, G;
    unsigned char* ws;
    const float *x, *meta, *g1, *w_in, *b_f, *q_gain, *k_gain, *fox_gain, *sb_gain, *w_out, *g2, *w_coarse, *b_coarse, *w_fine, *b_fine, *w1, *w3, *w2;
    float* out;
};

__device__ __forceinline__ void transpose_item(const float* W, size_t ldw, int k0, int n0, bf16* WT, size_t Kd, size_t drow0, LAS float* scr, int lane) {
#pragma unroll 8
    for (int i = 0; i < 64; ++i) scr[i * 65 + lane] = W[(size_t)(k0 + i) * ldw + n0 + lane];
    LDS_WAIT(); asm volatile("" ::: "memory");
    const int c = lane & 7;
#pragma unroll
    for (int j = 0; j < 8; ++j) { const int n = (lane >> 3) + 8 * j; const LAS float* s = scr + (8 * c) * 65 + n;
        v4u o; o.x = cvtpk(s[0 * 65], s[1 * 65]); o.y = cvtpk(s[2 * 65], s[3 * 65]); o.z = cvtpk(s[4 * 65], s[5 * 65]); o.w = cvtpk(s[6 * 65], s[7 * 65]);
        *(GAS v4u*)(WT + (drow0 + n) * Kd + k0 + 8 * c) = o; }
    LDS_WAIT(); asm volatile("" ::: "memory");
}

__device__ __forceinline__ void p0_prologue(Frame& F) {
    const int gw = F.vcu * 8 + F.wave, NGW = F.G * 8;
    LAS float* wf = (LAS float*)F.lds;
    for (int e = F.tid; e < 8 * DM; e += 512) { const int k = e >> 3, jj = e & 7; wf[jj * DM + k] = F.w_in[(size_t)k * LDW_IN + NPROJ + jj]; }
    __syncthreads();
    bf16* U1 = (bf16*)(F.ws + WS_U1); float* Fp = (float*)(F.ws + WS_F);
    for (int m = gw; m < MROWS; m += NGW) {
        GAS v2u* o8 = (GAS v2u*)(U1 + (size_t)m * DM) + F.lane;
        if (m >= NKEYROWS) {
#pragma unroll
            for (int j = 0; j < 8; ++j) o8[64 * j] = (v2u){0u, 0u};
            continue; }
        const float* xrow = m < TF ? F.x + (size_t)m * DM : F.meta + (size_t)(m - TF) * DM;
        const GAS f32x4* xr = (const GAS f32x4*)xrow + F.lane;
        f32x4 v[8]; float s = 0.f;
#pragma unroll
        for (int j = 0; j < 8; ++j) { v[j] = xr[64 * j]; s += (v[j].x * v[j].x + v[j].y * v[j].y) + (v[j].z * v[j].z + v[j].w * v[j].w); }
        const float rstd = 1.0f / sqrtf(wave_sum(s) * (1.f / DM) + EPS);
        float fa[8] = {0.f, 0.f, 0.f, 0.f, 0.f, 0.f, 0.f, 0.f};
#pragma unroll
        for (int j = 0; j < 8; ++j) { const f32x4 g = *((const GAS f32x4*)F.g1 + F.lane + 64 * j); v[j] = v[j] * rstd * g;
            o8[64 * j] = (v2u){cvtpk(v[j].x, v[j].y), cvtpk(v[j].z, v[j].w)};
#pragma unroll
            for (int jj = 0; jj < 8; ++jj) { const f32x4 w = *(const LAS f32x4*)(wf + jj * DM + 256 * j + 4 * F.lane); fa[jj] += (v[j].x * w.x + v[j].y * w.y) + (v[j].z * w.z + v[j].w * w.w); } }
#pragma unroll
        for (int jj = 0; jj < 8; ++jj) fa[jj] = wave_sum(fa[jj]);
        if (F.lane == 0) {
#pragma unroll
            for (int jj = 0; jj < 8; ++jj) Fp[(size_t)m * 8 + jj] = fa[jj]; }
    }
    { bf16* U2 = (bf16*)(F.ws + WS_U2);
      for (int m = TF + gw; m < MROWS; m += NGW) { GAS v2u* o8 = (GAS v2u*)(U2 + (size_t)m * DM) + F.lane;
#pragma unroll
          for (int j = 0; j < 8; ++j) o8[64 * j] = (v2u){0u, 0u}; } }
    { bf16* HID = (bf16*)(F.ws + WS_HID);
      for (int m = NASSIGN + gw; m < NASSIGN + 384; m += NGW) { GAS v2u* o8 = (GAS v2u*)(HID + (size_t)m * DE) + F.lane; o8[0] = (v2u){0u, 0u}; o8[64] = (v2u){0u, 0u}; } }
    { v4u* RB = (v4u*)(F.ws + WS_RB);
      for (int it = gw * 64 + F.lane; it < 64 * 5 * 64; it += NGW * 64) { const int ln = it & 63, kc = it >> 6, ks = kc / 5, cb = kc % 5, col = 16 * cb + (ln & 15), k0 = 32 * ks + 8 * (ln >> 4);
          float w[8], lo[8]; unsigned hb[4], lb[4];
#pragma unroll
          for (int i = 0; i < 8; ++i) { w[i] = col < 8 ? F.w_coarse[(size_t)(k0 + i) * 8 + col] : (col < 72 ? F.w_fine[(size_t)(k0 + i) * 64 + col - 8] : 0.f); }
#pragma unroll
          for (int i = 0; i < 4; ++i) { hb[i] = cvtpk(w[2 * i], w[2 * i + 1]); lo[2 * i] = w[2 * i] - __uint_as_float(hb[i] << 16); lo[2 * i + 1] = w[2 * i + 1] - __uint_as_float(hb[i] & 0xffff0000u); lb[i] = cvtpk(lo[2 * i], lo[2 * i + 1]); }
          RB[(size_t)(kc * 2 + 0) * 64 + ln] = (v4u){hb[0], hb[1], hb[2], hb[3]}; RB[(size_t)(kc * 2 + 1) * 64 + ln] = (v4u){lb[0], lb[1], lb[2], lb[3]}; } }
    __syncthreads();
    LAS float* scr = (LAS float*)(F.lds + F.wave * 16640);
    bf16* WinT = (bf16*)(F.ws + WS_WIN_T); bf16* WoutT = (bf16*)(F.ws + WS_WOUT_T);
    constexpr int I_IN = (DM / 64) * (NPROJ / 64), I_OUT = (DM / 64) * (DM / 64);
    constexpr int NITEMS = I_IN + I_OUT;
    for (int it = gw; it < NITEMS; it += NGW) {
        int r = it;
        if (r < I_IN) { const int kb = r / (NPROJ / 64), nb = r % (NPROJ / 64); transpose_item(F.w_in, LDW_IN, kb * 64, nb * 64, WinT, DM, nb * 64, scr, F.lane); continue; } r -= I_IN;
        { const int kb = r / (DM / 64), nb = r % (DM / 64); transpose_item(F.w_out, DM, kb * 64, nb * 64, WoutT, DM, nb * 64, scr, F.lane); }
    }
}

__device__ __forceinline__ void p2_norms(Frame& F) {
    const int gw = F.wave * F.G + (int)blockIdx.x, NGW = F.G * 8;
    const float* Fp = (const float*)(F.ws + WS_F); float* CUM = (float*)(F.ws + WS_CUM);
    const float* SS = (const float*)(F.ws + WS_SS); float* RK = (float*)(F.ws + WS_RK); float* MT = (float*)(F.ws + WS_MT);
    if (gw < NB * NH) {
        const int b = gw >> 3, h = gw & 7; const float bf = F.b_f[h]; float carry = 0.f;
        for (int c0 = 0; c0 < LPOS; c0 += 64) { const int pos = c0 + F.lane; float v = 0.f;
            if (pos < LPOS) { const int row = pos < NMETA ? ROW_META + pos : b * SEQ + pos - NMETA; const float xv = Fp[(size_t)row * 8 + h] + bf;
                v = (fminf(xv, 0.f) - log1pf(expf(-fabsf(xv)))) * LOG2E; }
#pragma unroll
            for (int o = 1; o < 64; o <<= 1) { const float t = __shfl_up(v, o); if (F.lane >= o) v += t; }
            v += carry;
            if (pos < LPOS) CUM[(size_t)gw * CUMLD + pos] = v;
            carry = __shfl(v, 63); }
    }
    for (int e = gw * 64 + F.lane; e < NKEYROWS * 8; e += NGW * 64) { const f32x4 p = *(const f32x4*)(SS + ((size_t)MROWS * 8 + e) * 4);
        RK[e] = 1.0f / sqrtf(((p.x + p.y) + (p.z + p.w)) * (1.f / HD) + EPS); }
    bf16* QA = (bf16*)(F.ws + WS_PROJ);
    const int dbase = (F.lane & 7) * 16;
    float gq[16];
#pragma unroll
    for (int i = 0; i < 16; ++i) gq[i] = F.q_gain[dbase + i] * F.k_gain[dbase + i] * QSCALE2;
    for (int m = gw; m < TF; m += NGW) { const int h = F.lane >> 3;
        const f32x4 p = *(const f32x4*)(SS + ((size_t)m * 8 + h) * 4);
        const float rstd = 1.0f / sqrtf(((p.x + p.y) + (p.z + p.w)) * (1.f / HD) + EPS);
        v4u* qp = (v4u*)(QA + (size_t)m * 1024 + F.lane * 16); v4u a = qp[0], b2 = qp[1];
        unsigned w[8] = {a.x, a.y, a.z, a.w, b2.x, b2.y, b2.z, b2.w}; float n2 = 0.f;
#pragma unroll
        for (int i = 0; i < 8; ++i) { const float lo = __uint_as_float(w[i] << 16) * rstd * gq[2 * i], hi2 = __uint_as_float(w[i] & 0xffff0000u) * rstd * gq[2 * i + 1]; n2 += lo * lo + hi2 * hi2; w[i] = cvtpk(lo, hi2); }
        qp[0] = (v4u){w[0], w[1], w[2], w[3]}; qp[1] = (v4u){w[4], w[5], w[6], w[7]};
        n2 += __shfl_xor(n2, 1); n2 += __shfl_xor(n2, 2); n2 += __shfl_xor(n2, 4);
        if ((F.lane & 7) == 0) MT[(size_t)m * 8 + h] = sqrtf(n2 * (float)HD);
    }
}

__device__ __forceinline__ void p5_router(Frame& F) {
    const int ntask = TF / 16;
    const float* H1 = F.out; bf16* U2 = (bf16*)(F.ws + WS_U2); const v4u* RB = (const v4u*)(F.ws + WS_RB);
    int* RE = (int*)(F.ws + WS_ROUTE); int* RP = RE + TF * 2; float* RW = (float*)(RP + TF * 2); int* TOK = (int*)(F.ws + WS_TOK);
    LAS float* lg = (LAS float*)(F.lds + F.wave * 5632);
    const int i = F.lane & 15, kq = F.lane >> 4;
    for (int task = F.wave * F.G + (int)blockIdx.x; task < ntask; task += F.G * 8) {
        const int row0 = task * 16; const float* hrow = H1 + (size_t)(row0 + i) * DM + 8 * kq;
        float ss = 0.f;
#pragma unroll 8
        for (int ks = 0; ks < 64; ++ks) { const f32x4 a = *(const f32x4*)(hrow + 32 * ks), b = *(const f32x4*)(hrow + 32 * ks + 4);
            ss += (a.x * a.x + a.y * a.y) + (a.z * a.z + a.w * a.w) + (b.x * b.x + b.y * b.y) + (b.z * b.z + b.w * b.w); }
        ss += __shfl_xor(ss, 16); ss += __shfl_xor(ss, 32);
        const float rstd = 1.0f / sqrtf(ss * (1.f / DM) + EPS);
        f32x4 acc[5];
#pragma unroll
        for (int cb = 0; cb < 5; ++cb) acc[cb] = (f32x4){0.f, 0.f, 0.f, 0.f};
#pragma unroll 2
        for (int ks = 0; ks < 64; ++ks) {
            const f32x4 a = *(const f32x4*)(hrow + 32 * ks), b = *(const f32x4*)(hrow + 32 * ks + 4);
            const f32x4 ga = *(const f32x4*)(F.g2 + 32 * ks + 8 * kq), gb = *(const f32x4*)(F.g2 + 32 * ks + 8 * kq + 4);
            float u[8] = {a.x * rstd * ga.x, a.y * rstd * ga.y, a.z * rstd * ga.z, a.w * rstd * ga.w, b.x * rstd * gb.x, b.y * rstd * gb.y, b.z * rstd * gb.z, b.w * rstd * gb.w};
            unsigned hb[4], lb[4];
#pragma unroll
            for (int q = 0; q < 4; ++q) { hb[q] = cvtpk(u[2 * q], u[2 * q + 1]); lb[q] = cvtpk(u[2 * q] - __uint_as_float(hb[q] << 16), u[2 * q + 1] - __uint_as_float(hb[q] & 0xffff0000u)); }
            v4u hv = {hb[0], hb[1], hb[2], hb[3]}, lv = {lb[0], lb[1], lb[2], lb[3]};
            *(v4u*)(U2 + (size_t)(row0 + i) * DM + 32 * ks + 8 * kq) = hv;
            const bf16x8 Ah = *reinterpret_cast<bf16x8*>(&hv), Al = *reinterpret_cast<bf16x8*>(&lv);
#pragma unroll
            for (int cb = 0; cb < 5; ++cb) { v4u bh = RB[(size_t)((ks * 5 + cb) * 2 + 0) * 64 + F.lane], bl = RB[(size_t)((ks * 5 + cb) * 2 + 1) * 64 + F.lane];
                const bf16x8 Bh = *reinterpret_cast<bf16x8*>(&bh), Bl = *reinterpret_cast<bf16x8*>(&bl);
                acc[cb] = __builtin_amdgcn_mfma_f32_16x16x32_bf16(Ah, Bh, acc[cb], 0, 0, 0);
                acc[cb] = __builtin_amdgcn_mfma_f32_16x16x32_bf16(Ah, Bl, acc[cb], 0, 0, 0);
                acc[cb] = __builtin_amdgcn_mfma_f32_16x16x32_bf16(Al, Bh, acc[cb], 0, 0, 0); }
        }
#pragma unroll
        for (int cb = 0; cb < 5; ++cb)
#pragma unroll
            for (int j = 0; j < 4; ++j) lg[(4 * kq + j) * 88 + 16 * cb + i] = acc[cb][j];
        LDS_WAIT(); asm volatile("" ::: "memory");
        if (F.lane < 16) { const LAS float* L = lg + F.lane * 88; const int row = row0 + F.lane;
            float cmax = L[0] + F.b_coarse[0]; int gs = 0; float cv[8]; cv[0] = cmax;
#pragma unroll
            for (int g = 1; g < 8; ++g) { cv[g] = L[g] + F.b_coarse[g]; if (cv[g] > cmax) { cmax = cv[g]; gs = g; } }
            float den = 0.f;
#pragma unroll
            for (int g = 0; g < 8; ++g) den += expf(cv[g] - cmax);
            const float ggate = 1.0f / den;
            float f1 = -__builtin_inff(), f2 = -__builtin_inff(); int i1 = 0, i2 = 0;
#pragma unroll
            for (int jx = 0; jx < 8; ++jx) { const float fv = L[8 + gs * 8 + jx] + F.b_fine[gs * 8 + jx];
                if (fv > f1) { f2 = f1; i2 = i1; f1 = fv; i1 = jx; } else if (fv > f2) { f2 = fv; i2 = jx; } }
            const float e2 = expf(f2 - f1), w1 = ggate / (1.f + e2), w2 = ggate * e2 / (1.f + e2);
            const int ea = gs * 8 + i1, eb = gs * 8 + i2;
            const int pa = (int)__hip_atomic_fetch_add(F.ctl + CW_CNT + 64 * ea, 1u, RLX_AGENT), pb = (int)__hip_atomic_fetch_add(F.ctl + CW_CNT + 64 * eb, 1u, RLX_AGENT);
            TOK[(size_t)ea * TOKLD + pa] = row * 2; TOK[(size_t)eb * TOKLD + pb] = row * 2 + 1;
            RE[row * 2] = ea; RE[row * 2 + 1] = eb; RP[row * 2] = pa; RP[row * 2 + 1] = pb; RW[row * 2] = w1; RW[row * 2 + 1] = w2; }
        LDS_WAIT(); asm volatile("" ::: "memory");
    }
}

__device__ __forceinline__ void moe_prefix(Frame& F, int ncs) {
    LAS int* upre = (LAS int*)(F.lds + TPRE_OFF); LAS int* cpre = upre + 80;
    if (F.tid < 64) { const int c = (int)__hip_atomic_load(F.ctl + CW_CNT + 64 * F.tid, RLX_AGENT); int u = ((c + 383) / 384) * ncs, v = c;
#pragma unroll
        for (int o = 1; o < 64; o <<= 1) { const int y = __shfl_up(u, o), z = __shfl_up(v, o); if (F.lane >= o) { u += y; v += z; } }
        upre[F.tid + 1] = u; cpre[F.tid + 1] = v; if (F.tid == 0) { upre[0] = 0; cpre[0] = 0; } }
    __syncthreads();
}

__device__ __forceinline__ void p8_combine(Frame& F) {
    const LAS int* cpre = (const LAS int*)(F.lds + TPRE_OFF) + 80;
    const int* RE = (const int*)(F.ws + WS_ROUTE); const int* RP = RE + TF * 2; const bf16* Y = (const bf16*)(F.ws + WS_Y);
    for (int m = F.vcu * 8 + F.wave; m < TF; m += F.G * 8) {
        const int e0 = RE[m * 2], e1 = RE[m * 2 + 1], p0 = RP[m * 2], p1 = RP[m * 2 + 1];
        const size_t s0 = (size_t)(cpre[e0] + p0), s1 = (size_t)(cpre[e1] + p1);
        GAS f32x4* op = (GAS f32x4*)(F.out + (size_t)m * DM) + 2 * F.lane;
        const GAS v4u* y0 = (const GAS v4u*)(Y + s0 * DM) + F.lane; const GAS v4u* y1 = (const GAS v4u*)(Y + s1 * DM) + F.lane;
#pragma unroll
        for (int j = 0; j < 4; ++j) { f32x4 a = op[128 * j], b = op[128 * j + 1]; const v4u u0 = y0[64 * j], u1 = y1[64 * j];
            a.x += __uint_as_float(u0.x << 16) + __uint_as_float(u1.x << 16); a.y += __uint_as_float(u0.x & 0xffff0000u) + __uint_as_float(u1.x & 0xffff0000u);
            a.z += __uint_as_float(u0.y << 16) + __uint_as_float(u1.y << 16); a.w += __uint_as_float(u0.y & 0xffff0000u) + __uint_as_float(u1.y & 0xffff0000u);
            b.x += __uint_as_float(u0.z << 16) + __uint_as_float(u1.z << 16); b.y += __uint_as_float(u0.z & 0xffff0000u) + __uint_as_float(u1.z & 0xffff0000u);
            b.z += __uint_as_float(u0.w << 16) + __uint_as_float(u1.w << 16); b.w += __uint_as_float(u0.w & 0xffff0000u) + __uint_as_float(u1.w & 0xffff0000u);
            op[128 * j] = a; op[128 * j + 1] = b; }
    }
}

#define XB_TMO      128
#define XB_XCNT(j)  (256  + 64 * (j))
#define XB_XSUB(j)  (1280 + 64 * (j))
#define XB_XGEN(j)  (2304 + 64 * (j))
#define XB_TOP      3328
#define XB_TOPGEN   3392
#define XCD_BAR_WORDS 3456
#define XB_SPIN_CAP (1u << 18)

__device__ __forceinline__ unsigned xb_ld(unsigned* p)              { return __hip_atomic_load(p, __ATOMIC_RELAXED, __HIP_MEMORY_SCOPE_AGENT); }
__device__ __forceinline__ unsigned xb_add(unsigned* p, unsigned v) { return __hip_atomic_fetch_add(p, v, __ATOMIC_RELAXED, __HIP_MEMORY_SCOPE_AGENT); }
__device__ __forceinline__ unsigned xb_xcc_id() { return (unsigned)__builtin_amdgcn_s_getreg((3 << 11) | 20) & 0xFu; }
#define XB_SPIN(cond, bar) do { unsigned _sp = 0; while (cond) { __builtin_amdgcn_s_sleep(1); \
    if ((++_sp & 255u) == 0u) { if (xb_ld(&(bar)[XB_TMO])) break; if (_sp > XB_SPIN_CAP) { atomicAdd(&(bar)[XB_TMO], 1u); break; } } } } while (0)

struct XcdBarrier {
    unsigned* bar; unsigned x;
    volatile LAS unsigned* st;
};

__device__ __forceinline__ XcdBarrier xcd_barrier_post(unsigned* bar, volatile LAS unsigned* st) {
    XcdBarrier b; b.bar = bar; b.x = xb_xcc_id(); b.st = st;
    if (threadIdx.x == 0) (void)xb_add(&bar[XB_XCNT(b.x)], 1u);
    return b;
}
__device__ __forceinline__ void xcd_barrier_complete(unsigned* bar, unsigned x, unsigned& nloc, unsigned& nx) {
    const unsigned G = gridDim.x * gridDim.y * gridDim.z;
    unsigned sum, cnt, mine, sp = 0u;
    for (;;) {
        sum = 0u; cnt = 0u; mine = 0u;
#pragma unroll
        for (unsigned j = 0; j < 16; ++j) { const unsigned c = xb_ld(&bar[XB_XCNT(j)]); sum += c; cnt += (c > 0u) ? 1u : 0u; mine = (j == x) ? c : mine; }
        if (sum == G) break;
        __builtin_amdgcn_s_sleep(1);
        if ((++sp & 255u) == 0u) { if (xb_ld(&bar[XB_TMO])) break; if (sp > XB_SPIN_CAP) { atomicAdd(&bar[XB_TMO], 1u); break; } }
    }
    nloc = mine > 0u ? mine : 1u; nx = cnt > 0u ? cnt : 1u;
}

__device__ __forceinline__ void xcd_barrier(const XcdBarrier& b) {
    asm volatile("s_waitcnt vmcnt(0)" ::: "memory");
    __syncthreads();
    if (threadIdx.x == 0) {
        unsigned* bar = b.bar;
        __builtin_amdgcn_s_waitcnt(0);
        unsigned nloc = b.st[0], nx = b.st[1];
        if (nloc == 0u) { xcd_barrier_complete(bar, b.x, nloc, nx); b.st[0] = nloc; b.st[1] = nx; }
        const unsigned old = xb_add(&bar[XB_XSUB(b.x)], 1u);
        const unsigned gen = old / nloc;
        if (old + 1u == (gen + 1u) * nloc) {
            __builtin_amdgcn_fence(__ATOMIC_RELEASE, "agent");
            asm volatile("s_waitcnt vmcnt(0)" ::: "memory");
            const unsigned og = xb_add(&bar[XB_TOP], 1u);
            const unsigned tg = og / nx;
            if (og + 1u == (tg + 1u) * nx) xb_add(&bar[XB_TOPGEN], 1u);
            else XB_SPIN(xb_ld(&bar[XB_TOPGEN]) == tg, bar);
            __builtin_amdgcn_fence(__ATOMIC_ACQUIRE, "agent");
            xb_add(&bar[XB_XGEN(b.x)], 1u);
            asm volatile("s_waitcnt vmcnt(0)" ::: "memory");
        } else {
            XB_SPIN(xb_ld(&bar[XB_XGEN(b.x)]) == gen, bar);
            __builtin_amdgcn_fence(__ATOMIC_ACQUIRE, "agent");
            asm volatile("s_waitcnt vmcnt(0)" ::: "memory");
        }
    }
    __syncthreads();
}

struct Args { const float* in[18]; float* out; unsigned char* ws; int ph_lo, ph_hi; };
__global__ void __launch_bounds__(512, 2) fwd(Args args) {
    extern __shared__ __attribute__((aligned(16))) unsigned char lds[];
    Frame F;
    F.lds = (LAS unsigned char*)lds; F.ldsg = (char*)lds;
    F.MISC = (volatile LAS unsigned*)(F.lds + MISC_OFF);
    F.tid = threadIdx.x; F.lane = F.tid & 63; F.wave = __builtin_amdgcn_readfirstlane(F.tid >> 6);
    F.G = gridDim.x; { const int bx = blockIdx.x; F.vcu = (F.G % 8 == 0) ? (bx % 8) * (F.G / 8) + bx / 8 : bx; }
    F.ws = args.ws; F.ctl = (gu32*)(args.ws + WS_CTL); F.out = args.out;
    F.x = args.in[0]; F.meta = args.in[1]; F.g1 = args.in[2]; F.w_in = args.in[3]; F.b_f = args.in[4]; F.q_gain = args.in[5]; F.k_gain = args.in[6];
    F.fox_gain = args.in[7]; F.sb_gain = args.in[8]; F.w_out = args.in[9]; F.g2 = args.in[10]; F.w_coarse = args.in[11]; F.b_coarse = args.in[12];
    F.w_fine = args.in[13]; F.b_fine = args.in[14]; F.w1 = args.in[15]; F.w3 = args.in[16]; F.w2 = args.in[17];
    for (int u = F.tid; u < 32; u += 512) F.MISC[u] = 0u;
    __syncthreads();
    const int lo = args.ph_lo, hi = args.ph_hi;
    XcdBarrier bar; bar.bar = (unsigned*)(F.ctl + CW_BAR); bar.x = 0; bar.st = nullptr;
    if (hi - lo > 1) bar = xcd_barrier_post((unsigned*)(F.ctl + CW_BAR), F.MISC + 8);
#define IN(k) (lo <= (k) && (k) < hi)
#define SEAM(k) do { if (IN(k) && IN((k) + 1)) xcd_barrier(bar); } while (0)
    bf16* PROJ = (bf16*)(F.ws + WS_PROJ);

    if (IN(0)) { p0_prologue(F); if (REP_PHASE == 0) { __syncthreads(); p0_prologue(F); } SEAM(0); }

    if (IN(1)) {
        pg8::DenseOrder S; S.init(F.ws + WS_U1, F.ws + WS_WIN_T, MROWS, NPROJ, DM, F.G, (int)blockIdx.x);
        pg8::EpiProj E{PROJ, (float*)(F.ws + WS_SS)};
        pg8::gemm_phase<pg8::EpiProj, pg8::DenseOrder, false>(F.lds, DM, S, E, nullptr);
        if (REP_PHASE == 1) pg8::gemm_phase<pg8::EpiProj, pg8::DenseOrder, false>(F.lds, DM, S, E, nullptr);
        SEAM(1);
    }
    if (IN(2)) { p2_norms(F); SEAM(2); }

    if (IN(3)) {
        att::Tensors T{PROJ, PROJ + PROJ_TS, PROJ + 2 * PROJ_TS, PROJ + 3 * PROJ_TS, PROJ + 4 * PROJ_TS, PROJ + 5 * PROJ_TS, PROJ + 6 * PROJ_TS,
                       (const float*)(F.ws + WS_RK), (const float*)(F.ws + WS_MT), (const float*)(F.ws + WS_CUM), F.fox_gain, F.sb_gain, (bf16*)(F.ws + WS_MIX)};
        for (int rep = 0; rep < (REP_PHASE == 3 ? 2 : 1); ++rep)
        for (int w = F.vcu; w < 256; w += F.G) { const int bh = w >> 3, s = w & 7;
#ifndef NO_FOX
            att::attn_unit<0>(F.ldsg, T, bh >> 3, bh & 7, s);
#endif
#ifndef NO_SB
            att::attn_unit<1>(F.ldsg, T, bh >> 3, bh & 7, 7 - s);
#endif
        }
        __syncthreads();
        SEAM(3);
    }
    if (IN(4)) {
        pg8::DenseOrder S; S.init(F.ws + WS_MIX, F.ws + WS_WOUT_T, TF, DM, DM, F.G, (int)blockIdx.x);
        pg8::EpiOut E{F.x, F.out};
        pg8::gemm_phase<pg8::EpiOut, pg8::DenseOrder, false>(F.lds, DM, S, E, nullptr);
        if (REP_PHASE == 4) pg8::gemm_phase<pg8::EpiOut, pg8::DenseOrder, false>(F.lds, DM, S, E, nullptr);
        SEAM(4);
    }
    if (IN(5)) { p5_router(F); SEAM(5); }

    if (IN(6)) {
        moe_prefix(F, 8);
        const LAS int* upre = (const LAS int*)(F.lds + TPRE_OFF);
        moe::Order S{F.G, (int)blockIdx.x, 8, upre, upre + 80};
        LAS int* tab = (LAS int*)(F.lds + TAB_OFF); const int* TOK = (const int*)(F.ws + WS_TOK);
        for (int i = 0; i < 8; ++i) { int e, cs, mt, cnt, cbase; if (!S.decode(i, e, cs, mt, cnt, cbase)) break;
            if (F.tid < 384) { const int p = mt * 384 + F.tid; tab[i * 384 + F.tid] = p < cnt ? (TOK[(size_t)e * TOKLD + p] >> 1) : TF; } }
        __syncthreads();
        for (int rep = 0; rep < (REP_PHASE == 6 ? 2 : 1); ++rep)
        moe::phase<DM, true>(F.lds, S, tab, (const char*)(F.ws + WS_U2), F.w1, F.w3, (bf16*)(F.ws + WS_HID));
        SEAM(6);
    }
    if (IN(7)) {
        moe_prefix(F, 16);
        const LAS int* upre = (const LAS int*)(F.lds + TPRE_OFF);
        moe::Order S{F.G, (int)blockIdx.x, 16, upre, upre + 80};
        LAS float* wtab = (LAS float*)(F.lds + TAB_OFF); const int* TOK = (const int*)(F.ws + WS_TOK); const float* RW = (const float*)(F.ws + WS_ROUTE) + TF * 4;
        for (int i = 0; i < 8; ++i) { int e, cs, mt, cnt, cbase; if (!S.decode(i, e, cs, mt, cnt, cbase)) break;
            if (F.tid < 384) { const int p = mt * 384 + F.tid; wtab[i * 384 + F.tid] = p < cnt ? RW[TOK[(size_t)e * TOKLD + p]] : 0.f; } }
        __syncthreads();
        for (int rep = 0; rep < (REP_PHASE == 7 ? 2 : 1); ++rep)
        moe::phase<DE, false>(F.lds, S, (const LAS int*)wtab, (const char*)(F.ws + WS_HID), F.w2, nullptr, (bf16*)(F.ws + WS_Y));
        SEAM(7);
    }
    if (IN(8)) { moe_prefix(F, 16); p8_combine(F); }
#undef IN
#undef SEAM
}

extern "C" void kernel_launch(void* const* d_in, const int* in_sizes, int n_in, void* d_out, int out_size, void* d_ws, size_t ws_size, hipStream_t stream) {
    static int grid = 0;
    if (grid == 0) {
        if (n_in != 18 || out_size != TF * DM || ws_size < WS_END) { fprintf(stderr, "kernel_launch: unexpected shapes (n_in %d, out %d, ws %zu); nothing launched\n", n_in, out_size, ws_size); grid = -1; return; }
        int dev = 0, cus = 0, per_cu = 0;
        if (hipGetDevice(&dev) != hipSuccess || hipDeviceGetAttribute(&cus, hipDeviceAttributeMultiprocessorCount, dev) != hipSuccess) { grid = -1; return; }
        if (hipFuncSetAttribute((const void*)fwd, hipFuncAttributeMaxDynamicSharedMemorySize, LDS_BYTES) != hipSuccess) { fprintf(stderr, "kernel_launch: hipFuncSetAttribute failed\n"); grid = -1; return; }
        if (hipOccupancyMaxActiveBlocksPerMultiprocessor(&per_cu, (const void*)fwd, 512, LDS_BYTES) != hipSuccess || per_cu < 1) fprintf(stderr, "kernel_launch: occupancy query reports %d\n", per_cu);
        (void)hipGetLastError();
        grid = cus > 0 ? cus : 256;
    }
    if (grid < 0) return;
    (void)hipMemsetAsync((char*)d_ws + WS_CTL, 0, CTL_ZERO_BYTES, stream);
    Args a{};
    for (int i = 0; i < 18; ++i) a.in[i] = (const float*)d_in[i];
    a.out = (float*)d_out; a.ws = (unsigned char*)d_ws;
    constexpr int NL = MK_N_LAUNCHES;
    for (int li = 0; li < NL; ++li) {
        a.ph_lo = (NL == 1) ? 0 : li; a.ph_hi = (NL == 1) ? NPHASE : li + 1;
        hipLaunchKernelGGL(fwd, dim3(grid), dim3(512), LDS_BYTES, stream, a);
    }
}
```

```cpp
#include <hip/hip_runtime.h>
#include <hip/hip_bf16.h>
#include <cstdio>
#include <cstdint>

#ifndef REP_PHASE
#define REP_PHASE -1
#endif
#ifndef MK_N_LAUNCHES
#define MK_N_LAUNCHES 1
#endif

constexpr int DM = 2048, NB = 4, SEQ = 2048, NMETA = 16, HD = 128, NH = 8;
constexpr int TF = NB * SEQ;
constexpr int ROW_META = TF;
constexpr int NKEYROWS = TF + NMETA;
constexpr int MROWS = 8448;
constexpr int NPROJ = 7168, LDW_IN = 7176;
constexpr int NE = 64, DE = 512;
constexpr int LPOS = SEQ + NMETA;
constexpr int CUMLD = 2112;
constexpr float EPS = 1e-6f;
constexpr float LOG2E = 1.4426950408889634f;
constexpr float QSCALE2 = 0.08838834764831845f * 1.4426950408889634f;
constexpr int NPHASE = 9;

constexpr size_t MiB = 1u << 20;
constexpr size_t WS_CTL = 0, CTL_ZERO_BYTES = 1 * MiB;
constexpr size_t WS_WIN_T = 2 * MiB;
constexpr size_t WS_WOUT_T = 30 * MiB;
constexpr size_t WS_U1 = 38 * MiB;
constexpr size_t WS_PROJ = 72 * MiB;
constexpr size_t PROJ_TS = (size_t)MROWS * 1024;
constexpr size_t WS_F = 188 * MiB;
constexpr size_t WS_CUM = 189 * MiB;
constexpr size_t WS_SS = 190 * MiB;
constexpr size_t WS_RK = 194 * MiB;
constexpr size_t WS_MT = 195 * MiB;
constexpr size_t WS_MIX = 196 * MiB;
constexpr size_t WS_U2 = 228 * MiB;
constexpr size_t WS_ROUTE = 262 * MiB;
constexpr size_t WS_TOK = 263 * MiB;
constexpr int TOKLD = 16512;
constexpr size_t WS_RB = 268 * MiB;
constexpr int NASSIGN = TF * 2;
constexpr size_t WS_HID = 272 * MiB;
constexpr size_t WS_Y = 292 * MiB;
constexpr size_t WS_END = 360 * MiB;
constexpr int CW_TMO = 0;
constexpr int CW_CNT = 1024;
constexpr int CW_BAR = 8192;

constexpr int RING_BYTES = 139264;
constexpr int TAB_OFF = RING_BYTES, TAB_BYTES = 8 * 384 * 4;
constexpr int TPRE_OFF = TAB_OFF + TAB_BYTES;
constexpr int MISC_OFF = TPRE_OFF + 1024;
constexpr int LDS_BYTES = MISC_OFF + 128;

#define GAS __attribute__((address_space(1)))
#define LAS __attribute__((address_space(3)))
typedef unsigned short bf16;
typedef unsigned v4u __attribute__((ext_vector_type(4)));
typedef unsigned v2u __attribute__((ext_vector_type(2)));
typedef float f32x4 __attribute__((ext_vector_type(4)));
typedef float f32x2 __attribute__((ext_vector_type(2)));
typedef float f32x16 __attribute__((ext_vector_type(16)));
typedef short bf16x8 __attribute__((ext_vector_type(8)));
typedef short s16x4 __attribute__((ext_vector_type(4)));
typedef GAS unsigned gu32;
#define RLX_AGENT __ATOMIC_RELAXED, __HIP_MEMORY_SCOPE_AGENT
#define LDS_WAIT() asm volatile("s_waitcnt lgkmcnt(0)" ::: "memory")
#define VM_WAIT() asm volatile("s_waitcnt vmcnt(0)" ::: "memory")
__device__ __forceinline__ unsigned cvtpk(float lo, float hi) { unsigned r; asm volatile("v_cvt_pk_bf16_f32 %0, %1, %2" : "=v"(r) : "v"(lo), "v"(hi)); return r; }
__device__ __forceinline__ float bf2f(unsigned short h) { return __uint_as_float(((unsigned)h) << 16); }
__device__ __forceinline__ float wave_sum(float v) {
#pragma unroll
    for (int o = 1; o < 64; o <<= 1) v += __shfl_xor(v, o);
    return v;
}
__device__ __forceinline__ int opaque_tid() { int t = threadIdx.x; asm volatile("" : "+v"(t)); return t; }
__device__ __forceinline__ float fast_exp2(float x) { return __builtin_amdgcn_exp2f(x); }
__device__ __forceinline__ float fast_log2(float x) { return __builtin_amdgcn_logf(x); }
__device__ __forceinline__ float fast_rcp(float x) { return __builtin_amdgcn_rcpf(x); }

namespace pg8 {
#define PG8_LAS __attribute__((address_space(3)))
typedef unsigned short bf16_t;
typedef unsigned u32x4 __attribute__((ext_vector_type(4)));
constexpr int BM = 256, BK = 64, HALF = 128, HTB = HALF * BK * 2, STAGE_BYTES = 8 * HTB, NXCD = 8, WGM = 8;
__host__ __device__ __forceinline__ int lds_byte(int r, int c) { const int st = (r >> 4) * 2 + (c >> 5), rr = r & 15, cc = c & 31, ob = rr * 64 + cc * 2; return st * 1024 + (ob ^ (((ob >> 9) & 1) << 5)); }
__host__ __device__ __forceinline__ void stage_rc(int b, int& R, int& C) { const int st = b / 1024, sb = b % 1024, swz = sb ^ (((sb >> 9) & 1) << 5); R = (st >> 1) * 16 + swz / 64; C = (st & 1) * 32 + (swz % 64) / 2; }
__host__ __device__ __forceinline__ int perm32(int rho) { const int n = rho >> 4, i = rho & 15; return 8 * (i >> 2) + 4 * n + (i & 3); }

struct Unit { int pm, pn, li; const char* A; const char* B; };

struct DenseOrder {
    int nM, nN, nwg, G, c; const char* A; const char* B; size_t tstep;
    __device__ void init(const void* A_, const void* B_, int M, int N, int K, int G_, int c_) { nM = M / BM; nN = N / BM; nwg = nM * nN; G = G_; c = c_; A = (const char*)A_; B = (const char*)B_; tstep = (size_t)BM * K * 2; }
    __device__ bool next(int i, Unit& u) const {
        const long L = (long)i * G + c; if (L >= nwg) return false;
        int wgid = (int)L; { const int q = nwg / NXCD, r = nwg % NXCD, xcd = wgid % NXCD, off = wgid / NXCD; wgid = (xcd < r ? xcd * (q + 1) : r * (q + 1) + (xcd - r) * q) + off; }
        const int nig = WGM * nN, gid = wgid / nig, fm = gid * WGM, gsz = (nM - fm) < WGM ? (nM - fm) : WGM;
        u.pm = fm + ((wgid % nig) % gsz); u.pn = (wgid % nig) / gsz; u.li = 0;
        u.A = A + (size_t)u.pm * tstep; u.B = B + (size_t)u.pn * tstep; return true;
    }
};

template <class Epi, class Sched, bool GATHER>
__device__ __forceinline__ void gemm_phase(PG8_LAS unsigned char* lds, const int K, const Sched& S, const Epi& E, const PG8_LAS int* tab) {
    const int tid = opaque_tid(), wid = __builtin_amdgcn_readfirstlane(tid >> 6), lane = tid & 63, wr = wid >> 2, wc = wid & 3, fr = lane & 15, fq = lane >> 4;
    const int nt = K / BK;
    unsigned voffA[2], voffB[2]; int RA[2], CA[2];
#pragma unroll
    for (int i = 0; i < 2; ++i) { int R, C; stage_rc(tid * 16 + i * 8192, R, C); const int Rb = Epi::PERM ? ((R & ~31) + perm32(R & 31)) : R;
        voffA[i] = (unsigned)(R * K + C) * 2u; voffB[i] = (unsigned)(Rb * K + C) * 2u; RA[i] = R; CA[i] = C; }
    const size_t kstep = (size_t)(BK * 2);
    const size_t hstep = (size_t)HALF * K * 2;
    const unsigned ldsw = (unsigned)wid * 1024u;
    const int aoff = lds_byte(wr * 64 + fr, fq * 8), boff = lds_byte(wc * 32 + fr, fq * 8);
    unsigned gA[2][2], gAn[2][2];
#define PG8_SA(b, h) (((b) * 2 + (h)) * HTB)
#define PG8_SB(b, h) ((4 + (b) * 2 + (h)) * HTB)
#define PG8_GL(gptr, ldsoff) __builtin_amdgcn_global_load_lds((const unsigned*)(gptr), (PG8_LAS unsigned*)(lds + (ldsoff)), 16, 0, 0)
#define PG8_STAGE_B(bufoff, gbase) do { _Pragma("unroll") for (int _i = 0; _i < 2; ++_i) PG8_GL((const char*)(gbase) + voffB[_i], (bufoff) + ldsw + _i * 8192); } while (0)
#define PG8_STAGE_A(bufoff, gbase, h, NX) do { _Pragma("unroll") for (int _i = 0; _i < 2; ++_i) { \
        if constexpr (GATHER) { const unsigned _vo = (NX) ? gAn[h][_i] : gA[h][_i]; PG8_GL((const char*)(gbase) + _vo, (bufoff) + ldsw + _i * 8192); } \
        else { PG8_GL((const char*)(gbase) + (size_t)(h) * hstep + voffA[_i], (bufoff) + ldsw + _i * 8192); } } } while (0)
#define PG8_GIDX(dst, li) do { if constexpr (GATHER) { _Pragma("unroll") for (int _h = 0; _h < 2; ++_h) _Pragma("unroll") for (int _i = 0; _i < 2; ++_i) \
        dst[_h][_i] = ((unsigned)tab[(li) * 256 + _h * 128 + RA[_i]] * (unsigned)K + (unsigned)CA[_i]) * 2u; } } while (0)
#define PG8_LDA(dst, b, h) do { _Pragma("unroll") for (int m = 0; m < 4; ++m) _Pragma("unroll") for (int k = 0; k < 2; ++k) dst[m][k] = *(const PG8_LAS bf16x8*)(lds + PG8_SA(b, h) + aoff + m * 2048 + k * 1024); } while (0)
#define PG8_LDB(dst, b, h) do { _Pragma("unroll") for (int n = 0; n < 2; ++n) _Pragma("unroll") for (int k = 0; k < 2; ++k) dst[n][k] = *(const PG8_LAS bf16x8*)(lds + PG8_SB(b, h) + boff + n * 2048 + k * 1024); } while (0)
#define PG8_MMA(ai, bj, At, Bt) do { __builtin_amdgcn_s_setprio(1); _Pragma("unroll") for (int m = 0; m < 4; ++m) _Pragma("unroll") for (int n = 0; n < 2; ++n) _Pragma("unroll") for (int k = 0; k < 2; ++k) \
        acc[ai][bj][m][n] = __builtin_amdgcn_mfma_f32_16x16x32_bf16(Bt[n][k], At[m][k], acc[ai][bj][m][n], 0, 0, 0); __builtin_amdgcn_s_setprio(0); } while (0)
#define PG8_WAIT_V(n) asm volatile("s_waitcnt vmcnt(" #n ")" ::: "memory")
#define PG8_WAIT_L(n) asm volatile("s_waitcnt lgkmcnt(" #n ")" ::: "memory")
#define PG8_BAR __builtin_amdgcn_s_barrier()
#define PG8_SCHED __builtin_amdgcn_sched_barrier(0)
    Unit cur, nxt; int ui = 0;
    if (!S.next(0, cur)) return;
    f32x4 acc[2][2][4][2];
#pragma unroll
    for (int a = 0; a < 2; ++a)
#pragma unroll
        for (int b = 0; b < 2; ++b)
#pragma unroll
            for (int m = 0; m < 4; ++m)
#pragma unroll
                for (int n = 0; n < 2; ++n) acc[a][b][m][n] = (f32x4){0.f, 0.f, 0.f, 0.f};
    bf16x8 At[4][2], B0[2][2], B1[2][2];
    const char* cA = cur.A; const char* cB = cur.B;
    PG8_GIDX(gA, cur.li);
    PG8_STAGE_B(PG8_SB(0, 0), cB); PG8_STAGE_B(PG8_SB(0, 1), cB + hstep); PG8_STAGE_A(PG8_SA(0, 0), cA, 0, false); PG8_STAGE_A(PG8_SA(0, 1), cA, 1, false);
    if (wr == 1) PG8_BAR;
    PG8_WAIT_V(2); PG8_BAR;
    PG8_STAGE_B(PG8_SB(1, 0), cB + kstep); PG8_STAGE_A(PG8_SA(1, 0), cA + kstep, 0, false); PG8_STAGE_B(PG8_SB(1, 1), cB + hstep + kstep);
    PG8_WAIT_V(6); PG8_BAR;
    for (;;) {
        const bool has_next = S.next(ui + 1, nxt);
        const char* nA = has_next ? nxt.A : cA; const char* nB = has_next ? nxt.B : cB;
        if constexpr (GATHER) { if (has_next) { PG8_GIDX(gAn, nxt.li); } else {
#pragma unroll
            for (int _h = 0; _h < 2; ++_h)
#pragma unroll
                for (int _i = 0; _i < 2; ++_i) gAn[_h][_i] = gA[_h][_i]; } }
        for (int t = 0; t < nt; t += 2) {
            const bool last = (t == nt - 2);
            const char* a1 = cA + (size_t)(t + 1) * kstep;
            const char* a2 = last ? nA : cA + (size_t)(t + 2) * kstep; const char* b2 = last ? nB : cB + (size_t)(t + 2) * kstep;
            const char* a3 = a2 + kstep; const char* b3 = b2 + kstep;
            PG8_LDB(B0, 0, 0); PG8_LDB(B1, 0, 1); PG8_SCHED; PG8_LDA(At, 0, 0); PG8_STAGE_A(PG8_SA(1, 1), a1, 1, false);
            PG8_WAIT_V(8); PG8_WAIT_L(0); PG8_BAR; PG8_MMA(0, 0, At, B0); PG8_MMA(0, 1, At, B1); PG8_BAR; PG8_SCHED;
            PG8_LDA(At, 0, 1); PG8_STAGE_B(PG8_SB(0, 0), b2); PG8_STAGE_B(PG8_SB(0, 1), b2 + hstep); PG8_STAGE_A(PG8_SA(0, 0), a2, 0, last);
            PG8_WAIT_V(8); PG8_WAIT_L(0); PG8_BAR; PG8_MMA(1, 0, At, B0); PG8_MMA(1, 1, At, B1); PG8_BAR; PG8_SCHED;
            PG8_LDB(B0, 1, 0); PG8_LDB(B1, 1, 1); PG8_SCHED; PG8_LDA(At, 1, 0); PG8_STAGE_A(PG8_SA(0, 1), a2, 1, last);
            PG8_WAIT_V(8); PG8_WAIT_L(0); PG8_BAR; PG8_MMA(0, 0, At, B0); PG8_MMA(0, 1, At, B1); PG8_BAR; PG8_SCHED;
            PG8_LDA(At, 1, 1); PG8_STAGE_B(PG8_SB(1, 0), b3); PG8_STAGE_B(PG8_SB(1, 1), b3 + hstep); PG8_STAGE_A(PG8_SA(1, 0), a3, 0, last);
            PG8_WAIT_V(8); PG8_WAIT_L(0); PG8_BAR; PG8_MMA(1, 0, At, B0); PG8_MMA(1, 1, At, B1); PG8_BAR; PG8_SCHED;
        }
        if (wr == 0) PG8_BAR;
        E(acc, cur, wr, wc, fr, fq);
        if (!has_next) break;
#pragma unroll
        for (int a = 0; a < 2; ++a)
#pragma unroll
            for (int b = 0; b < 2; ++b)
#pragma unroll
                for (int m = 0; m < 4; ++m)
#pragma unroll
                    for (int n = 0; n < 2; ++n) acc[a][b][m][n] = (f32x4){0.f, 0.f, 0.f, 0.f};
        cur = nxt; cA = nA; cB = nB; ++ui;
        if constexpr (GATHER) {
#pragma unroll
            for (int _h = 0; _h < 2; ++_h)
#pragma unroll
                for (int _i = 0; _i < 2; ++_i) gA[_h][_i] = gAn[_h][_i]; }
        if (wr == 1) PG8_BAR;
    }
    PG8_WAIT_V(0);
    PG8_BAR;
#undef PG8_SA
#undef PG8_SB
#undef PG8_GL
#undef PG8_STAGE_A
#undef PG8_STAGE_B
#undef PG8_GIDX
#undef PG8_LDA
#undef PG8_LDB
#undef PG8_MMA
#undef PG8_WAIT_V
#undef PG8_WAIT_L
#undef PG8_BAR
#undef PG8_SCHED
}

struct EpiProj {
    static constexpr bool PERM = true;
    bf16_t* P; float* SS;
    __device__ __forceinline__ void operator()(const f32x4 (&acc)[2][2][4][2], const Unit& u, int wr, int wc, int fr, int fq) const {
        const int t = u.pn >> 2, colt = (u.pn & 3) * BM;
        bf16_t* base = P + (size_t)t * PROJ_TS;
        const int row0 = u.pm * BM + wr * 64 + fr, col0 = colt + wc * 32 + 8 * fq;
        if (t <= 1) {
#pragma unroll
            for (int ai = 0; ai < 2; ++ai)
#pragma unroll
                for (int m = 0; m < 4; ++m)
#pragma unroll
                    for (int bj = 0; bj < 2; ++bj) {
                        const f32x4 a = acc[ai][bj][m][0], b = acc[ai][bj][m][1];
                        float s = (a[0] * a[0] + a[1] * a[1]) + (a[2] * a[2] + a[3] * a[3]) + (b[0] * b[0] + b[1] * b[1]) + (b[2] * b[2] + b[3] * b[3]);
                        s += __shfl_xor(s, 16); s += __shfl_xor(s, 32);
                        if (fq == 0) SS[(((size_t)t * MROWS + (row0 + ai * HALF + m * 16)) * 8 + ((u.pn & 3) * 2 + bj)) * 4 + wc] = s;
                    }
        }
#pragma unroll
        for (int ai = 0; ai < 2; ++ai)
#pragma unroll
            for (int m = 0; m < 4; ++m) { bf16_t* rowp = base + (size_t)(row0 + ai * HALF + m * 16) * 1024 + col0;
#pragma unroll
                for (int bj = 0; bj < 2; ++bj) { f32x4 v0 = acc[ai][bj][m][0], v1 = acc[ai][bj][m][1];
                    if (t == 3) {
#pragma unroll
                        for (int j = 0; j < 4; ++j) { v0[j] = fast_rcp(1.f + fast_exp2(-v0[j] * LOG2E)); v1[j] = fast_rcp(1.f + fast_exp2(-v1[j] * LOG2E)); } }
                    if (t == 4) { v0 = v0 * QSCALE2; v1 = v1 * QSCALE2; }
                    u32x4 w; w.x = cvtpk(v0[0], v0[1]); w.y = cvtpk(v0[2], v0[3]); w.z = cvtpk(v1[0], v1[1]); w.w = cvtpk(v1[2], v1[3]);
                    *(u32x4*)(rowp + bj * HALF) = w; } }
    }
};
struct EpiOut {
    static constexpr bool PERM = false;
    const float* X; float* O;
    __device__ __forceinline__ void operator()(const f32x4 (&acc)[2][2][4][2], const Unit& u, int wr, int wc, int fr, int fq) const {
        const int row0 = u.pm * BM + wr * 64 + fr, col0 = u.pn * BM + wc * 32 + 4 * fq;
#pragma unroll
        for (int ai = 0; ai < 2; ++ai)
#pragma unroll
            for (int m = 0; m < 4; ++m) { const size_t off = (size_t)(row0 + ai * HALF + m * 16) * DM + col0;
#pragma unroll
                for (int bj = 0; bj < 2; ++bj)
#pragma unroll
                    for (int n = 0; n < 2; ++n) { const f32x4 xv = *(const f32x4*)(X + off + bj * HALF + n * 16); *(f32x4*)(O + off + bj * HALF + n * 16) = xv + acc[ai][bj][m][n]; } }
    }
};
}

namespace moe {
constexpr int MT = 384, BKT = 64, A_BYTES = MT * BKT * 2, B_PITCH = 320, B_BYTES = BKT * B_PITCH;
constexpr int OFF_A = 0, OFF_B = 2 * A_BYTES, STAGE_END = 2 * A_BYTES + 2 * B_BYTES;
typedef short v4i16_t __attribute__((ext_vector_type(4)));
__device__ __forceinline__ s16x4 vtr(const LAS unsigned char* p) { return __builtin_bit_cast(s16x4, __builtin_amdgcn_ds_read_tr16_b64_v4i16((LAS v4i16_t*)p)); }

struct Order {
    int G, c, ncs; const LAS int* upre; const LAS int* cpre;
    __device__ bool decode(int i, int& e, int& cs, int& mt, int& cnt, int& cbase) const {
        const int L = i * G + c; if (L >= __builtin_amdgcn_readfirstlane(upre[NE])) return false;
        int lo = 0, hi = NE;
        while (hi - lo > 1) { const int mid = (lo + hi) >> 1; const int v = __builtin_amdgcn_readfirstlane(upre[mid]); if (v <= L) lo = mid; else hi = mid; }
        e = lo; const int u0 = __builtin_amdgcn_readfirstlane(upre[e]), u1 = __builtin_amdgcn_readfirstlane(upre[e + 1]), ntm = (u1 - u0) / ncs, r = L - u0;
        cs = r / ntm; mt = r - cs * ntm; cbase = __builtin_amdgcn_readfirstlane(cpre[e]); cnt = __builtin_amdgcn_readfirstlane(cpre[e + 1]) - cbase; return true;
    }
};

template <int KDIM, bool G1>
__device__ __forceinline__ void phase(LAS unsigned char* lds, const Order& S, const LAS int* tab, const char* Abase, const float* Wa, const float* Wb, bf16* Out) {
    const int tid = opaque_tid(), wid = __builtin_amdgcn_readfirstlane(tid >> 6), lane = tid & 63, r32 = lane & 31, hi = lane >> 5, wr = wid >> 1, wc = wid & 1;
    constexpr int NTK = KDIM / BKT;
    constexpr int LDB = G1 ? DE : DM;
    for (int ui = 0;; ++ui) {
        int e, cs, mt, cnt, cbase; if (!S.decode(ui, e, cs, mt, cnt, cbase)) break;
        const int rows_valid = cnt - MT * mt;
        unsigned aoff[6];
#pragma unroll
        for (int q = 0; q < 6; ++q) { const int row = 8 * (6 * wid + q) + (lane >> 3); const int arow = G1 ? tab[ui * MT + row] : cbase + MT * mt + row;
            aoff[q] = (unsigned)arow * (unsigned)(KDIM * 2) + (unsigned)(((lane & 7) ^ (row & 7)) * 16); }
        const int bn = (tid & 31) * 4, bk = tid >> 5;
        const float* bsrc = G1 ? ((bn < 64 ? Wa : Wb) + (size_t)e * DM * DE + 64 * cs + (bn & 63) + (size_t)bk * LDB)
                               : (Wa + (size_t)e * DE * DM + 128 * cs + bn + (size_t)bk * LDB);
        const unsigned bwr = (unsigned)(bk * B_PITCH + (tid & 31) * 8);
        const LAS unsigned char* trb = lds + OFF_B + (8 * hi + ((lane & 15) >> 2)) * B_PITCH + (16 * ((lane >> 4) & 1) + 4 * (lane & 3)) * 2 + wc * 64;
        const LAS unsigned char* xa[4];
#pragma unroll
        for (int ks = 0; ks < 4; ++ks) xa[ks] = lds + OFF_A + (32 * wr + r32) * 128 + (((2 * ks + hi) ^ (r32 & 7)) * 16);
        const bool rbv1 = 32 * (wr + 4) < rows_valid, rbv2 = 32 * (wr + 8) < rows_valid, rbv0 = 32 * wr < rows_valid;
        f32x16 acc[3][2];
#pragma unroll
        for (int j = 0; j < 3; ++j) { acc[j][0] = f32x16{}; acc[j][1] = f32x16{}; }
        f32x4 R0[4], R1[4];
#define MOE_DMA_A(t, buf) do { _Pragma("unroll") for (int q = 0; q < 6; ++q) \
            __builtin_amdgcn_global_load_lds((const unsigned*)(Abase + aoff[q] + (size_t)(t) * (BKT * 2)), (LAS unsigned*)(lds + OFF_A + (buf) * A_BYTES + (6 * wid + q) * 1024), 16, 0, 0); } while (0)
#define MOE_LDB(R, t) do { const int t_ = (t) < NTK ? (t) : NTK - 1; _Pragma("unroll") for (int i = 0; i < 4; ++i) R[i] = *(const f32x4*)(bsrc + (size_t)(t_ * BKT + 16 * i) * LDB); } while (0)
#define MOE_WRB(R, buf) do { _Pragma("unroll") for (int i = 0; i < 4; ++i) *(LAS v2u*)(lds + OFF_B + (buf) * B_BYTES + bwr + i * 16 * B_PITCH) = (v2u){cvtpk(R[i].x, R[i].y), cvtpk(R[i].z, R[i].w)}; } while (0)
#define MOE_COMPUTE(buf) do { _Pragma("unroll") for (int ks = 0; ks < 4; ++ks) { \
            bf16x8 wf[2], xf[3]; \
            _Pragma("unroll") for (int nbi = 0; nbi < 2; ++nbi) { const s16x4 lo_ = vtr(trb + (buf) * B_BYTES + ks * 16 * B_PITCH + nbi * 128), hi_ = vtr(trb + (buf) * B_BYTES + ks * 16 * B_PITCH + 4 * B_PITCH + nbi * 128); \
                wf[nbi] = (bf16x8){lo_[0], lo_[1], lo_[2], lo_[3], hi_[0], hi_[1], hi_[2], hi_[3]}; } \
            _Pragma("unroll") for (int j = 0; j < 3; ++j) xf[j] = *(const LAS bf16x8*)(xa[ks] + (buf) * A_BYTES + j * 16384); \
            if (rbv0) { acc[0][0] = __builtin_amdgcn_mfma_f32_32x32x16_bf16(wf[0], xf[0], acc[0][0], 0, 0, 0); acc[0][1] = __builtin_amdgcn_mfma_f32_32x32x16_bf16(wf[1], xf[0], acc[0][1], 0, 0, 0); } \
            if (rbv1) { acc[1][0] = __builtin_amdgcn_mfma_f32_32x32x16_bf16(wf[0], xf[1], acc[1][0], 0, 0, 0); acc[1][1] = __builtin_amdgcn_mfma_f32_32x32x16_bf16(wf[1], xf[1], acc[1][1], 0, 0, 0); } \
            if (rbv2) { acc[2][0] = __builtin_amdgcn_mfma_f32_32x32x16_bf16(wf[0], xf[2], acc[2][0], 0, 0, 0); acc[2][1] = __builtin_amdgcn_mfma_f32_32x32x16_bf16(wf[1], xf[2], acc[2][1], 0, 0, 0); } } } while (0)
#define MOE_WAITV(n) asm volatile("s_waitcnt vmcnt(" #n ")" ::: "memory")
        __syncthreads();
        MOE_LDB(R0, 0); MOE_LDB(R1, 1); MOE_DMA_A(0, 0);
        MOE_WAITV(10); MOE_WRB(R0, 0); MOE_LDB(R0, 2);
        MOE_WAITV(4); LDS_WAIT(); __builtin_amdgcn_s_barrier();
        for (int t = 0; t < NTK; t += 2) {
            MOE_DMA_A(t + 1 < NTK ? t + 1 : t, 1);
            MOE_WAITV(10); MOE_WRB(R1, 1); MOE_LDB(R1, t + 3);
            MOE_COMPUTE(0);
            MOE_WAITV(4); LDS_WAIT(); __builtin_amdgcn_s_barrier();
            MOE_DMA_A(t + 2 < NTK ? t + 2 : t, 0);
            MOE_WAITV(10); MOE_WRB(R0, 0); MOE_LDB(R0, t + 4);
            MOE_COMPUTE(1);
            MOE_WAITV(4); LDS_WAIT(); __builtin_amdgcn_s_barrier();
        }
        MOE_WAITV(0);
#undef MOE_DMA_A
#undef MOE_LDB
#undef MOE_WRB
#undef MOE_COMPUTE
#undef MOE_WAITV
#pragma unroll
        for (int j = 0; j < 3; ++j) { const int row = 32 * (wr + 4 * j) + r32;
            if (row < rows_valid) { const size_t orow = (size_t)(cbase + MT * mt + row);
                if (G1) { bf16* op = Out + orow * DE + 64 * cs + 32 * wc + 4 * hi;
#pragma unroll
                    for (int g = 0; g < 4; ++g) { float h4[4];
#pragma unroll
                        for (int i2 = 0; i2 < 4; ++i2) { const float a = acc[j][0][4 * g + i2], b = acc[j][1][4 * g + i2]; h4[i2] = a * fast_rcp(1.f + fast_exp2(-a * LOG2E)) * b; }
                        *(v2u*)(op + 8 * g) = (v2u){cvtpk(h4[0], h4[1]), cvtpk(h4[2], h4[3])}; } }
                else { const float w = ((const LAS float*)tab)[ui * MT + row]; bf16* op = Out + orow * DM + 128 * cs + 32 * wc + 4 * hi;
#pragma unroll
                    for (int nbi = 0; nbi < 2; ++nbi)
#pragma unroll
                        for (int g = 0; g < 4; ++g) *(v2u*)(op + 64 * nbi + 8 * g) = (v2u){cvtpk(acc[j][nbi][4 * g] * w, acc[j][nbi][4 * g + 1] * w), cvtpk(acc[j][nbi][4 * g + 2] * w, acc[j][nbi][4 * g + 3] * w)}; } } }
    }
}
}

namespace att {
#define KSWZ(row, colB) ((row) * 256 + ((colB) ^ (((row) & 7) << 4)))
#define SBAR() __builtin_amdgcn_sched_barrier(0)
constexpr int SHM_V = 16384, SHM_K = 16384;
constexpr int KS_OFF = 32768, WSF_OFF = 33792, WSF_FLOATS = 1152;
__device__ __forceinline__ int v_st(int k, int c) { const int kk = (k & ~0xC) | ((k & 4) << 1) | ((k & 8) >> 1); return ((kk >> 3) * 4 + (c >> 5)) * 512 + ((kk & 7) * 32 + (c & 31)) * 2; }
__device__ __forceinline__ int v_rd_base(int lane) { return ((lane & 3) << 3) | (((lane >> 2) & 3) << 6) | (((lane >> 4) & 1) << 5) | (((lane >> 5) & 1) << 8); }
constexpr int v_rd_off(int d0, int ks, int half) { return d0 * 512 + ks * 4096 + half * 2048; }
__device__ __forceinline__ int crow(int r, int hi) { return (r & 3) + 8 * (r >> 2) + 4 * hi; }

__device__ __forceinline__ void qkt(f32x16& p0, f32x16& p1, const char* K_lds, int r32, int hi, const bf16x8* qr) {
    p0 = f32x16{}; p1 = f32x16{};
    const char* kb[4];
#pragma unroll
    for (int dd = 0; dd < 4; ++dd) kb[dd] = K_lds + KSWZ(r32, (dd * 16 + hi * 8) * 2);
#pragma unroll
    for (int d0 = 0; d0 < 8; ++d0) { const char* a = kb[d0 & 3] + (d0 >> 2) * 128;
        bf16x8 b0 = *reinterpret_cast<const bf16x8*>(a);
        bf16x8 b1 = *reinterpret_cast<const bf16x8*>(a + 32 * 256);
        p0 = __builtin_amdgcn_mfma_f32_32x32x16_bf16(b0, qr[d0], p0, 0, 0, 0);
        p1 = __builtin_amdgcn_mfma_f32_32x32x16_bf16(b1, qr[d0], p1, 0, 0, 0); }
}
__device__ __forceinline__ void pv_tile(f32x16* o, int vb0, bf16x8 pa0, bf16x8 pa1, bf16x8 pa2, bf16x8 pa3) {
#define TRRD(dst, off) asm volatile("ds_read_b64_tr_b16 %0, %1 offset:%2" : "=&v"(dst) : "v"(vb0), "i"(off) : "memory")
#define PV_D0(d0) do { s16x4 l0, l1, l2, l3, h0, h1, h2, h3; constexpr int b_ = v_rd_off(d0, 0, 0); \
        TRRD(l0, b_); TRRD(h0, b_ + 2048); TRRD(l1, b_ + 4096); TRRD(h1, b_ + 6144); TRRD(l2, b_ + 8192); TRRD(h2, b_ + 10240); TRRD(l3, b_ + 12288); TRRD(h3, b_ + 14336); \
        asm volatile("s_waitcnt lgkmcnt(0)" ::: "memory"); SBAR(); \
        o[d0] = __builtin_amdgcn_mfma_f32_32x32x16_bf16(pa0, (bf16x8){l0[0], l0[1], l0[2], l0[3], h0[0], h0[1], h0[2], h0[3]}, o[d0], 0, 0, 0); \
        o[d0] = __builtin_amdgcn_mfma_f32_32x32x16_bf16(pa1, (bf16x8){l1[0], l1[1], l1[2], l1[3], h1[0], h1[1], h1[2], h1[3]}, o[d0], 0, 0, 0); \
        o[d0] = __builtin_amdgcn_mfma_f32_32x32x16_bf16(pa2, (bf16x8){l2[0], l2[1], l2[2], l2[3], h2[0], h2[1], h2[2], h2[3]}, o[d0], 0, 0, 0); \
        o[d0] = __builtin_amdgcn_mfma_f32_32x32x16_bf16(pa3, (bf16x8){l3[0], l3[1], l3[2], l3[3], h3[0], h3[1], h3[2], h3[3]}, o[d0], 0, 0, 0); } while (0)
    PV_D0(0); PV_D0(1); PV_D0(2); PV_D0(3);
#undef PV_D0
#undef TRRD
}
#define PK4(P, B_, OUT) do { unsigned a0 = cvtpk(P[B_+0], P[B_+1]), a1 = cvtpk(P[B_+2], P[B_+3]); \
        unsigned b0 = cvtpk(P[B_+4], P[B_+5]), b1 = cvtpk(P[B_+6], P[B_+7]); \
        auto r0 = __builtin_amdgcn_permlane32_swap(a0, b0, false, false); auto r1 = __builtin_amdgcn_permlane32_swap(a1, b1, false, false); \
        v4u w = {r0[0], r1[0], r0[1], r1[1]}; OUT = *reinterpret_cast<bf16x8*>(&w); } while (0)

struct Tensors {
    const bf16* QA; const bf16* KA; const bf16* VA; const bf16* GA; const bf16* QB; const bf16* KB; const bf16* VB;
    const float* SS; const float* CUM;
    const float* q_gain; const float* k_gain;
    const float* fox_gain; const float* sb_gain;
    bf16* MIX;
};

template <int TYP>
__device__ __forceinline__ void attn_unit(char* lds, const Tensors& T, const int b, const int h, const int qb) {
    const int tid = opaque_tid(), wid = __builtin_amdgcn_readfirstlane(tid >> 6), lane = tid & 63, r32 = lane & 31, hi = lane >> 5;
    char* V_lds = lds; char* K_lds = lds + SHM_V;
    float* ks_rk = (float*)(lds + KS_OFF); float* ks_nc = ks_rk + 64; int* wdone = (int*)(lds + KS_OFF + 512);
    float* wsf = (float*)(lds + WSF_OFF) + wid * WSF_FLOATS; float* part = wsf; float* li_l = wsf + 1056; float* rs_l = wsf + 1088;
    const bf16* Qp = TYP == 0 ? T.QA : T.QB; const bf16* Kp = TYP == 0 ? T.KA : T.KB; const bf16* Vp = TYP == 0 ? T.VA : T.VB;
    const int frow0 = b * SEQ + qb * 256 + wid * 32;
    const int cbase = (b * NH + h) * CUMLD;
    bf16x8 qr[8];
#pragma unroll
    for (int d0 = 0; d0 < 8; ++d0) qr[d0] = *reinterpret_cast<const bf16x8*>(Qp + (size_t)(frow0 + r32) * 1024 + h * HD + d0 * 16 + hi * 8);
    float mt2 = 0.f;
    if (TYP == 0) {
        const f32x4 sp = *(const f32x4*)(T.SS + ((size_t)(frow0 + r32) * 8 + h) * 4);
        const float rstd = (1.0f / sqrtf(((sp.x + sp.y) + (sp.z + sp.w)) * (1.f / HD) + EPS)) * QSCALE2;
        float n2 = 0.f;
#pragma unroll
        for (int d0 = 0; d0 < 8; ++d0) { const int db = d0 * 16 + hi * 8;
            const f32x4 ga = *(const f32x4*)(T.q_gain + db), gb = *(const f32x4*)(T.q_gain + db + 4), ka = *(const f32x4*)(T.k_gain + db), kb = *(const f32x4*)(T.k_gain + db + 4);
            const float g8[8] = {ga.x * ka.x, ga.y * ka.y, ga.z * ka.z, ga.w * ka.w, gb.x * kb.x, gb.y * kb.y, gb.z * kb.z, gb.w * kb.w};
            v4u w = *reinterpret_cast<v4u*>(&qr[d0]); unsigned ww[4] = {w.x, w.y, w.z, w.w};
#pragma unroll
            for (int i = 0; i < 4; ++i) { const float lo = __uint_as_float(ww[i] << 16) * rstd * g8[2 * i], hi2 = __uint_as_float(ww[i] & 0xffff0000u) * rstd * g8[2 * i + 1]; n2 += lo * lo + hi2 * hi2; ww[i] = cvtpk(lo, hi2); }
            w = (v4u){ww[0], ww[1], ww[2], ww[3]}; qr[d0] = *reinterpret_cast<bf16x8*>(&w); }
        n2 += __shfl_xor(n2, 32);
        mt2 = sqrtf(n2 * (float)HD);
    }
    const int qp = 64 + qb * 256 + wid * 32 + r32;
    const int qpmin = 64 + qb * 256 + wid * 32, qpmax = qpmin + 31;
    float bias_t = 0.f, cum_t = 0.f, Rrun = 0.f, l_reg = 0.f;
    if (TYP == 0) { cum_t = T.CUM[cbase + qp - 48]; bias_t = cum_t - mt2; rs_l[r32] = cum_t; }
    bool wave_done = false;
    if (lane == 0) wdone[wid] = 0;
    f32x16 o[4] = {};
    const int sr = tid >> 4, sc = (tid & 15) * 8;
    const int vst0 = v_st(sr, sc), vst1 = v_st(32 + sr, sc), kws = KSWZ(sr, sc * 2);
    const int vb0 = (int)(uintptr_t)V_lds + v_rd_base(lane);
    bf16x8 st_k0, st_k1, st_v0, st_v1; float st_rk = 0.f, st_nc = 0.f;
#define KEYROW(j, i) ((j) == 0 ? ((i) >= 48 ? ROW_META + (i) - 48 : ROW_META) : b * SEQ + 64 * ((j) - 1) + (i))
#define TLOAD(j) do { const size_t r0_ = (size_t)KEYROW(j, sr) * 1024 + h * HD + sc, r1_ = (size_t)KEYROW(j, 32 + sr) * 1024 + h * HD + sc; \
        st_k0 = *reinterpret_cast<const bf16x8*>(Kp + r0_); st_k1 = *reinterpret_cast<const bf16x8*>(Kp + r1_); \
        st_v0 = *reinterpret_cast<const bf16x8*>(Vp + r0_); st_v1 = *reinterpret_cast<const bf16x8*>(Vp + r1_); \
        if (TYP == 0 && tid < 64) { const int kr_ = KEYROW(j, tid); const int pos_ = (j) == 0 ? (tid >= 48 ? tid - 48 : 0) : 16 + 64 * ((j) - 1) + tid; \
            const f32x4 sk_ = *(const f32x4*)(T.SS + (((size_t)MROWS + kr_) * 8 + h) * 4); st_rk = 1.0f / sqrtf(((sk_.x + sk_.y) + (sk_.z + sk_.w)) * (1.f / HD) + EPS); st_nc = -T.CUM[cbase + pos_]; } } while (0)
    int j = 4 * qb + 4;
    TLOAD(j);
    for (; j >= 0; --j) {
        __syncthreads();
        { const v4u d0 = *(const v4u*)wdone, d1 = *((const v4u*)wdone + 1);
          if (__builtin_amdgcn_readfirstlane((d0.x & d0.y & d0.z & d0.w) & (d1.x & d1.y & d1.z & d1.w)) != 0u) break; }
        *(bf16x8*)(K_lds + kws) = st_k0; *(bf16x8*)(K_lds + kws + 32 * 256) = st_k1;
        *(bf16x8*)(V_lds + vst0) = st_v0; *(bf16x8*)(V_lds + vst1) = st_v1;
        if (TYP == 0 && tid < 64) { ks_rk[tid] = st_rk; ks_nc[tid] = st_nc; }
        __syncthreads();
        if (j > 0) TLOAD(j - 1);
        if (wave_done || 64 * j > qpmax) continue;
        f32x16 p0, p1;
        qkt(p0, p1, K_lds, r32, hi, qr);
        const bool need_mask = (j == 0) || (64 * j + 63 > qpmin - (TYP == 1 ? 1 : 0));
        const int kp0 = 64 * j + 4 * hi;
        bf16x8 pa0, pa1, pa2, pa3;
        if (TYP == 0) {
#pragma unroll
            for (int q = 0; q < 8; ++q) {
                const f32x4 rkv = *(const f32x4*)(ks_rk + 8 * q + 4 * hi), ncv = *(const f32x4*)(ks_nc + 8 * q + 4 * hi);
                if (q < 4) {
#pragma unroll
                    for (int i = 0; i < 4; ++i) p0[4 * q + i] = fmaf(p0[4 * q + i], rkv[i], ncv[i]) + bias_t;
                } else {
#pragma unroll
                    for (int i = 0; i < 4; ++i) p1[4 * (q - 4) + i] = fmaf(p1[4 * (q - 4) + i], rkv[i], ncv[i]) + bias_t;
                }
                asm volatile("" ::: "memory");
            }
            if (need_mask) {
#pragma unroll
                for (int r = 0; r < 16; ++r) { const int kp = kp0 + (r & 3) + 8 * (r >> 2);
                    if (!(kp <= qp && kp >= 48)) p0[r] = -__builtin_inff();
                    if (!(kp + 32 <= qp && kp + 32 >= 48)) p1[r] = -__builtin_inff(); }
            }
            float ps = 0.f;
#pragma unroll
            for (int r = 0; r < 16; ++r) { p0[r] = fast_exp2(p0[r]); p1[r] = fast_exp2(p1[r]); ps += p0[r] + p1[r]; }
            l_reg += ps;
        } else {
            f32x16 k0, k1;
#pragma unroll
            for (int r = 0; r < 16; ++r) {
                { const float z = p0[r], sp = fmaxf(z, 0.f) + fast_log2(1.f + fast_exp2(-fabsf(z))); k0[r] = -sp; p0[r] = z - sp; }
                { const float z = p1[r], sp = fmaxf(z, 0.f) + fast_log2(1.f + fast_exp2(-fabsf(z))); k1[r] = -sp; p1[r] = z - sp; }
            }
            if (need_mask) {
#pragma unroll
                for (int r = 0; r < 16; ++r) { const int kp = kp0 + (r & 3) + 8 * (r >> 2);
                    if (!(kp < qp && kp >= 48)) { p0[r] = -__builtin_inff(); k0[r] = 0.f; }
                    if (!(kp + 32 < qp && kp + 32 >= 48)) { p1[r] = -__builtin_inff(); k1[r] = 0.f; } }
            }
            float so = 0.f, spi = 0.f;
#pragma unroll
            for (int i = 7; i >= 0; --i) {
                const float g = (i < 4) ? (k0[4 * (i & 3)] + k0[4 * (i & 3) + 1]) + (k0[4 * (i & 3) + 2] + k0[4 * (i & 3) + 3]) : (k1[4 * (i & 3)] + k1[4 * (i & 3) + 1]) + (k1[4 * (i & 3) + 2] + k1[4 * (i & 3) + 3]);
                const float spn = spi + __shfl_xor(g, 32);
                const float off = Rrun + so + (hi ? spi : spn);
                if (i < 4) { const float l3 = off, l2 = l3 + k0[4 * i + 3], l1 = l2 + k0[4 * i + 2], l0 = l1 + k0[4 * i + 1];
                    p0[4 * i + 3] = fast_exp2(p0[4 * i + 3] + l3); p0[4 * i + 2] = fast_exp2(p0[4 * i + 2] + l2); p0[4 * i + 1] = fast_exp2(p0[4 * i + 1] + l1); p0[4 * i] = fast_exp2(p0[4 * i] + l0); }
                else { const int ii = i - 4; const float l3 = off, l2 = l3 + k1[4 * ii + 3], l1 = l2 + k1[4 * ii + 2], l0 = l1 + k1[4 * ii + 1];
                    p1[4 * ii + 3] = fast_exp2(p1[4 * ii + 3] + l3); p1[4 * ii + 2] = fast_exp2(p1[4 * ii + 2] + l2); p1[4 * ii + 1] = fast_exp2(p1[4 * ii + 1] + l1); p1[4 * ii] = fast_exp2(p1[4 * ii] + l0); }
                so += g; spi = spn;
            }
            Rrun += so + spi;
        }
        PK4(p0, 0, pa0); PK4(p0, 8, pa1); PK4(p1, 0, pa2); PK4(p1, 8, pa3);
        pv_tile(o, vb0, pa0, pa1, pa2, pa3);
        if (j > 0) { bool conv;
            if (TYP == 0) { const float lt = l_reg + __shfl_xor(l_reg, 32); conv = (rs_l[r32] + ks_nc[0]) <= fast_log2(lt) - 41.f; }
            else conv = Rrun <= -30.f;
            if (__all(conv)) { wave_done = true; if (lane == 0) wdone[wid] = 1; } }
    }
#undef TLOAD
#undef KEYROW
    __syncthreads();
    int lane_e = lane, frow_e = frow0;
    asm volatile("" : "+v"(lane_e), "+s"(frow_e));
    const int r32e = lane_e & 31, hie = lane_e >> 5;
    if (TYP == 0) {
        l_reg += __shfl_xor(l_reg, 32);
        if (hie == 0) li_l[r32e] = fast_rcp(l_reg);
        LDS_WAIT();
#pragma unroll
        for (int r = 0; r < 16; ++r) { const float il = li_l[crow(r, hie)];
#pragma unroll
            for (int d0 = 0; d0 < 4; ++d0) o[d0][r] *= il; }
    }
#pragma unroll
    for (int r = 0; r < 16; ++r) { float s = 0.f;
#pragma unroll
        for (int d0 = 0; d0 < 4; ++d0) s += o[d0][r] * o[d0][r];
        part[crow(r, hie) * 33 + r32e] = s; }
    LDS_WAIT();
    { float s = 0.f;
#pragma unroll
      for (int c = 0; c < 16; ++c) s += part[r32e * 33 + hie * 16 + c];
      s += __shfl_xor(s, 32);
      if (hie == 0) rs_l[r32e] = 1.0f / sqrtf(s * (1.f / HD) + EPS); }
    LDS_WAIT();
    const float* gain = (TYP == 0 ? T.fox_gain : T.sb_gain) + h * HD;
    float gn[4];
#pragma unroll
    for (int d0 = 0; d0 < 4; ++d0) gn[d0] = gain[d0 * 32 + r32e];
#pragma unroll
    for (int r = 0; r < 16; ++r) { const int orow = crow(r, hie); const float rs = rs_l[orow];
        bf16* orp = T.MIX + (size_t)(frow_e + orow) * DM + TYP * 1024 + h * HD;
#pragma unroll
        for (int d0 = 0; d0 < 4; ++d0) { float v = o[d0][r] * rs * gn[d0];
            if (TYP == 0) v *= bf2f(T.GA[(size_t)(frow_e + orow) * 1024 + h * HD + d0 * 32 + r32e]);
            const float vn = __shfl_xor(v, 1);
            if ((r32e & 1) == 0) *(unsigned*)(orp + d0 * 32 + r32e) = cvtpk(v, vn); } }
    LDS_WAIT();
}
#undef PK4
#undef SBAR
#undef KSWZ
}

struct Frame {
    LAS unsigned char* lds; char* ldsg;
    volatile LAS unsigned* MISC;
    gu32* ctl;
    int tid, lane, wave, vcu, G;
    unsigned char* ws;
    const float *x, *meta, *g1, *w_in, *b_f, *q_gain, *k_gain, *fox_gain, *sb_gain, *w_out, *g2, *w_coarse, *b_coarse, *w_fine, *b_fine, *w1, *w3, *w2;
    float* out;
};

__device__ __forceinline__ void transpose_item(const float* W, size_t ldw, int k0, int n0, bf16* WT, size_t Kd, size_t drow0, LAS float* scr, int lane) {
    { const int r = lane >> 4, c4 = (lane & 15) * 4; const float* src = W + (size_t)(k0 + r) * ldw + n0 + c4; LAS float* dst = scr + r * 65 + c4;
#pragma unroll
      for (int hlf = 0; hlf < 2; ++hlf) { f32x4 v[8];
#pragma unroll
          for (int i = 0; i < 8; ++i) v[i] = *(const f32x4*)(src + (size_t)(4 * (8 * hlf + i)) * ldw);
#pragma unroll
          for (int i = 0; i < 8; ++i) { LAS float* d = dst + 4 * (8 * hlf + i) * 65; d[0] = v[i].x; d[1] = v[i].y; d[2] = v[i].z; d[3] = v[i].w; } } }
    LDS_WAIT(); asm volatile("" ::: "memory");
    const int c = lane & 7;
#pragma unroll
    for (int j = 0; j < 8; ++j) { const int n = (lane >> 3) + 8 * j; const LAS float* s = scr + (8 * c) * 65 + n;
        v4u o; o.x = cvtpk(s[0 * 65], s[1 * 65]); o.y = cvtpk(s[2 * 65], s[3 * 65]); o.z = cvtpk(s[4 * 65], s[5 * 65]); o.w = cvtpk(s[6 * 65], s[7 * 65]);
        *(GAS v4u*)(WT + (drow0 + n) * Kd + k0 + 8 * c) = o; }
    LDS_WAIT(); asm volatile("" ::: "memory");
}

__device__ __forceinline__ void p0_prologue(Frame& F) {
    const int gw = F.vcu * 8 + F.wave, NGW = F.G * 8;
    LAS float* wf = (LAS float*)F.lds;
    for (int e = F.tid; e < 8 * DM; e += 512) { const int k = e >> 3, jj = e & 7; wf[jj * DM + k] = F.w_in[(size_t)k * LDW_IN + NPROJ + jj]; }
    __syncthreads();
    bf16* U1 = (bf16*)(F.ws + WS_U1); float* Fp = (float*)(F.ws + WS_F);
    for (int m = gw; m < MROWS; m += NGW) {
        GAS v2u* o8 = (GAS v2u*)(U1 + (size_t)m * DM) + F.lane;
        if (m >= NKEYROWS) {
#pragma unroll
            for (int j = 0; j < 8; ++j) o8[64 * j] = (v2u){0u, 0u};
            continue; }
        const float* xrow = m < TF ? F.x + (size_t)m * DM : F.meta + (size_t)(m - TF) * DM;
        const GAS f32x4* xr = (const GAS f32x4*)xrow + F.lane;
        f32x4 v[8]; float s = 0.f;
#pragma unroll
        for (int j = 0; j < 8; ++j) { v[j] = xr[64 * j]; s += (v[j].x * v[j].x + v[j].y * v[j].y) + (v[j].z * v[j].z + v[j].w * v[j].w); }
        const float rstd = 1.0f / sqrtf(wave_sum(s) * (1.f / DM) + EPS);
        float fa[8] = {0.f, 0.f, 0.f, 0.f, 0.f, 0.f, 0.f, 0.f};
#pragma unroll
        for (int j = 0; j < 8; ++j) { const f32x4 g = *((const GAS f32x4*)F.g1 + F.lane + 64 * j); v[j] = v[j] * rstd * g;
            o8[64 * j] = (v2u){cvtpk(v[j].x, v[j].y), cvtpk(v[j].z, v[j].w)};
#pragma unroll
            for (int jj = 0; jj < 8; ++jj) { const f32x4 w = *(const LAS f32x4*)(wf + jj * DM + 256 * j + 4 * F.lane); fa[jj] += (v[j].x * w.x + v[j].y * w.y) + (v[j].z * w.z + v[j].w * w.w); } }
#pragma unroll
        for (int jj = 0; jj < 8; ++jj) fa[jj] = wave_sum(fa[jj]);
        if (F.lane == 0) {
#pragma unroll
            for (int jj = 0; jj < 8; ++jj) Fp[(size_t)m * 8 + jj] = fa[jj]; }
    }
    { bf16* U2 = (bf16*)(F.ws + WS_U2);
      for (int m = TF + gw; m < MROWS; m += NGW) { GAS v2u* o8 = (GAS v2u*)(U2 + (size_t)m * DM) + F.lane;
#pragma unroll
          for (int j = 0; j < 8; ++j) o8[64 * j] = (v2u){0u, 0u}; } }
    { bf16* HID = (bf16*)(F.ws + WS_HID);
      for (int m = NASSIGN + gw; m < NASSIGN + 384; m += NGW) { GAS v2u* o8 = (GAS v2u*)(HID + (size_t)m * DE) + F.lane; o8[0] = (v2u){0u, 0u}; o8[64] = (v2u){0u, 0u}; } }
    { v4u* RB = (v4u*)(F.ws + WS_RB);
      for (int it = gw * 64 + F.lane; it < 64 * 5 * 64; it += NGW * 64) { const int ln = it & 63, kc = it >> 6, ks = kc / 5, cb = kc % 5, col = 16 * cb + (ln & 15), k0 = 32 * ks + 8 * (ln >> 4);
          float w[8], lo[8]; unsigned hb[4], lb[4];
#pragma unroll
          for (int i = 0; i < 8; ++i) { w[i] = col < 8 ? F.w_coarse[(size_t)(k0 + i) * 8 + col] : (col < 72 ? F.w_fine[(size_t)(k0 + i) * 64 + col - 8] : 0.f); }
#pragma unroll
          for (int i = 0; i < 4; ++i) { hb[i] = cvtpk(w[2 * i], w[2 * i + 1]); lo[2 * i] = w[2 * i] - __uint_as_float(hb[i] << 16); lo[2 * i + 1] = w[2 * i + 1] - __uint_as_float(hb[i] & 0xffff0000u); lb[i] = cvtpk(lo[2 * i], lo[2 * i + 1]); }
          RB[(size_t)(kc * 2 + 0) * 64 + ln] = (v4u){hb[0], hb[1], hb[2], hb[3]}; RB[(size_t)(kc * 2 + 1) * 64 + ln] = (v4u){lb[0], lb[1], lb[2], lb[3]}; } }
    __syncthreads();
    LAS float* scr = (LAS float*)(F.lds + F.wave * 16640);
    bf16* WinT = (bf16*)(F.ws + WS_WIN_T); bf16* WoutT = (bf16*)(F.ws + WS_WOUT_T);
    constexpr int I_IN = (DM / 64) * (NPROJ / 64), I_OUT = (DM / 64) * (DM / 64);
    constexpr int NITEMS = I_IN + I_OUT;
    for (int it = gw; it < NITEMS; it += NGW) {
        int r = it;
        if (r < I_IN) { const int kb = r / (NPROJ / 64), nb = r % (NPROJ / 64); transpose_item(F.w_in, LDW_IN, kb * 64, nb * 64, WinT, DM, nb * 64, scr, F.lane); continue; } r -= I_IN;
        { const int kb = r / (DM / 64), nb = r % (DM / 64); transpose_item(F.w_out, DM, kb * 64, nb * 64, WoutT, DM, nb * 64, scr, F.lane); }
    }
}

__device__ __forceinline__ void cum_scan(Frame& F, int bh) {
    const float* Fp = (const float*)(F.ws + WS_F); float* CUM = (float*)(F.ws + WS_CUM);
    const int b = bh >> 3, h = bh & 7; const float bf = F.b_f[h]; float carry = 0.f;
    for (int c0 = 0; c0 < LPOS; c0 += 64) { const int pos = c0 + F.lane; float v = 0.f;
        if (pos < LPOS) { const int row = pos < NMETA ? ROW_META + pos : b * SEQ + pos - NMETA; const float xv = Fp[(size_t)row * 8 + h] + bf;
            v = (fminf(xv, 0.f) - log1pf(expf(-fabsf(xv)))) * LOG2E; }
#pragma unroll
        for (int o = 1; o < 64; o <<= 1) { const float t = __shfl_up(v, o); if (F.lane >= o) v += t; }
        v += carry;
        if (pos < LPOS) CUM[(size_t)bh * CUMLD + pos] = v;
        carry = __shfl(v, 63); }
}

__device__ __forceinline__ void p5_router(Frame& F) {
    const int ntask = TF / 16;
    const float* H1 = F.out; bf16* U2 = (bf16*)(F.ws + WS_U2); const v4u* RB = (const v4u*)(F.ws + WS_RB);
    int* RE = (int*)(F.ws + WS_ROUTE); int* RP = RE + TF * 2; float* RW = (float*)(RP + TF * 2); int* TOK = (int*)(F.ws + WS_TOK);
    const int tid = opaque_tid(), lane = tid & 63, wave = __builtin_amdgcn_readfirstlane(tid >> 6), tk = wave >> 2, kp = wave & 3;
    LAS float* pacc = (LAS float*)F.lds;
    LAS float* ssp = (LAS float*)(F.lds + 40960);
    LAS float* lg = (LAS float*)(F.lds + 41472) + tk * 16 * 88;
    const int i = lane & 15, kq = lane >> 4;
    for (int base = 0; base < ntask; base += 2 * F.G) {
        const int task = base + 2 * (int)blockIdx.x + tk; const bool live = task < ntask;
        const int row0 = (live ? task : 0) * 16; const float* hrow = H1 + (size_t)(row0 + i) * DM + 8 * kq + 512 * kp;
        float ss = 0.f;
#pragma unroll 8
        for (int ks = 0; ks < 16; ++ks) { const f32x4 a = *(const f32x4*)(hrow + 32 * ks), b = *(const f32x4*)(hrow + 32 * ks + 4);
            ss += (a.x * a.x + a.y * a.y) + (a.z * a.z + a.w * a.w) + (b.x * b.x + b.y * b.y) + (b.z * b.z + b.w * b.w); }
        ss += __shfl_xor(ss, 16); ss += __shfl_xor(ss, 32);
        if (lane < 16) ssp[wave * 16 + i] = ss;
        __syncthreads();
        const float rstd = 1.0f / sqrtf(((ssp[(4 * tk) * 16 + i] + ssp[(4 * tk + 1) * 16 + i]) + (ssp[(4 * tk + 2) * 16 + i] + ssp[(4 * tk + 3) * 16 + i])) * (1.f / DM) + EPS);
        f32x4 acc[5];
#pragma unroll
        for (int cb = 0; cb < 5; ++cb) acc[cb] = (f32x4){0.f, 0.f, 0.f, 0.f};
#pragma unroll 2
        for (int ks = 0; ks < 16; ++ks) { const int kg = 16 * kp + ks;
            const f32x4 a = *(const f32x4*)(hrow + 32 * ks), b = *(const f32x4*)(hrow + 32 * ks + 4);
            const f32x4 ga = *(const f32x4*)(F.g2 + 32 * kg + 8 * kq), gb = *(const f32x4*)(F.g2 + 32 * kg + 8 * kq + 4);
            float u[8] = {a.x * rstd * ga.x, a.y * rstd * ga.y, a.z * rstd * ga.z, a.w * rstd * ga.w, b.x * rstd * gb.x, b.y * rstd * gb.y, b.z * rstd * gb.z, b.w * rstd * gb.w};
            unsigned hb[4], lb[4];
#pragma unroll
            for (int q = 0; q < 4; ++q) { hb[q] = cvtpk(u[2 * q], u[2 * q + 1]); lb[q] = cvtpk(u[2 * q] - __uint_as_float(hb[q] << 16), u[2 * q + 1] - __uint_as_float(hb[q] & 0xffff0000u)); }
            v4u hv = {hb[0], hb[1], hb[2], hb[3]}, lv = {lb[0], lb[1], lb[2], lb[3]};
            if (live) *(v4u*)(U2 + (size_t)(row0 + i) * DM + 32 * kg + 8 * kq) = hv;
            const bf16x8 Ah = *reinterpret_cast<bf16x8*>(&hv), Al = *reinterpret_cast<bf16x8*>(&lv);
#pragma unroll
            for (int cb = 0; cb < 5; ++cb) { v4u bh = RB[(size_t)((kg * 5 + cb) * 2 + 0) * 64 + lane], bl = RB[(size_t)((kg * 5 + cb) * 2 + 1) * 64 + lane];
                const bf16x8 Bh = *reinterpret_cast<bf16x8*>(&bh), Bl = *reinterpret_cast<bf16x8*>(&bl);
                acc[cb] = __builtin_amdgcn_mfma_f32_16x16x32_bf16(Ah, Bh, acc[cb], 0, 0, 0);
                acc[cb] = __builtin_amdgcn_mfma_f32_16x16x32_bf16(Ah, Bl, acc[cb], 0, 0, 0);
                acc[cb] = __builtin_amdgcn_mfma_f32_16x16x32_bf16(Al, Bh, acc[cb], 0, 0, 0); }
        }
#pragma unroll
        for (int cb = 0; cb < 5; ++cb)
#pragma unroll
            for (int j = 0; j < 4; ++j) pacc[(wave * 16 + 4 * kq + j) * 80 + 16 * cb + i] = acc[cb][j];
        __syncthreads();
        if (kp == 0) {
#pragma unroll
            for (int m = 0; m < 20; ++m) { const int idx = lane + 64 * m, r = idx / 80, c = idx - r * 80;
                lg[r * 88 + c] = (pacc[((4 * tk) * 16 + r) * 80 + c] + pacc[((4 * tk + 1) * 16 + r) * 80 + c]) + (pacc[((4 * tk + 2) * 16 + r) * 80 + c] + pacc[((4 * tk + 3) * 16 + r) * 80 + c]); }
            LDS_WAIT(); asm volatile("" ::: "memory");
            if (lane < 16 && live) { const LAS float* L = lg + lane * 88; const int row = row0 + lane;
                float cmax = L[0] + F.b_coarse[0]; int gs = 0; float cv[8]; cv[0] = cmax;
#pragma unroll
                for (int g = 1; g < 8; ++g) { cv[g] = L[g] + F.b_coarse[g]; if (cv[g] > cmax) { cmax = cv[g]; gs = g; } }
                float den = 0.f;
#pragma unroll
                for (int g = 0; g < 8; ++g) den += expf(cv[g] - cmax);
                const float ggate = 1.0f / den;
                float f1 = -__builtin_inff(), f2 = -__builtin_inff(); int i1 = 0, i2 = 0;
#pragma unroll
                for (int jx = 0; jx < 8; ++jx) { const float fv = L[8 + gs * 8 + jx] + F.b_fine[gs * 8 + jx];
                    if (fv > f1) { f2 = f1; i2 = i1; f1 = fv; i1 = jx; } else if (fv > f2) { f2 = fv; i2 = jx; } }
                const float e2 = expf(f2 - f1), w1 = ggate / (1.f + e2), w2 = ggate * e2 / (1.f + e2);
                const int ea = gs * 8 + i1, eb = gs * 8 + i2;
                const int pa = (int)__hip_atomic_fetch_add(F.ctl + CW_CNT + 64 * ea, 1u, RLX_AGENT), pb = (int)__hip_atomic_fetch_add(F.ctl + CW_CNT + 64 * eb, 1u, RLX_AGENT);
                TOK[(size_t)ea * TOKLD + pa] = row * 2; TOK[(size_t)eb * TOKLD + pb] = row * 2 + 1;
                RE[row * 2] = ea; RE[row * 2 + 1] = eb; RP[row * 2] = pa; RP[row * 2 + 1] = pb; RW[row * 2] = w1; RW[row * 2 + 1] = w2; }
        }
        __syncthreads();
    }
}

__device__ __forceinline__ void moe_prefix(Frame& F, int ncs) {
    LAS int* upre = (LAS int*)(F.lds + TPRE_OFF); LAS int* cpre = upre + 80;
    if (F.tid < 64) { const int c = (int)__hip_atomic_load(F.ctl + CW_CNT + 64 * F.tid, RLX_AGENT); int u = ((c + 383) / 384) * ncs, v = c;
#pragma unroll
        for (int o = 1; o < 64; o <<= 1) { const int y = __shfl_up(u, o), z = __shfl_up(v, o); if (F.lane >= o) { u += y; v += z; } }
        upre[F.tid + 1] = u; cpre[F.tid + 1] = v; if (F.tid == 0) { upre[0] = 0; cpre[0] = 0; } }
    __syncthreads();
}

__device__ __forceinline__ void p8_combine(Frame& F) {
    const LAS int* cpre = (const LAS int*)(F.lds + TPRE_OFF) + 80;
    const int* RE = (const int*)(F.ws + WS_ROUTE); const int* RP = RE + TF * 2; const bf16* Y = (const bf16*)(F.ws + WS_Y);
    for (int m = F.vcu * 8 + F.wave; m < TF; m += F.G * 8) {
        const int e0 = RE[m * 2], e1 = RE[m * 2 + 1], p0 = RP[m * 2], p1 = RP[m * 2 + 1];
        const size_t s0 = (size_t)(cpre[e0] + p0), s1 = (size_t)(cpre[e1] + p1);
        GAS f32x4* op = (GAS f32x4*)(F.out + (size_t)m * DM) + 2 * F.lane;
        const GAS v4u* y0 = (const GAS v4u*)(Y + s0 * DM) + F.lane; const GAS v4u* y1 = (const GAS v4u*)(Y + s1 * DM) + F.lane;
#pragma unroll
        for (int j = 0; j < 4; ++j) { f32x4 a = op[128 * j], b = op[128 * j + 1]; const v4u u0 = y0[64 * j], u1 = y1[64 * j];
            a.x += __uint_as_float(u0.x << 16) + __uint_as_float(u1.x << 16); a.y += __uint_as_float(u0.x & 0xffff0000u) + __uint_as_float(u1.x & 0xffff0000u);
            a.z += __uint_as_float(u0.y << 16) + __uint_as_float(u1.y << 16); a.w += __uint_as_float(u0.y & 0xffff0000u) + __uint_as_float(u1.y & 0xffff0000u);
            b.x += __uint_as_float(u0.z << 16) + __uint_as_float(u1.z << 16); b.y += __uint_as_float(u0.z & 0xffff0000u) + __uint_as_float(u1.z & 0xffff0000u);
            b.z += __uint_as_float(u0.w << 16) + __uint_as_float(u1.w << 16); b.w += __uint_as_float(u0.w & 0xffff0000u) + __uint_as_float(u1.w & 0xffff0000u);
            op[128 * j] = a; op[128 * j + 1] = b; }
    }
}

#define XB_TMO      128
#define XB_XCNT(j)  (256  + 64 * (j))
#define XB_XSUB(j)  (1280 + 64 * (j))
#define XB_XGEN(j)  (2304 + 64 * (j))
#define XB_TOP      3328
#define XB_TOPGEN   3392
#define XCD_BAR_WORDS 3456
#define XB_SPIN_CAP (1u << 18)

__device__ __forceinline__ unsigned xb_ld(unsigned* p)              { return __hip_atomic_load(p, __ATOMIC_RELAXED, __HIP_MEMORY_SCOPE_AGENT); }
__device__ __forceinline__ unsigned xb_add(unsigned* p, unsigned v) { return __hip_atomic_fetch_add(p, v, __ATOMIC_RELAXED, __HIP_MEMORY_SCOPE_AGENT); }
__device__ __forceinline__ unsigned xb_xcc_id() { return (unsigned)__builtin_amdgcn_s_getreg((3 << 11) | 20) & 0xFu; }
#define XB_SPIN(cond, bar) do { unsigned _sp = 0; while (cond) { __builtin_amdgcn_s_sleep(1); \
    if ((++_sp & 255u) == 0u) { if (xb_ld(&(bar)[XB_TMO])) break; if (_sp > XB_SPIN_CAP) { atomicAdd(&(bar)[XB_TMO], 1u); break; } } } } while (0)

struct XcdBarrier {
    unsigned* bar; unsigned x;
    volatile LAS unsigned* st;
};

__device__ __forceinline__ XcdBarrier xcd_barrier_post(unsigned* bar, volatile LAS unsigned* st) {
    XcdBarrier b; b.bar = bar; b.x = xb_xcc_id(); b.st = st;
    if (threadIdx.x == 0) (void)xb_add(&bar[XB_XCNT(b.x)], 1u);
    return b;
}
__device__ __forceinline__ void xcd_barrier_complete(unsigned* bar, unsigned x, unsigned& nloc, unsigned& nx) {
    const unsigned G = gridDim.x * gridDim.y * gridDim.z;
    unsigned sum, cnt, mine, sp = 0u;
    for (;;) {
        sum = 0u; cnt = 0u; mine = 0u;
#pragma unroll
        for (unsigned j = 0; j < 16; ++j) { const unsigned c = xb_ld(&bar[XB_XCNT(j)]); sum += c; cnt += (c > 0u) ? 1u : 0u; mine = (j == x) ? c : mine; }
        if (sum == G) break;
        __builtin_amdgcn_s_sleep(1);
        if ((++sp & 255u) == 0u) { if (xb_ld(&bar[XB_TMO])) break; if (sp > XB_SPIN_CAP) { atomicAdd(&bar[XB_TMO], 1u); break; } }
    }
    nloc = mine > 0u ? mine : 1u; nx = cnt > 0u ? cnt : 1u;
}

__device__ __forceinline__ void xcd_barrier(const XcdBarrier& b) {
    asm volatile("s_waitcnt vmcnt(0)" ::: "memory");
    __syncthreads();
    if (threadIdx.x == 0) {
        unsigned* bar = b.bar;
        __builtin_amdgcn_s_waitcnt(0);
        unsigned nloc = b.st[0], nx = b.st[1];
        if (nloc == 0u) { xcd_barrier_complete(bar, b.x, nloc, nx); b.st[0] = nloc; b.st[1] = nx; }
        const unsigned old = xb_add(&bar[XB_XSUB(b.x)], 1u);
        const unsigned gen = old / nloc;
        if (old + 1u == (gen + 1u) * nloc) {
            __builtin_amdgcn_fence(__ATOMIC_RELEASE, "agent");
            asm volatile("s_waitcnt vmcnt(0)" ::: "memory");
            const unsigned og = xb_add(&bar[XB_TOP], 1u);
            const unsigned tg = og / nx;
            if (og + 1u == (tg + 1u) * nx) xb_add(&bar[XB_TOPGEN], 1u);
            else XB_SPIN(xb_ld(&bar[XB_TOPGEN]) == tg, bar);
            __builtin_amdgcn_fence(__ATOMIC_ACQUIRE, "agent");
            xb_add(&bar[XB_XGEN(b.x)], 1u);
            asm volatile("s_waitcnt vmcnt(0)" ::: "memory");
        } else {
            XB_SPIN(xb_ld(&bar[XB_XGEN(b.x)]) == gen, bar);
            __builtin_amdgcn_fence(__ATOMIC_ACQUIRE, "agent");
            asm volatile("s_waitcnt vmcnt(0)" ::: "memory");
        }
    }
    __syncthreads();
}

struct Args { const float* in[18]; float* out; unsigned char* ws; int ph_lo, ph_hi; };
__global__ void __launch_bounds__(512, 2) fwd(Args args) {
    extern __shared__ __attribute__((aligned(16))) unsigned char lds[];
    Frame F;
    F.lds = (LAS unsigned char*)lds; F.ldsg = (char*)lds;
    F.MISC = (volatile LAS unsigned*)(F.lds + MISC_OFF);
    F.tid = threadIdx.x; F.lane = F.tid & 63; F.wave = __builtin_amdgcn_readfirstlane(F.tid >> 6);
    F.G = gridDim.x; { const int bx = blockIdx.x; F.vcu = (F.G % 8 == 0) ? (bx % 8) * (F.G / 8) + bx / 8 : bx; }
    F.ws = args.ws; F.ctl = (gu32*)(args.ws + WS_CTL); F.out = args.out;
    F.x = args.in[0]; F.meta = args.in[1]; F.g1 = args.in[2]; F.w_in = args.in[3]; F.b_f = args.in[4]; F.q_gain = args.in[5]; F.k_gain = args.in[6];
    F.fox_gain = args.in[7]; F.sb_gain = args.in[8]; F.w_out = args.in[9]; F.g2 = args.in[10]; F.w_coarse = args.in[11]; F.b_coarse = args.in[12];
    F.w_fine = args.in[13]; F.b_fine = args.in[14]; F.w1 = args.in[15]; F.w3 = args.in[16]; F.w2 = args.in[17];
    for (int u = F.tid; u < 32; u += 512) F.MISC[u] = 0u;
    __syncthreads();
    const int lo = args.ph_lo, hi = args.ph_hi;
    XcdBarrier bar; bar.bar = (unsigned*)(F.ctl + CW_BAR); bar.x = 0; bar.st = nullptr;
    if (hi - lo > 1) bar = xcd_barrier_post((unsigned*)(F.ctl + CW_BAR), F.MISC + 8);
#define IN(k) (lo <= (k) && (k) < hi)
#define SEAM(k) do { if (IN(k) && IN((k) + 1)) xcd_barrier(bar); } while (0)
    bf16* PROJ = (bf16*)(F.ws + WS_PROJ);

    if (IN(0)) { p0_prologue(F); if (REP_PHASE == 0) { __syncthreads(); p0_prologue(F); } SEAM(0); }

    if (IN(1)) {
        { const int bh = (int)blockIdx.x - (F.G - NB * NH); if (bh >= 0 && F.wave == 0) cum_scan(F, bh); }
        pg8::DenseOrder S; S.init(F.ws + WS_U1, F.ws + WS_WIN_T, MROWS, NPROJ, DM, F.G, (int)blockIdx.x);
        pg8::EpiProj E{PROJ, (float*)(F.ws + WS_SS)};
        pg8::gemm_phase<pg8::EpiProj, pg8::DenseOrder, false>(F.lds, DM, S, E, nullptr);
        if (REP_PHASE == 1) pg8::gemm_phase<pg8::EpiProj, pg8::DenseOrder, false>(F.lds, DM, S, E, nullptr);
        if (IN(1) && IN(3)) xcd_barrier(bar);
    }

    if (IN(3)) {
        att::Tensors T{PROJ, PROJ + PROJ_TS, PROJ + 2 * PROJ_TS, PROJ + 3 * PROJ_TS, PROJ + 4 * PROJ_TS, PROJ + 5 * PROJ_TS, PROJ + 6 * PROJ_TS,
                       (const float*)(F.ws + WS_SS), (const float*)(F.ws + WS_CUM), F.q_gain, F.k_gain, F.fox_gain, F.sb_gain, (bf16*)(F.ws + WS_MIX)};
        for (int rep = 0; rep < (REP_PHASE == 3 ? 2 : 1); ++rep)
        for (int w = F.vcu; w < 256; w += F.G) { const int bh = w >> 3, s = w & 7;
#ifndef NO_FOX
            att::attn_unit<0>(F.ldsg, T, bh >> 3, bh & 7, s);
#endif
#ifndef NO_SB
            att::attn_unit<1>(F.ldsg, T, bh >> 3, bh & 7, 7 - s);
#endif
        }
        __syncthreads();
        SEAM(3);
    }
    if (IN(4)) {
        pg8::DenseOrder S; S.init(F.ws + WS_MIX, F.ws + WS_WOUT_T, TF, DM, DM, F.G, (int)blockIdx.x);
        pg8::EpiOut E{F.x, F.out};
        pg8::gemm_phase<pg8::EpiOut, pg8::DenseOrder, false>(F.lds, DM, S, E, nullptr);
        if (REP_PHASE == 4) pg8::gemm_phase<pg8::EpiOut, pg8::DenseOrder, false>(F.lds, DM, S, E, nullptr);
        SEAM(4);
    }
    if (IN(5)) { p5_router(F); SEAM(5); }

    if (IN(6)) {
        moe_prefix(F, 8);
        const LAS int* upre = (const LAS int*)(F.lds + TPRE_OFF);
        moe::Order S{F.G, (int)blockIdx.x, 8, upre, upre + 80};
        LAS int* tab = (LAS int*)(F.lds + TAB_OFF); const int* TOK = (const int*)(F.ws + WS_TOK);
        for (int i = 0; i < 8; ++i) { int e, cs, mt, cnt, cbase; if (!S.decode(i, e, cs, mt, cnt, cbase)) break;
            if (F.tid < 384) { const int p = mt * 384 + F.tid; tab[i * 384 + F.tid] = p < cnt ? (TOK[(size_t)e * TOKLD + p] >> 1) : TF; } }
        __syncthreads();
        for (int rep = 0; rep < (REP_PHASE == 6 ? 2 : 1); ++rep)
        moe::phase<DM, true>(F.lds, S, tab, (const char*)(F.ws + WS_U2), F.w1, F.w3, (bf16*)(F.ws + WS_HID));
        SEAM(6);
    }
    if (IN(7)) {
        moe_prefix(F, 16);
        const LAS int* upre = (const LAS int*)(F.lds + TPRE_OFF);
        moe::Order S{F.G, (int)blockIdx.x, 16, upre, upre + 80};
        LAS float* wtab = (LAS float*)(F.lds + TAB_OFF); const int* TOK = (const int*)(F.ws + WS_TOK); const float* RW = (const float*)(F.ws + WS_ROUTE) + TF * 4;
        for (int i = 0; i < 8; ++i) { int e, cs, mt, cnt, cbase; if (!S.decode(i, e, cs, mt, cnt, cbase)) break;
            if (F.tid < 384) { const int p = mt * 384 + F.tid; wtab[i * 384 + F.tid] = p < cnt ? RW[TOK[(size_t)e * TOKLD + p]] : 0.f; } }
        __syncthreads();
        for (int rep = 0; rep < (REP_PHASE == 7 ? 2 : 1); ++rep)
        moe::phase<DE, false>(F.lds, S, (const LAS int*)wtab, (const char*)(F.ws + WS_HID), F.w2, nullptr, (bf16*)(F.ws + WS_Y));
        SEAM(7);
    }
    if (IN(8)) { moe_prefix(F, 16); p8_combine(F); }
#undef IN
#undef SEAM
}

extern "C" void kernel_launch(void* const* d_in, const int* in_sizes, int n_in, void* d_out, int out_size, void* d_ws, size_t ws_size, hipStream_t stream) {
    static int grid = 0;
    if (grid == 0) {
        if (n_in != 18 || out_size != TF * DM || ws_size < WS_END) { fprintf(stderr, "kernel_launch: unexpected shapes (n_in %d, out %d, ws %zu); nothing launched\n", n_in, out_size, ws_size); grid = -1; return; }
        int dev = 0, cus = 0, per_cu = 0;
        if (hipGetDevice(&dev) != hipSuccess || hipDeviceGetAttribute(&cus, hipDeviceAttributeMultiprocessorCount, dev) != hipSuccess) { grid = -1; return; }
        if (hipFuncSetAttribute((const void*)fwd, hipFuncAttributeMaxDynamicSharedMemorySize, LDS_BYTES) != hipSuccess) { fprintf(stderr, "kernel_launch: hipFuncSetAttribute failed\n"); grid = -1; return; }
        if (hipOccupancyMaxActiveBlocksPerMultiprocessor(&per_cu, (const void*)fwd, 512, LDS_BYTES) != hipSuccess || per_cu < 1) fprintf(stderr, "kernel_launch: occupancy query reports %d\n", per_cu);
        (void)hipGetLastError();
        grid = cus > 0 ? cus : 256;
    }
    if (grid < 0) return;
    (void)hipMemsetAsync((char*)d_ws + WS_CTL, 0, CTL_ZERO_BYTES, stream);
    Args a{};
    for (int i = 0; i < 18; ++i) a.in[i] = (const float*)d_in[i];
    a.out = (float*)d_out; a.ws = (unsigned char*)d_ws;
    constexpr int NL = MK_N_LAUNCHES;
    for (int li = 0; li < NL; ++li) {
        a.ph_lo = (NL == 1) ? 0 : li; a.ph_hi = (NL == 1) ? NPHASE : li + 1;
        hipLaunchKernelGGL(fwd, dim3(grid), dim3(512), LDS_BYTES, stream, a);
    }
}
```

```cpp
#include <hip/hip_runtime.h>
#include <hip/hip_bf16.h>
#include <cstdio>
#include <cstdint>

#ifndef REP_PHASE
#define REP_PHASE -1
#endif
#ifndef MK_N_LAUNCHES
#define MK_N_LAUNCHES 1
#endif

constexpr int DM = 2048, NB = 4, SEQ = 2048, NMETA = 16, HD = 128, NH = 8;
constexpr int TF = NB * SEQ;
constexpr int ROW_META = TF;
constexpr int NKEYROWS = TF + NMETA;
constexpr int MROWS = 8448;
constexpr int NPROJ = 7168, LDW_IN = 7176;
constexpr int NE = 64, DE = 512;
constexpr int LPOS = SEQ + NMETA;
constexpr int CUMLD = 2112;
constexpr float EPS = 1e-6f;
constexpr float LOG2E = 1.4426950408889634f;
constexpr float QSCALE2 = 0.08838834764831845f * 1.4426950408889634f;
constexpr int NPHASE = 9;

constexpr size_t MiB = 1u << 20;
constexpr size_t WS_CTL = 0, CTL_ZERO_BYTES = 1 * MiB;
constexpr size_t WS_WIN_T = 2 * MiB;
constexpr size_t WS_WOUT_T = 30 * MiB;
constexpr size_t WS_U1 = 38 * MiB;
constexpr size_t WS_PROJ = 72 * MiB;
constexpr size_t PROJ_TS = (size_t)MROWS * 1024;
constexpr size_t WS_F = 188 * MiB;
constexpr size_t WS_CUM = 189 * MiB;
constexpr size_t WS_SS = 190 * MiB;
constexpr size_t WS_RK = 194 * MiB;
constexpr size_t WS_MT = 195 * MiB;
constexpr size_t WS_MIX = 196 * MiB;
constexpr size_t WS_U2 = 228 * MiB;
constexpr size_t WS_ROUTE = 262 * MiB;
constexpr size_t WS_TOK = 263 * MiB;
constexpr int TOKLD = 16512;
constexpr size_t WS_RB = 268 * MiB;
constexpr int NASSIGN = TF * 2;
constexpr size_t WS_HID = 272 * MiB;
constexpr size_t WS_Y = 292 * MiB;
constexpr size_t WS_END = 360 * MiB;
constexpr int CW_TMO = 0;
constexpr int CW_CNT = 1024;
constexpr int CW_BAR = 8192;

constexpr int RING_BYTES = 139264;
constexpr int TAB_OFF = RING_BYTES, TAB_BYTES = 8 * 384 * 4;
constexpr int TPRE_OFF = TAB_OFF + TAB_BYTES;
constexpr int MISC_OFF = TPRE_OFF + 1024;
constexpr int LDS_BYTES = MISC_OFF + 128;

#define GAS __attribute__((address_space(1)))
#define LAS __attribute__((address_space(3)))
typedef unsigned short bf16;
typedef unsigned v4u __attribute__((ext_vector_type(4)));
typedef unsigned v2u __attribute__((ext_vector_type(2)));
typedef float f32x4 __attribute__((ext_vector_type(4)));
typedef float f32x2 __attribute__((ext_vector_type(2)));
typedef float f32x16 __attribute__((ext_vector_type(16)));
typedef short bf16x8 __attribute__((ext_vector_type(8)));
typedef short s16x4 __attribute__((ext_vector_type(4)));
typedef GAS unsigned gu32;
#define RLX_AGENT __ATOMIC_RELAXED, __HIP_MEMORY_SCOPE_AGENT
#define LDS_WAIT() asm volatile("s_waitcnt lgkmcnt(0)" ::: "memory")
#define VM_WAIT() asm volatile("s_waitcnt vmcnt(0)" ::: "memory")
__device__ __forceinline__ unsigned cvtpk(float lo, float hi) { unsigned r; asm volatile("v_cvt_pk_bf16_f32 %0, %1, %2" : "=v"(r) : "v"(lo), "v"(hi)); return r; }
__device__ __forceinline__ float bf2f(unsigned short h) { return __uint_as_float(((unsigned)h) << 16); }
__device__ __forceinline__ float wave_sum(float v) {
#pragma unroll
    for (int o = 1; o < 64; o <<= 1) v += __shfl_xor(v, o);
    return v;
}
__device__ __forceinline__ int opaque_tid() { int t = threadIdx.x; asm volatile("" : "+v"(t)); return t; }
__device__ __forceinline__ float fast_exp2(float x) { return __builtin_amdgcn_exp2f(x); }
__device__ __forceinline__ float fast_log2(float x) { return __builtin_amdgcn_logf(x); }
__device__ __forceinline__ float fast_rcp(float x) { return __builtin_amdgcn_rcpf(x); }

namespace pg8 {
#define PG8_LAS __attribute__((address_space(3)))
typedef unsigned short bf16_t;
typedef unsigned u32x4 __attribute__((ext_vector_type(4)));
constexpr int BM = 256, BK = 64, HALF = 128, HTB = HALF * BK * 2, STAGE_BYTES = 8 * HTB, NXCD = 8, WGM = 8;
__host__ __device__ __forceinline__ int lds_byte(int r, int c) { const int st = (r >> 4) * 2 + (c >> 5), rr = r & 15, cc = c & 31, ob = rr * 64 + cc * 2; return st * 1024 + (ob ^ (((ob >> 9) & 1) << 5)); }
__host__ __device__ __forceinline__ void stage_rc(int b, int& R, int& C) { const int st = b / 1024, sb = b % 1024, swz = sb ^ (((sb >> 9) & 1) << 5); R = (st >> 1) * 16 + swz / 64; C = (st & 1) * 32 + (swz % 64) / 2; }
__host__ __device__ __forceinline__ int perm32(int rho) { const int n = rho >> 4, i = rho & 15; return 8 * (i >> 2) + 4 * n + (i & 3); }

struct Unit { int pm, pn, li; const char* A; const char* B; };

struct DenseOrder {
    int nM, nN, nwg, G, c; const char* A; const char* B; size_t tstep;
    __device__ void init(const void* A_, const void* B_, int M, int N, int K, int G_, int c_) { nM = M / BM; nN = N / BM; nwg = nM * nN; G = G_; c = c_; A = (const char*)A_; B = (const char*)B_; tstep = (size_t)BM * K * 2; }
    __device__ bool next(int i, Unit& u) const {
        const long L = (long)i * G + c; if (L >= nwg) return false;
        int wgid = (int)L; { const int q = nwg / NXCD, r = nwg % NXCD, xcd = wgid % NXCD, off = wgid / NXCD; wgid = (xcd < r ? xcd * (q + 1) : r * (q + 1) + (xcd - r) * q) + off; }
        const int nig = WGM * nN, gid = wgid / nig, fm = gid * WGM, gsz = (nM - fm) < WGM ? (nM - fm) : WGM;
        u.pm = fm + ((wgid % nig) % gsz); u.pn = (wgid % nig) / gsz; u.li = 0;
        u.A = A + (size_t)u.pm * tstep; u.B = B + (size_t)u.pn * tstep; return true;
    }
};

template <class Epi, class Sched, bool GATHER>
__device__ __forceinline__ void gemm_phase(PG8_LAS unsigned char* lds, const int K, const Sched& S, const Epi& E, const PG8_LAS int* tab) {
    const int tid = opaque_tid(), wid = __builtin_amdgcn_readfirstlane(tid >> 6), lane = tid & 63, wr = wid >> 2, wc = wid & 3, fr = lane & 15, fq = lane >> 4;
    const int nt = K / BK;
    unsigned voffA[2], voffB[2]; int RA[2], CA[2];
#pragma unroll
    for (int i = 0; i < 2; ++i) { int R, C; stage_rc(tid * 16 + i * 8192, R, C); const int Rb = Epi::PERM ? ((R & ~31) + perm32(R & 31)) : R;
        voffA[i] = (unsigned)(R * K + C) * 2u; voffB[i] = (unsigned)(Rb * K + C) * 2u; RA[i] = R; CA[i] = C; }
    const size_t kstep = (size_t)(BK * 2);
    const size_t hstep = (size_t)HALF * K * 2;
    const unsigned ldsw = (unsigned)wid * 1024u;
    const int aoff = lds_byte(wr * 64 + fr, fq * 8), boff = lds_byte(wc * 32 + fr, fq * 8);
    unsigned gA[2][2], gAn[2][2];
#define PG8_SA(b, h) (((b) * 2 + (h)) * HTB)
#define PG8_SB(b, h) ((4 + (b) * 2 + (h)) * HTB)
#define PG8_GL(gptr, ldsoff) __builtin_amdgcn_global_load_lds((const unsigned*)(gptr), (PG8_LAS unsigned*)(lds + (ldsoff)), 16, 0, 0)
#define PG8_STAGE_B(bufoff, gbase) do { _Pragma("unroll") for (int _i = 0; _i < 2; ++_i) PG8_GL((const char*)(gbase) + voffB[_i], (bufoff) + ldsw + _i * 8192); } while (0)
#define PG8_STAGE_A(bufoff, gbase, h, NX) do { _Pragma("unroll") for (int _i = 0; _i < 2; ++_i) { \
        if constexpr (GATHER) { const unsigned _vo = (NX) ? gAn[h][_i] : gA[h][_i]; PG8_GL((const char*)(gbase) + _vo, (bufoff) + ldsw + _i * 8192); } \
        else { PG8_GL((const char*)(gbase) + (size_t)(h) * hstep + voffA[_i], (bufoff) + ldsw + _i * 8192); } } } while (0)
#define PG8_GIDX(dst, li) do { if constexpr (GATHER) { _Pragma("unroll") for (int _h = 0; _h < 2; ++_h) _Pragma("unroll") for (int _i = 0; _i < 2; ++_i) \
        dst[_h][_i] = ((unsigned)tab[(li) * 256 + _h * 128 + RA[_i]] * (unsigned)K + (unsigned)CA[_i]) * 2u; } } while (0)
#define PG8_LDA(dst, b, h) do { _Pragma("unroll") for (int m = 0; m < 4; ++m) _Pragma("unroll") for (int k = 0; k < 2; ++k) dst[m][k] = *(const PG8_LAS bf16x8*)(lds + PG8_SA(b, h) + aoff + m * 2048 + k * 1024); } while (0)
#define PG8_LDB(dst, b, h) do { _Pragma("unroll") for (int n = 0; n < 2; ++n) _Pragma("unroll") for (int k = 0; k < 2; ++k) dst[n][k] = *(const PG8_LAS bf16x8*)(lds + PG8_SB(b, h) + boff + n * 2048 + k * 1024); } while (0)
#define PG8_MMA(ai, bj, At, Bt) do { __builtin_amdgcn_s_setprio(1); _Pragma("unroll") for (int m = 0; m < 4; ++m) _Pragma("unroll") for (int n = 0; n < 2; ++n) _Pragma("unroll") for (int k = 0; k < 2; ++k) \
        acc[ai][bj][m][n] = __builtin_amdgcn_mfma_f32_16x16x32_bf16(Bt[n][k], At[m][k], acc[ai][bj][m][n], 0, 0, 0); __builtin_amdgcn_s_setprio(0); } while (0)
#define PG8_WAIT_V(n) asm volatile("s_waitcnt vmcnt(" #n ")" ::: "memory")
#define PG8_WAIT_L(n) asm volatile("s_waitcnt lgkmcnt(" #n ")" ::: "memory")
#define PG8_BAR __builtin_amdgcn_s_barrier()
#define PG8_SCHED __builtin_amdgcn_sched_barrier(0)
    Unit cur, nxt; int ui = 0;
    if (!S.next(0, cur)) return;
    f32x4 acc[2][2][4][2];
#pragma unroll
    for (int a = 0; a < 2; ++a)
#pragma unroll
        for (int b = 0; b < 2; ++b)
#pragma unroll
            for (int m = 0; m < 4; ++m)
#pragma unroll
                for (int n = 0; n < 2; ++n) acc[a][b][m][n] = (f32x4){0.f, 0.f, 0.f, 0.f};
    bf16x8 At[4][2], B0[2][2], B1[2][2];
    const char* cA = cur.A; const char* cB = cur.B;
    PG8_GIDX(gA, cur.li);
    PG8_STAGE_B(PG8_SB(0, 0), cB); PG8_STAGE_B(PG8_SB(0, 1), cB + hstep); PG8_STAGE_A(PG8_SA(0, 0), cA, 0, false); PG8_STAGE_A(PG8_SA(0, 1), cA, 1, false);
    if (wr == 1) PG8_BAR;
    PG8_WAIT_V(2); PG8_BAR;
    PG8_STAGE_B(PG8_SB(1, 0), cB + kstep); PG8_STAGE_A(PG8_SA(1, 0), cA + kstep, 0, false); PG8_STAGE_B(PG8_SB(1, 1), cB + hstep + kstep);
    PG8_WAIT_V(6); PG8_BAR;
    for (;;) {
        const bool has_next = S.next(ui + 1, nxt);
        const char* nA = has_next ? nxt.A : cA; const char* nB = has_next ? nxt.B : cB;
        if constexpr (GATHER) { if (has_next) { PG8_GIDX(gAn, nxt.li); } else {
#pragma unroll
            for (int _h = 0; _h < 2; ++_h)
#pragma unroll
                for (int _i = 0; _i < 2; ++_i) gAn[_h][_i] = gA[_h][_i]; } }
        for (int t = 0; t < nt; t += 2) {
            const bool last = (t == nt - 2);
            const char* a1 = cA + (size_t)(t + 1) * kstep;
            const char* a2 = last ? nA : cA + (size_t)(t + 2) * kstep; const char* b2 = last ? nB : cB + (size_t)(t + 2) * kstep;
            const char* a3 = a2 + kstep; const char* b3 = b2 + kstep;
            PG8_LDB(B0, 0, 0); PG8_LDB(B1, 0, 1); PG8_SCHED; PG8_LDA(At, 0, 0); PG8_STAGE_A(PG8_SA(1, 1), a1, 1, false);
            PG8_WAIT_V(8); PG8_WAIT_L(0); PG8_BAR; PG8_MMA(0, 0, At, B0); PG8_MMA(0, 1, At, B1); PG8_BAR; PG8_SCHED;
            PG8_LDA(At, 0, 1); PG8_STAGE_B(PG8_SB(0, 0), b2); PG8_STAGE_B(PG8_SB(0, 1), b2 + hstep); PG8_STAGE_A(PG8_SA(0, 0), a2, 0, last);
            PG8_WAIT_V(8); PG8_WAIT_L(0); PG8_BAR; PG8_MMA(1, 0, At, B0); PG8_MMA(1, 1, At, B1); PG8_BAR; PG8_SCHED;
            PG8_LDB(B0, 1, 0); PG8_LDB(B1, 1, 1); PG8_SCHED; PG8_LDA(At, 1, 0); PG8_STAGE_A(PG8_SA(0, 1), a2, 1, last);
            PG8_WAIT_V(8); PG8_WAIT_L(0); PG8_BAR; PG8_MMA(0, 0, At, B0); PG8_MMA(0, 1, At, B1); PG8_BAR; PG8_SCHED;
            PG8_LDA(At, 1, 1); PG8_STAGE_B(PG8_SB(1, 0), b3); PG8_STAGE_B(PG8_SB(1, 1), b3 + hstep); PG8_STAGE_A(PG8_SA(1, 0), a3, 0, last);
            PG8_WAIT_V(8); PG8_WAIT_L(0); PG8_BAR; PG8_MMA(1, 0, At, B0); PG8_MMA(1, 1, At, B1); PG8_BAR; PG8_SCHED;
        }
        if (wr == 0) PG8_BAR;
        E(acc, cur, wr, wc, fr, fq);
        if (!has_next) break;
#pragma unroll
        for (int a = 0; a < 2; ++a)
#pragma unroll
            for (int b = 0; b < 2; ++b)
#pragma unroll
                for (int m = 0; m < 4; ++m)
#pragma unroll
                    for (int n = 0; n < 2; ++n) acc[a][b][m][n] = (f32x4){0.f, 0.f, 0.f, 0.f};
        cur = nxt; cA = nA; cB = nB; ++ui;
        if constexpr (GATHER) {
#pragma unroll
            for (int _h = 0; _h < 2; ++_h)
#pragma unroll
                for (int _i = 0; _i < 2; ++_i) gA[_h][_i] = gAn[_h][_i]; }
        if (wr == 1) PG8_BAR;
    }
    PG8_WAIT_V(0);
    PG8_BAR;
#undef PG8_SA
#undef PG8_SB
#undef PG8_GL
#undef PG8_STAGE_A
#undef PG8_STAGE_B
#undef PG8_GIDX
#undef PG8_LDA
#undef PG8_LDB
#undef PG8_MMA
#undef PG8_WAIT_V
#undef PG8_WAIT_L
#undef PG8_BAR
#undef PG8_SCHED
}

struct EpiProj {
    static constexpr bool PERM = true;
    bf16_t* P; float* SS;
    __device__ __forceinline__ void operator()(const f32x4 (&acc)[2][2][4][2], const Unit& u, int wr, int wc, int fr, int fq) const {
        const int t = u.pn >> 2, colt = (u.pn & 3) * BM;
        bf16_t* base = P + (size_t)t * PROJ_TS;
        const int row0 = u.pm * BM + wr * 64 + fr, col0 = colt + wc * 32 + 8 * fq;
        if (t <= 1) {
#pragma unroll
            for (int ai = 0; ai < 2; ++ai)
#pragma unroll
                for (int m = 0; m < 4; ++m)
#pragma unroll
                    for (int bj = 0; bj < 2; ++bj) {
                        const f32x4 a = acc[ai][bj][m][0], b = acc[ai][bj][m][1];
                        float s = (a[0] * a[0] + a[1] * a[1]) + (a[2] * a[2] + a[3] * a[3]) + (b[0] * b[0] + b[1] * b[1]) + (b[2] * b[2] + b[3] * b[3]);
                        s += __shfl_xor(s, 16); s += __shfl_xor(s, 32);
                        if (fq == 0) SS[(((size_t)t * MROWS + (row0 + ai * HALF + m * 16)) * 8 + ((u.pn & 3) * 2 + bj)) * 4 + wc] = s;
                    }
        }
#pragma unroll
        for (int ai = 0; ai < 2; ++ai)
#pragma unroll
            for (int m = 0; m < 4; ++m) { bf16_t* rowp = base + (size_t)(row0 + ai * HALF + m * 16) * 1024 + col0;
#pragma unroll
                for (int bj = 0; bj < 2; ++bj) { f32x4 v0 = acc[ai][bj][m][0], v1 = acc[ai][bj][m][1];
                    if (t == 3) {
#pragma unroll
                        for (int j = 0; j < 4; ++j) { v0[j] = fast_rcp(1.f + fast_exp2(-v0[j] * LOG2E)); v1[j] = fast_rcp(1.f + fast_exp2(-v1[j] * LOG2E)); } }
                    if (t == 4) { v0 = v0 * QSCALE2; v1 = v1 * QSCALE2; }
                    u32x4 w; w.x = cvtpk(v0[0], v0[1]); w.y = cvtpk(v0[2], v0[3]); w.z = cvtpk(v1[0], v1[1]); w.w = cvtpk(v1[2], v1[3]);
                    *(u32x4*)(rowp + bj * HALF) = w; } }
    }
};
struct EpiOut {
    static constexpr bool PERM = false;
    const float* X; float* O;
    __device__ __forceinline__ void operator()(const f32x4 (&acc)[2][2][4][2], const Unit& u, int wr, int wc, int fr, int fq) const {
        const int row0 = u.pm * BM + wr * 64 + fr, col0 = u.pn * BM + wc * 32 + 4 * fq;
#pragma unroll
        for (int ai = 0; ai < 2; ++ai)
#pragma unroll
            for (int m = 0; m < 4; ++m) { const size_t off = (size_t)(row0 + ai * HALF + m * 16) * DM + col0;
#pragma unroll
                for (int bj = 0; bj < 2; ++bj)
#pragma unroll
                    for (int n = 0; n < 2; ++n) { const f32x4 xv = *(const f32x4*)(X + off + bj * HALF + n * 16); *(f32x4*)(O + off + bj * HALF + n * 16) = xv + acc[ai][bj][m][n]; } }
    }
};
}

namespace moe {
constexpr int MT = 384, BKT = 64, A_BYTES = MT * BKT * 2, B_PITCH = 320, B_BYTES = BKT * B_PITCH;
constexpr int OFF_A = 0, OFF_B = 2 * A_BYTES, STAGE_END = 2 * A_BYTES + 2 * B_BYTES;
typedef short v4i16_t __attribute__((ext_vector_type(4)));
__device__ __forceinline__ void glds16(const void* gsrc, unsigned lds_dst) { unsigned keep;
    asm volatile("s_mov_b32 %0, m0\n\ts_mov_b32 m0, %2\n\ts_nop 0\n\tglobal_load_lds_dwordx4 %1, off\n\ts_mov_b32 m0, %0" : "=&s"(keep) : "v"(gsrc), "s"(lds_dst) : "memory"); }
__device__ __forceinline__ s16x4 vtr(const LAS unsigned char* p) { return __builtin_bit_cast(s16x4, __builtin_amdgcn_ds_read_tr16_b64_v4i16((LAS v4i16_t*)p)); }

struct Order {
    int G, c, ncs; const LAS int* upre; const LAS int* cpre;
    __device__ bool decode(int i, int& e, int& cs, int& mt, int& cnt, int& cbase) const {
        const int L = i * G + c; if (L >= __builtin_amdgcn_readfirstlane(upre[NE])) return false;
        int lo = 0, hi = NE;
        while (hi - lo > 1) { const int mid = (lo + hi) >> 1; const int v = __builtin_amdgcn_readfirstlane(upre[mid]); if (v <= L) lo = mid; else hi = mid; }
        e = lo; const int u0 = __builtin_amdgcn_readfirstlane(upre[e]), u1 = __builtin_amdgcn_readfirstlane(upre[e + 1]), ntm = (u1 - u0) / ncs, r = L - u0;
        cs = r / ntm; mt = r - cs * ntm; cbase = __builtin_amdgcn_readfirstlane(cpre[e]); cnt = __builtin_amdgcn_readfirstlane(cpre[e + 1]) - cbase; return true;
    }
};

template <int KDIM, bool G1, bool WW>
__device__ __forceinline__ void unit_kloop(LAS unsigned char* lds, f32x16 (&acc)[3][2], const int tid, const int wid, const int lane, const LAS int* tabrow, const int arow0, const char* Abase, const float* bsrc0) {
    constexpr int NTK = KDIM / BKT; constexpr int LDB = G1 ? DE : DM;
    const int r32 = lane & 31, hi = lane >> 5, wr = wid >> 1, wc = wid & 1;
    unsigned aoff[12];
    if constexpr (!WW) {
#pragma unroll
        for (int q = 0; q < 12; ++q) { const int row = 8 * (4 * q + (wid & 3)) + (lane >> 3); const int arow = G1 ? tabrow[row] : arow0 + row;
            aoff[q] = (unsigned)arow * (unsigned)(KDIM * 2) + (unsigned)(((lane & 7) ^ (row & 7)) * 16); } }
    const int tl = tid & 255, bk = tl >> 5;
    const float* bsrc = bsrc0 + (size_t)bk * LDB;
    const unsigned bwr = (unsigned)(bk * B_PITCH + (tl & 31) * 8);
    const unsigned trbv = (unsigned)(uintptr_t)(lds + OFF_B + (8 * hi + ((lane & 15) >> 2)) * B_PITCH + (16 * ((lane >> 4) & 1) + 4 * (lane & 3)) * 2 + wc * 64);
    const unsigned ldsA = (unsigned)(uintptr_t)(lds + OFF_A) + (unsigned)(wid & 3) * 1024u;
    const LAS unsigned char* xa[4];
#pragma unroll
    for (int ks = 0; ks < 4; ++ks) xa[ks] = lds + OFF_A + (32 * wr + r32) * 128 + (((2 * ks + hi) ^ (r32 & 7)) * 16);
    f32x4 R0[8], R1[8];
#define MOE_DMA_A(t, buf) do { if constexpr (!WW) { _Pragma("unroll") for (int q = 0; q < 12; ++q) \
        glds16(Abase + aoff[q] + (size_t)(t) * (BKT * 2), (unsigned)__builtin_amdgcn_readfirstlane((int)(ldsA + (buf) * A_BYTES + q * 4096))); } } while (0)
#define MOE_LDB(R, t) do { if constexpr (WW) { const int t_ = (t) < NTK ? (t) : NTK - 1; _Pragma("unroll") for (int i = 0; i < 8; ++i) R[i] = __builtin_nontemporal_load((const f32x4*)(bsrc + (size_t)(t_ * BKT + 8 * i) * LDB)); } asm volatile("" ::: "memory"); __builtin_amdgcn_sched_barrier(0); } while (0)
#define MOE_WRB(R, buf) do { if constexpr (WW) { asm volatile("s_waitcnt vmcnt(8)" ::: "memory"); _Pragma("unroll") for (int i = 0; i < 8; ++i) *(LAS v2u*)(lds + OFF_B + (buf) * B_BYTES + bwr + i * 8 * B_PITCH) = (v2u){cvtpk(R[i].x, R[i].y), cvtpk(R[i].z, R[i].w)}; } } while (0)
#define MOE_TR4(W0, W1, W2, W3, off) asm volatile("ds_read_b64_tr_b16 %0, %4 offset:%5\n\tds_read_b64_tr_b16 %1, %4 offset:%6\n\tds_read_b64_tr_b16 %2, %4 offset:%7\n\tds_read_b64_tr_b16 %3, %4 offset:%8" \
        : "=&v"(W0), "=&v"(W1), "=&v"(W2), "=&v"(W3) : "v"(trbv), "i"(off), "i"((off) + 4 * B_PITCH), "i"((off) + 128), "i"((off) + 4 * B_PITCH + 128) : "memory")
#define MOE_COMPUTE(buf) do { _Pragma("unroll") for (int ks = 0; ks < 4; ++ks) { \
        s16x4 l0_, h0_, l1_, h1_; bf16x8 xf[3]; \
        MOE_TR4(l0_, h0_, l1_, h1_, (buf) * B_BYTES + ks * 16 * B_PITCH); \
        _Pragma("unroll") for (int j = 0; j < 3; ++j) xf[j] = *(const LAS bf16x8*)(xa[ks] + (buf) * A_BYTES + j * 16384); \
        asm volatile("s_waitcnt lgkmcnt(0)" ::: "memory"); __builtin_amdgcn_sched_barrier(0); \
        const bf16x8 wf0 = (bf16x8){l0_[0], l0_[1], l0_[2], l0_[3], h0_[0], h0_[1], h0_[2], h0_[3]}, wf1 = (bf16x8){l1_[0], l1_[1], l1_[2], l1_[3], h1_[0], h1_[1], h1_[2], h1_[3]}; \
        _Pragma("unroll") for (int j = 0; j < 3; ++j) { acc[j][0] = __builtin_amdgcn_mfma_f32_32x32x16_bf16(wf0, xf[j], acc[j][0], 0, 0, 0); acc[j][1] = __builtin_amdgcn_mfma_f32_32x32x16_bf16(wf1, xf[j], acc[j][1], 0, 0, 0); } } } while (0)
#define MOE_ENDT() do { if constexpr (!WW) asm volatile("s_waitcnt vmcnt(0)" ::: "memory"); LDS_WAIT(); __builtin_amdgcn_s_barrier(); } while (0)
#define MOE_STEP(t, buf, RN) do { MOE_DMA_A((t) + 1 < NTK ? (t) + 1 : (t), 1 - (buf)); MOE_COMPUTE(buf); MOE_WRB(RN, 1 - (buf)); MOE_LDB(RN, (t) + 3); MOE_ENDT(); } while (0)
    MOE_LDB(R0, 0); MOE_LDB(R1, 1); MOE_DMA_A(0, 0);
    MOE_WRB(R0, 0); MOE_LDB(R0, 2);
    MOE_ENDT();
    for (int t = 0; t < NTK; t += 2) { MOE_STEP(t, 0, R1); MOE_STEP(t + 1, 1, R0); }
    asm volatile("s_waitcnt vmcnt(0)" ::: "memory");
#undef MOE_DMA_A
#undef MOE_LDB
#undef MOE_WRB
#undef MOE_TR4
#undef MOE_COMPUTE
#undef MOE_ENDT
#undef MOE_STEP
}

template <int KDIM, bool G1>
__device__ __forceinline__ void phase(LAS unsigned char* lds, const Order& S, const LAS int* tab, const char* Abase, const float* Wa, const float* Wb, bf16* Out) {
    const int tid = opaque_tid(), wid = __builtin_amdgcn_readfirstlane(tid >> 6), lane = tid & 63, r32 = lane & 31, hi = lane >> 5, wr = wid >> 1, wc = wid & 1;
    constexpr int LDB = G1 ? DE : DM;
    for (int ui = 0;; ++ui) {
        int e, cs, mt, cnt, cbase; if (!S.decode(ui, e, cs, mt, cnt, cbase)) break;
        const int rows_valid = cnt - MT * mt;
        const int bn = (tid & 31) * 4;
        const float* bsrc0 = G1 ? ((bn < 64 ? Wa : Wb) + (size_t)e * DM * DE + 64 * cs + (bn & 63)) : (Wa + (size_t)e * DE * DM + 128 * cs + bn);
        f32x16 acc[3][2];
#pragma unroll
        for (int j = 0; j < 3; ++j) { acc[j][0] = f32x16{}; acc[j][1] = f32x16{}; }
        __syncthreads();
        if (wid >= 4) unit_kloop<KDIM, G1, true>(lds, acc, tid, wid, lane, tab + ui * MT, cbase + MT * mt, Abase, bsrc0);
        else unit_kloop<KDIM, G1, false>(lds, acc, tid, wid, lane, tab + ui * MT, cbase + MT * mt, Abase, bsrc0);
#pragma unroll
        for (int j = 0; j < 3; ++j) { const int row = 32 * (wr + 4 * j) + r32;
            if (row < rows_valid) { const size_t orow = (size_t)(cbase + MT * mt + row);
                if (G1) { bf16* op = Out + orow * DE + 64 * cs + 32 * wc + 4 * hi;
#pragma unroll
                    for (int g = 0; g < 4; ++g) { float h4[4];
#pragma unroll
                        for (int i2 = 0; i2 < 4; ++i2) { const float a = acc[j][0][4 * g + i2], b = acc[j][1][4 * g + i2]; h4[i2] = a * fast_rcp(1.f + fast_exp2(-a * LOG2E)) * b; }
                        *(v2u*)(op + 8 * g) = (v2u){cvtpk(h4[0], h4[1]), cvtpk(h4[2], h4[3])}; } }
                else { const float w = ((const LAS float*)tab)[ui * MT + row]; bf16* op = Out + orow * DM + 128 * cs + 32 * wc + 4 * hi;
#pragma unroll
                    for (int nbi = 0; nbi < 2; ++nbi)
#pragma unroll
                        for (int g = 0; g < 4; ++g) *(v2u*)(op + 64 * nbi + 8 * g) = (v2u){cvtpk(acc[j][nbi][4 * g] * w, acc[j][nbi][4 * g + 1] * w), cvtpk(acc[j][nbi][4 * g + 2] * w, acc[j][nbi][4 * g + 3] * w)}; } } }
    }
}
}

namespace att {
#define KSWZ(row, colB) ((row) * 256 + ((colB) ^ (((row) & 7) << 4)))
#define SBAR() __builtin_amdgcn_sched_barrier(0)
constexpr int SHM_V = 16384, SHM_K = 16384;
constexpr int KS_OFF = 32768, WSF_OFF = 33792, WSF_FLOATS = 1152;
__device__ __forceinline__ int v_st(int k, int c) { const int kk = (k & ~0xC) | ((k & 4) << 1) | ((k & 8) >> 1); return ((kk >> 3) * 4 + (c >> 5)) * 512 + ((kk & 7) * 32 + (c & 31)) * 2; }
__device__ __forceinline__ int v_rd_base(int lane) { return ((lane & 3) << 3) | (((lane >> 2) & 3) << 6) | (((lane >> 4) & 1) << 5) | (((lane >> 5) & 1) << 8); }
constexpr int v_rd_off(int d0, int ks, int half) { return d0 * 512 + ks * 4096 + half * 2048; }
__device__ __forceinline__ int crow(int r, int hi) { return (r & 3) + 8 * (r >> 2) + 4 * hi; }

__device__ __forceinline__ void qkt(f32x16& p0, f32x16& p1, const char* K_lds, int r32, int hi, const bf16x8* qr) {
    p0 = f32x16{}; p1 = f32x16{};
    const char* kb[4];
#pragma unroll
    for (int dd = 0; dd < 4; ++dd) kb[dd] = K_lds + KSWZ(r32, (dd * 16 + hi * 8) * 2);
#pragma unroll
    for (int d0 = 0; d0 < 8; ++d0) { const char* a = kb[d0 & 3] + (d0 >> 2) * 128;
        bf16x8 b0 = *reinterpret_cast<const bf16x8*>(a);
        bf16x8 b1 = *reinterpret_cast<const bf16x8*>(a + 32 * 256);
        p0 = __builtin_amdgcn_mfma_f32_32x32x16_bf16(b0, qr[d0], p0, 0, 0, 0);
        p1 = __builtin_amdgcn_mfma_f32_32x32x16_bf16(b1, qr[d0], p1, 0, 0, 0); }
}
__device__ __forceinline__ void pv_tile(f32x16* o, int vb0, bf16x8 pa0, bf16x8 pa1, bf16x8 pa2, bf16x8 pa3) {
#define TRRD(dst, off) asm volatile("ds_read_b64_tr_b16 %0, %1 offset:%2" : "=&v"(dst) : "v"(vb0), "i"(off) : "memory")
#define PV_D0(d0) do { s16x4 l0, l1, l2, l3, h0, h1, h2, h3; constexpr int b_ = v_rd_off(d0, 0, 0); \
        TRRD(l0, b_); TRRD(h0, b_ + 2048); TRRD(l1, b_ + 4096); TRRD(h1, b_ + 6144); TRRD(l2, b_ + 8192); TRRD(h2, b_ + 10240); TRRD(l3, b_ + 12288); TRRD(h3, b_ + 14336); \
        asm volatile("s_waitcnt lgkmcnt(0)" ::: "memory"); SBAR(); \
        o[d0] = __builtin_amdgcn_mfma_f32_32x32x16_bf16(pa0, (bf16x8){l0[0], l0[1], l0[2], l0[3], h0[0], h0[1], h0[2], h0[3]}, o[d0], 0, 0, 0); \
        o[d0] = __builtin_amdgcn_mfma_f32_32x32x16_bf16(pa1, (bf16x8){l1[0], l1[1], l1[2], l1[3], h1[0], h1[1], h1[2], h1[3]}, o[d0], 0, 0, 0); \
        o[d0] = __builtin_amdgcn_mfma_f32_32x32x16_bf16(pa2, (bf16x8){l2[0], l2[1], l2[2], l2[3], h2[0], h2[1], h2[2], h2[3]}, o[d0], 0, 0, 0); \
        o[d0] = __builtin_amdgcn_mfma_f32_32x32x16_bf16(pa3, (bf16x8){l3[0], l3[1], l3[2], l3[3], h3[0], h3[1], h3[2], h3[3]}, o[d0], 0, 0, 0); } while (0)
    PV_D0(0); PV_D0(1); PV_D0(2); PV_D0(3);
#undef PV_D0
#undef TRRD
}
#define PK4(P, B_, OUT) do { unsigned a0 = cvtpk(P[B_+0], P[B_+1]), a1 = cvtpk(P[B_+2], P[B_+3]); \
        unsigned b0 = cvtpk(P[B_+4], P[B_+5]), b1 = cvtpk(P[B_+6], P[B_+7]); \
        auto r0 = __builtin_amdgcn_permlane32_swap(a0, b0, false, false); auto r1 = __builtin_amdgcn_permlane32_swap(a1, b1, false, false); \
        v4u w = {r0[0], r1[0], r0[1], r1[1]}; OUT = *reinterpret_cast<bf16x8*>(&w); } while (0)

struct Tensors {
    const bf16* QA; const bf16* KA; const bf16* VA; const bf16* GA; const bf16* QB; const bf16* KB; const bf16* VB;
    const float* SS; const float* CUM;
    const float* q_gain; const float* k_gain;
    const float* fox_gain; const float* sb_gain;
    bf16* MIX;
};

template <int TYP>
__device__ __forceinline__ void attn_unit(char* lds, const Tensors& T, const int b, const int h, const int qb) {
    const int tid = opaque_tid(), wid = __builtin_amdgcn_readfirstlane(tid >> 6), lane = tid & 63, r32 = lane & 31, hi = lane >> 5;
    char* V_lds = lds; char* K_lds = lds + SHM_V;
    float* ks_rk = (float*)(lds + KS_OFF); float* ks_nc = ks_rk + 64; int* wdone = (int*)(lds + KS_OFF + 512);
    float* wsf = (float*)(lds + WSF_OFF) + wid * WSF_FLOATS; float* part = wsf; float* li_l = wsf + 1056; float* rs_l = wsf + 1088;
    const bf16* Qp = TYP == 0 ? T.QA : T.QB; const bf16* Kp = TYP == 0 ? T.KA : T.KB; const bf16* Vp = TYP == 0 ? T.VA : T.VB;
    const int frow0 = b * SEQ + qb * 256 + wid * 32;
    const int cbase = (b * NH + h) * CUMLD;
    bf16x8 qr[8];
#pragma unroll
    for (int d0 = 0; d0 < 8; ++d0) qr[d0] = *reinterpret_cast<const bf16x8*>(Qp + (size_t)(frow0 + r32) * 1024 + h * HD + d0 * 16 + hi * 8);
    float mt2 = 0.f;
    if (TYP == 0) {
        const f32x4 sp = *(const f32x4*)(T.SS + ((size_t)(frow0 + r32) * 8 + h) * 4);
        const float rstd = (1.0f / sqrtf(((sp.x + sp.y) + (sp.z + sp.w)) * (1.f / HD) + EPS)) * QSCALE2;
        float n2 = 0.f;
#pragma unroll
        for (int d0 = 0; d0 < 8; ++d0) { const int db = d0 * 16 + hi * 8;
            const f32x4 ga = *(const f32x4*)(T.q_gain + db), gb = *(const f32x4*)(T.q_gain + db + 4), ka = *(const f32x4*)(T.k_gain + db), kb = *(const f32x4*)(T.k_gain + db + 4);
            const float g8[8] = {ga.x * ka.x, ga.y * ka.y, ga.z * ka.z, ga.w * ka.w, gb.x * kb.x, gb.y * kb.y, gb.z * kb.z, gb.w * kb.w};
            v4u w = *reinterpret_cast<v4u*>(&qr[d0]); unsigned ww[4] = {w.x, w.y, w.z, w.w};
#pragma unroll
            for (int i = 0; i < 4; ++i) { const float lo = __uint_as_float(ww[i] << 16) * rstd * g8[2 * i], hi2 = __uint_as_float(ww[i] & 0xffff0000u) * rstd * g8[2 * i + 1]; n2 += lo * lo + hi2 * hi2; ww[i] = cvtpk(lo, hi2); }
            w = (v4u){ww[0], ww[1], ww[2], ww[3]}; qr[d0] = *reinterpret_cast<bf16x8*>(&w); }
        n2 += __shfl_xor(n2, 32);
        mt2 = sqrtf(n2 * (float)HD);
    }
    const int qp = 64 + qb * 256 + wid * 32 + r32;
    const int qpmin = 64 + qb * 256 + wid * 32, qpmax = qpmin + 31;
    float bias_t = 0.f, cum_t = 0.f, Rrun = 0.f, l_reg = 0.f;
    if (TYP == 0) { cum_t = T.CUM[cbase + qp - 48]; bias_t = cum_t - mt2; rs_l[r32] = cum_t; }
    bool wave_done = false;
    if (lane == 0) wdone[wid] = 0;
    f32x16 o[4] = {};
    const int sr = tid >> 4, sc = (tid & 15) * 8;
    const int vst0 = v_st(sr, sc), vst1 = v_st(32 + sr, sc), kws = KSWZ(sr, sc * 2);
    const int vb0 = (int)(uintptr_t)V_lds + v_rd_base(lane);
    bf16x8 st_k0, st_k1, st_v0, st_v1; float st_rk = 0.f, st_nc = 0.f;
#define KEYROW(j, i) ((j) == 0 ? ((i) >= 48 ? ROW_META + (i) - 48 : ROW_META) : b * SEQ + 64 * ((j) - 1) + (i))
#define TLOAD(j) do { const size_t r0_ = (size_t)KEYROW(j, sr) * 1024 + h * HD + sc, r1_ = (size_t)KEYROW(j, 32 + sr) * 1024 + h * HD + sc; \
        st_k0 = *reinterpret_cast<const bf16x8*>(Kp + r0_); st_k1 = *reinterpret_cast<const bf16x8*>(Kp + r1_); \
        st_v0 = *reinterpret_cast<const bf16x8*>(Vp + r0_); st_v1 = *reinterpret_cast<const bf16x8*>(Vp + r1_); \
        if (TYP == 0 && tid < 64) { const int kr_ = KEYROW(j, tid); const int pos_ = (j) == 0 ? (tid >= 48 ? tid - 48 : 0) : 16 + 64 * ((j) - 1) + tid; \
            const f32x4 sk_ = *(const f32x4*)(T.SS + (((size_t)MROWS + kr_) * 8 + h) * 4); st_rk = 1.0f / sqrtf(((sk_.x + sk_.y) + (sk_.z + sk_.w)) * (1.f / HD) + EPS); st_nc = -T.CUM[cbase + pos_]; } } while (0)
    int j = 4 * qb + 4;
    TLOAD(j);
    for (; j >= 0; --j) {
        __syncthreads();
        { const v4u d0 = *(const v4u*)wdone, d1 = *((const v4u*)wdone + 1);
          if (__builtin_amdgcn_readfirstlane((d0.x & d0.y & d0.z & d0.w) & (d1.x & d1.y & d1.z & d1.w)) != 0u) break; }
        *(bf16x8*)(K_lds + kws) = st_k0; *(bf16x8*)(K_lds + kws + 32 * 256) = st_k1;
        *(bf16x8*)(V_lds + vst0) = st_v0; *(bf16x8*)(V_lds + vst1) = st_v1;
        if (TYP == 0 && tid < 64) { ks_rk[tid] = st_rk; ks_nc[tid] = st_nc; }
        __syncthreads();
        if (j > 0) TLOAD(j - 1);
        if (wave_done || 64 * j > qpmax) continue;
        f32x16 p0, p1;
        qkt(p0, p1, K_lds, r32, hi, qr);
        const bool need_mask = (j == 0) || (64 * j + 63 > qpmin - (TYP == 1 ? 1 : 0));
        const int kp0 = 64 * j + 4 * hi;
        bf16x8 pa0, pa1, pa2, pa3;
        if (TYP == 0) {
#pragma unroll
            for (int q = 0; q < 8; ++q) {
                const f32x4 rkv = *(const f32x4*)(ks_rk + 8 * q + 4 * hi), ncv = *(const f32x4*)(ks_nc + 8 * q + 4 * hi);
                if (q < 4) {
#pragma unroll
                    for (int i = 0; i < 4; ++i) p0[4 * q + i] = fmaf(p0[4 * q + i], rkv[i], ncv[i]) + bias_t;
                } else {
#pragma unroll
                    for (int i = 0; i < 4; ++i) p1[4 * (q - 4) + i] = fmaf(p1[4 * (q - 4) + i], rkv[i], ncv[i]) + bias_t;
                }
                asm volatile("" ::: "memory");
            }
            if (need_mask) {
#pragma unroll
                for (int r = 0; r < 16; ++r) { const int kp = kp0 + (r & 3) + 8 * (r >> 2);
                    if (!(kp <= qp && kp >= 48)) p0[r] = -__builtin_inff();
                    if (!(kp + 32 <= qp && kp + 32 >= 48)) p1[r] = -__builtin_inff(); }
            }
            float ps = 0.f;
#pragma unroll
            for (int r = 0; r < 16; ++r) { p0[r] = fast_exp2(p0[r]); p1[r] = fast_exp2(p1[r]); ps += p0[r] + p1[r]; }
            l_reg += ps;
        } else {
            f32x16 k0, k1;
#pragma unroll
            for (int r = 0; r < 16; ++r) {
                { const float z = p0[r], sp = fmaxf(z, 0.f) + fast_log2(1.f + fast_exp2(-fabsf(z))); k0[r] = -sp; p0[r] = z - sp; }
                { const float z = p1[r], sp = fmaxf(z, 0.f) + fast_log2(1.f + fast_exp2(-fabsf(z))); k1[r] = -sp; p1[r] = z - sp; }
            }
            if (need_mask) {
#pragma unroll
                for (int r = 0; r < 16; ++r) { const int kp = kp0 + (r & 3) + 8 * (r >> 2);
                    if (!(kp < qp && kp >= 48)) { p0[r] = -__builtin_inff(); k0[r] = 0.f; }
                    if (!(kp + 32 < qp && kp + 32 >= 48)) { p1[r] = -__builtin_inff(); k1[r] = 0.f; } }
            }
            float so = 0.f, spi = 0.f;
#pragma unroll
            for (int i = 7; i >= 0; --i) {
                const float g = (i < 4) ? (k0[4 * (i & 3)] + k0[4 * (i & 3) + 1]) + (k0[4 * (i & 3) + 2] + k0[4 * (i & 3) + 3]) : (k1[4 * (i & 3)] + k1[4 * (i & 3) + 1]) + (k1[4 * (i & 3) + 2] + k1[4 * (i & 3) + 3]);
                const float spn = spi + __shfl_xor(g, 32);
                const float off = Rrun + so + (hi ? spi : spn);
                if (i < 4) { const float l3 = off, l2 = l3 + k0[4 * i + 3], l1 = l2 + k0[4 * i + 2], l0 = l1 + k0[4 * i + 1];
                    p0[4 * i + 3] = fast_exp2(p0[4 * i + 3] + l3); p0[4 * i + 2] = fast_exp2(p0[4 * i + 2] + l2); p0[4 * i + 1] = fast_exp2(p0[4 * i + 1] + l1); p0[4 * i] = fast_exp2(p0[4 * i] + l0); }
                else { const int ii = i - 4; const float l3 = off, l2 = l3 + k1[4 * ii + 3], l1 = l2 + k1[4 * ii + 2], l0 = l1 + k1[4 * ii + 1];
                    p1[4 * ii + 3] = fast_exp2(p1[4 * ii + 3] + l3); p1[4 * ii + 2] = fast_exp2(p1[4 * ii + 2] + l2); p1[4 * ii + 1] = fast_exp2(p1[4 * ii + 1] + l1); p1[4 * ii] = fast_exp2(p1[4 * ii] + l0); }
                so += g; spi = spn;
            }
            Rrun += so + spi;
        }
        PK4(p0, 0, pa0); PK4(p0, 8, pa1); PK4(p1, 0, pa2); PK4(p1, 8, pa3);
        pv_tile(o, vb0, pa0, pa1, pa2, pa3);
        if (j > 0) { bool conv;
            if (TYP == 0) { const float lt = l_reg + __shfl_xor(l_reg, 32); conv = (rs_l[r32] + ks_nc[0]) <= fast_log2(lt) - 41.f; }
            else conv = Rrun <= -30.f;
            if (__all(conv)) { wave_done = true; if (lane == 0) wdone[wid] = 1; } }
    }
#undef TLOAD
#undef KEYROW
    __syncthreads();
    int lane_e = lane, frow_e = frow0;
    asm volatile("" : "+v"(lane_e), "+s"(frow_e));
    const int r32e = lane_e & 31, hie = lane_e >> 5;
    if (TYP == 0) {
        l_reg += __shfl_xor(l_reg, 32);
        if (hie == 0) li_l[r32e] = fast_rcp(l_reg);
        LDS_WAIT();
#pragma unroll
        for (int r = 0; r < 16; ++r) { const float il = li_l[crow(r, hie)];
#pragma unroll
            for (int d0 = 0; d0 < 4; ++d0) o[d0][r] *= il; }
    }
#pragma unroll
    for (int r = 0; r < 16; ++r) { float s = 0.f;
#pragma unroll
        for (int d0 = 0; d0 < 4; ++d0) s += o[d0][r] * o[d0][r];
        part[crow(r, hie) * 33 + r32e] = s; }
    LDS_WAIT();
    { float s = 0.f;
#pragma unroll
      for (int c = 0; c < 16; ++c) s += part[r32e * 33 + hie * 16 + c];
      s += __shfl_xor(s, 32);
      if (hie == 0) rs_l[r32e] = 1.0f / sqrtf(s * (1.f / HD) + EPS); }
    LDS_WAIT();
    const float* gain = (TYP == 0 ? T.fox_gain : T.sb_gain) + h * HD;
    float gn[4];
#pragma unroll
    for (int d0 = 0; d0 < 4; ++d0) gn[d0] = gain[d0 * 32 + r32e];
#pragma unroll
    for (int r = 0; r < 16; ++r) { const int orow = crow(r, hie); const float rs = rs_l[orow];
        bf16* orp = T.MIX + (size_t)(frow_e + orow) * DM + TYP * 1024 + h * HD;
#pragma unroll
        for (int d0 = 0; d0 < 4; ++d0) { float v = o[d0][r] * rs * gn[d0];
            if (TYP == 0) v *= bf2f(T.GA[(size_t)(frow_e + orow) * 1024 + h * HD + d0 * 32 + r32e]);
            const float vn = __shfl_xor(v, 1);
            if ((r32e & 1) == 0) *(unsigned*)(orp + d0 * 32 + r32e) = cvtpk(v, vn); } }
    LDS_WAIT();
}
#undef PK4
#undef SBAR
#undef KSWZ
}

struct Frame {
    LAS unsigned char* lds; char* ldsg;
    volatile LAS unsigned* MISC;
    gu32* ctl;
    int tid, lane, wave, vcu, G;
    unsigned char* ws;
    const float *x, *meta, *g1, *w_in, *b_f, *q_gain, *k_gain, *fox_gain, *sb_gain, *w_out, *g2, *w_coarse, *b_coarse, *w_fine, *b_fine, *w1, *w3, *w2;
    float* out;
};

__device__ __forceinline__ void transpose_item(const float* W, size_t ldw, int k0, int n0, bf16* WT, size_t Kd, size_t drow0, LAS float* scr, int lane) {
    { const int r = lane >> 4, c4 = (lane & 15) * 4; const float* src = W + (size_t)(k0 + r) * ldw + n0 + c4; LAS float* dst = scr + r * 65 + c4;
#pragma unroll
      for (int hlf = 0; hlf < 2; ++hlf) { f32x4 v[8];
#pragma unroll
          for (int i = 0; i < 8; ++i) v[i] = *(const f32x4*)(src + (size_t)(4 * (8 * hlf + i)) * ldw);
#pragma unroll
          for (int i = 0; i < 8; ++i) { LAS float* d = dst + 4 * (8 * hlf + i) * 65; d[0] = v[i].x; d[1] = v[i].y; d[2] = v[i].z; d[3] = v[i].w; } } }
    LDS_WAIT(); asm volatile("" ::: "memory");
    const int c = lane & 7;
#pragma unroll
    for (int j = 0; j < 8; ++j) { const int n = (lane >> 3) + 8 * j; const LAS float* s = scr + (8 * c) * 65 + n;
        v4u o; o.x = cvtpk(s[0 * 65], s[1 * 65]); o.y = cvtpk(s[2 * 65], s[3 * 65]); o.z = cvtpk(s[4 * 65], s[5 * 65]); o.w = cvtpk(s[6 * 65], s[7 * 65]);
        *(GAS v4u*)(WT + (drow0 + n) * Kd + k0 + 8 * c) = o; }
    LDS_WAIT(); asm volatile("" ::: "memory");
}

__device__ __forceinline__ void p0_prologue(Frame& F) {
    const int gw = F.vcu * 8 + F.wave, NGW = F.G * 8;
    LAS float* wf = (LAS float*)F.lds;
    for (int e = F.tid; e < 8 * DM; e += 512) { const int k = e >> 3, jj = e & 7; wf[jj * DM + k] = F.w_in[(size_t)k * LDW_IN + NPROJ + jj]; }
    __syncthreads();
    bf16* U1 = (bf16*)(F.ws + WS_U1); float* Fp = (float*)(F.ws + WS_F);
    for (int m = gw; m < MROWS; m += NGW) {
        GAS v2u* o8 = (GAS v2u*)(U1 + (size_t)m * DM) + F.lane;
        if (m >= NKEYROWS) {
#pragma unroll
            for (int j = 0; j < 8; ++j) o8[64 * j] = (v2u){0u, 0u};
            continue; }
        const float* xrow = m < TF ? F.x + (size_t)m * DM : F.meta + (size_t)(m - TF) * DM;
        const GAS f32x4* xr = (const GAS f32x4*)xrow + F.lane;
        f32x4 v[8]; float s = 0.f;
#pragma unroll
        for (int j = 0; j < 8; ++j) { v[j] = xr[64 * j]; s += (v[j].x * v[j].x + v[j].y * v[j].y) + (v[j].z * v[j].z + v[j].w * v[j].w); }
        const float rstd = 1.0f / sqrtf(wave_sum(s) * (1.f / DM) + EPS);
        float fa[8] = {0.f, 0.f, 0.f, 0.f, 0.f, 0.f, 0.f, 0.f};
#pragma unroll
        for (int j = 0; j < 8; ++j) { const f32x4 g = *((const GAS f32x4*)F.g1 + F.lane + 64 * j); v[j] = v[j] * rstd * g;
            o8[64 * j] = (v2u){cvtpk(v[j].x, v[j].y), cvtpk(v[j].z, v[j].w)};
#pragma unroll
            for (int jj = 0; jj < 8; ++jj) { const f32x4 w = *(const LAS f32x4*)(wf + jj * DM + 256 * j + 4 * F.lane); fa[jj] += (v[j].x * w.x + v[j].y * w.y) + (v[j].z * w.z + v[j].w * w.w); } }
#pragma unroll
        for (int jj = 0; jj < 8; ++jj) fa[jj] = wave_sum(fa[jj]);
        if (F.lane == 0) {
#pragma unroll
            for (int jj = 0; jj < 8; ++jj) Fp[(size_t)m * 8 + jj] = fa[jj]; }
    }
    { bf16* U2 = (bf16*)(F.ws + WS_U2);
      for (int m = TF + gw; m < MROWS; m += NGW) { GAS v2u* o8 = (GAS v2u*)(U2 + (size_t)m * DM) + F.lane;
#pragma unroll
          for (int j = 0; j < 8; ++j) o8[64 * j] = (v2u){0u, 0u}; } }
    { bf16* HID = (bf16*)(F.ws + WS_HID);
      for (int m = NASSIGN + gw; m < NASSIGN + 384; m += NGW) { GAS v2u* o8 = (GAS v2u*)(HID + (size_t)m * DE) + F.lane; o8[0] = (v2u){0u, 0u}; o8[64] = (v2u){0u, 0u}; } }
    { v4u* RB = (v4u*)(F.ws + WS_RB);
      for (int it = gw * 64 + F.lane; it < 64 * 5 * 64; it += NGW * 64) { const int ln = it & 63, kc = it >> 6, ks = kc / 5, cb = kc % 5, col = 16 * cb + (ln & 15), k0 = 32 * ks + 8 * (ln >> 4);
          float w[8], lo[8]; unsigned hb[4], lb[4];
#pragma unroll
          for (int i = 0; i < 8; ++i) { w[i] = col < 8 ? F.w_coarse[(size_t)(k0 + i) * 8 + col] : (col < 72 ? F.w_fine[(size_t)(k0 + i) * 64 + col - 8] : 0.f); }
#pragma unroll
          for (int i = 0; i < 4; ++i) { hb[i] = cvtpk(w[2 * i], w[2 * i + 1]); lo[2 * i] = w[2 * i] - __uint_as_float(hb[i] << 16); lo[2 * i + 1] = w[2 * i + 1] - __uint_as_float(hb[i] & 0xffff0000u); lb[i] = cvtpk(lo[2 * i], lo[2 * i + 1]); }
          RB[(size_t)(kc * 2 + 0) * 64 + ln] = (v4u){hb[0], hb[1], hb[2], hb[3]}; RB[(size_t)(kc * 2 + 1) * 64 + ln] = (v4u){lb[0], lb[1], lb[2], lb[3]}; } }
    __syncthreads();
    LAS float* scr = (LAS float*)(F.lds + F.wave * 16640);
    bf16* WinT = (bf16*)(F.ws + WS_WIN_T); bf16* WoutT = (bf16*)(F.ws + WS_WOUT_T);
    constexpr int I_IN = (DM / 64) * (NPROJ / 64), I_OUT = (DM / 64) * (DM / 64);
    constexpr int NITEMS = I_IN + I_OUT;
    for (int it = gw; it < NITEMS; it += NGW) {
        int r = it;
        if (r < I_IN) { const int kb = r / (NPROJ / 64), nb = r % (NPROJ / 64); transpose_item(F.w_in, LDW_IN, kb * 64, nb * 64, WinT, DM, nb * 64, scr, F.lane); continue; } r -= I_IN;
        { const int kb = r / (DM / 64), nb = r % (DM / 64); transpose_item(F.w_out, DM, kb * 64, nb * 64, WoutT, DM, nb * 64, scr, F.lane); }
    }
}

__device__ __forceinline__ void cum_scan(Frame& F, int bh) {
    const float* Fp = (const float*)(F.ws + WS_F); float* CUM = (float*)(F.ws + WS_CUM);
    const int b = bh >> 3, h = bh & 7; const float bf = F.b_f[h]; float carry = 0.f;
    for (int c0 = 0; c0 < LPOS; c0 += 64) { const int pos = c0 + F.lane; float v = 0.f;
        if (pos < LPOS) { const int row = pos < NMETA ? ROW_META + pos : b * SEQ + pos - NMETA; const float xv = Fp[(size_t)row * 8 + h] + bf;
            v = (fminf(xv, 0.f) - log1pf(expf(-fabsf(xv)))) * LOG2E; }
#pragma unroll
        for (int o = 1; o < 64; o <<= 1) { const float t = __shfl_up(v, o); if (F.lane >= o) v += t; }
        v += carry;
        if (pos < LPOS) CUM[(size_t)bh * CUMLD + pos] = v;
        carry = __shfl(v, 63); }
}

__device__ __forceinline__ void p5_router(Frame& F) {
    const int ntask = TF / 16;
    const float* H1 = F.out; bf16* U2 = (bf16*)(F.ws + WS_U2); const v4u* RB = (const v4u*)(F.ws + WS_RB);
    int* RE = (int*)(F.ws + WS_ROUTE); int* RP = RE + TF * 2; float* RW = (float*)(RP + TF * 2); int* TOK = (int*)(F.ws + WS_TOK);
    const int tid = opaque_tid(), lane = tid & 63, wave = __builtin_amdgcn_readfirstlane(tid >> 6), tk = wave >> 2, kp = wave & 3;
    LAS float* pacc = (LAS float*)F.lds;
    LAS float* ssp = (LAS float*)(F.lds + 40960);
    LAS float* lg = (LAS float*)(F.lds + 41472) + tk * 16 * 88;
    const int i = lane & 15, kq = lane >> 4;
    for (int base = 0; base < ntask; base += 2 * F.G) {
        const int task = base + 2 * (int)blockIdx.x + tk; const bool live = task < ntask;
        const int row0 = (live ? task : 0) * 16; const float* hrow = H1 + (size_t)(row0 + i) * DM + 8 * kq + 512 * kp;
        float ss = 0.f;
#pragma unroll 8
        for (int ks = 0; ks < 16; ++ks) { const f32x4 a = *(const f32x4*)(hrow + 32 * ks), b = *(const f32x4*)(hrow + 32 * ks + 4);
            ss += (a.x * a.x + a.y * a.y) + (a.z * a.z + a.w * a.w) + (b.x * b.x + b.y * b.y) + (b.z * b.z + b.w * b.w); }
        ss += __shfl_xor(ss, 16); ss += __shfl_xor(ss, 32);
        if (lane < 16) ssp[wave * 16 + i] = ss;
        __syncthreads();
        const float rstd = 1.0f / sqrtf(((ssp[(4 * tk) * 16 + i] + ssp[(4 * tk + 1) * 16 + i]) + (ssp[(4 * tk + 2) * 16 + i] + ssp[(4 * tk + 3) * 16 + i])) * (1.f / DM) + EPS);
        f32x4 acc[5];
#pragma unroll
        for (int cb = 0; cb < 5; ++cb) acc[cb] = (f32x4){0.f, 0.f, 0.f, 0.f};
#pragma unroll 2
        for (int ks = 0; ks < 16; ++ks) { const int kg = 16 * kp + ks;
            const f32x4 a = *(const f32x4*)(hrow + 32 * ks), b = *(const f32x4*)(hrow + 32 * ks + 4);
            const f32x4 ga = *(const f32x4*)(F.g2 + 32 * kg + 8 * kq), gb = *(const f32x4*)(F.g2 + 32 * kg + 8 * kq + 4);
            float u[8] = {a.x * rstd * ga.x, a.y * rstd * ga.y, a.z * rstd * ga.z, a.w * rstd * ga.w, b.x * rstd * gb.x, b.y * rstd * gb.y, b.z * rstd * gb.z, b.w * rstd * gb.w};
            unsigned hb[4], lb[4];
#pragma unroll
            for (int q = 0; q < 4; ++q) { hb[q] = cvtpk(u[2 * q], u[2 * q + 1]); lb[q] = cvtpk(u[2 * q] - __uint_as_float(hb[q] << 16), u[2 * q + 1] - __uint_as_float(hb[q] & 0xffff0000u)); }
            v4u hv = {hb[0], hb[1], hb[2], hb[3]}, lv = {lb[0], lb[1], lb[2], lb[3]};
            if (live) *(v4u*)(U2 + (size_t)(row0 + i) * DM + 32 * kg + 8 * kq) = hv;
            const bf16x8 Ah = *reinterpret_cast<bf16x8*>(&hv), Al = *reinterpret_cast<bf16x8*>(&lv);
#pragma unroll
            for (int cb = 0; cb < 5; ++cb) { v4u bh = RB[(size_t)((kg * 5 + cb) * 2 + 0) * 64 + lane], bl = RB[(size_t)((kg * 5 + cb) * 2 + 1) * 64 + lane];
                const bf16x8 Bh = *reinterpret_cast<bf16x8*>(&bh), Bl = *reinterpret_cast<bf16x8*>(&bl);
                acc[cb] = __builtin_amdgcn_mfma_f32_16x16x32_bf16(Ah, Bh, acc[cb], 0, 0, 0);
                acc[cb] = __builtin_amdgcn_mfma_f32_16x16x32_bf16(Ah, Bl, acc[cb], 0, 0, 0);
                acc[cb] = __builtin_amdgcn_mfma_f32_16x16x32_bf16(Al, Bh, acc[cb], 0, 0, 0); }
        }
#pragma unroll
        for (int cb = 0; cb < 5; ++cb)
#pragma unroll
            for (int j = 0; j < 4; ++j) pacc[(wave * 16 + 4 * kq + j) * 80 + 16 * cb + i] = acc[cb][j];
        __syncthreads();
        if (kp == 0) {
#pragma unroll
            for (int m = 0; m < 20; ++m) { const int idx = lane + 64 * m, r = idx / 80, c = idx - r * 80;
                lg[r * 88 + c] = (pacc[((4 * tk) * 16 + r) * 80 + c] + pacc[((4 * tk + 1) * 16 + r) * 80 + c]) + (pacc[((4 * tk + 2) * 16 + r) * 80 + c] + pacc[((4 * tk + 3) * 16 + r) * 80 + c]); }
            LDS_WAIT(); asm volatile("" ::: "memory");
            if (lane < 16 && live) { const LAS float* L = lg + lane * 88; const int row = row0 + lane;
                float cmax = L[0] + F.b_coarse[0]; int gs = 0; float cv[8]; cv[0] = cmax;
#pragma unroll
                for (int g = 1; g < 8; ++g) { cv[g] = L[g] + F.b_coarse[g]; if (cv[g] > cmax) { cmax = cv[g]; gs = g; } }
                float den = 0.f;
#pragma unroll
                for (int g = 0; g < 8; ++g) den += expf(cv[g] - cmax);
                const float ggate = 1.0f / den;
                float f1 = -__builtin_inff(), f2 = -__builtin_inff(); int i1 = 0, i2 = 0;
#pragma unroll
                for (int jx = 0; jx < 8; ++jx) { const float fv = L[8 + gs * 8 + jx] + F.b_fine[gs * 8 + jx];
                    if (fv > f1) { f2 = f1; i2 = i1; f1 = fv; i1 = jx; } else if (fv > f2) { f2 = fv; i2 = jx; } }
                const float e2 = expf(f2 - f1), w1 = ggate / (1.f + e2), w2 = ggate * e2 / (1.f + e2);
                const int ea = gs * 8 + i1, eb = gs * 8 + i2;
                const int pa = (int)__hip_atomic_fetch_add(F.ctl + CW_CNT + 64 * ea, 1u, RLX_AGENT), pb = (int)__hip_atomic_fetch_add(F.ctl + CW_CNT + 64 * eb, 1u, RLX_AGENT);
                TOK[(size_t)ea * TOKLD + pa] = row * 2; TOK[(size_t)eb * TOKLD + pb] = row * 2 + 1;
                RE[row * 2] = ea; RE[row * 2 + 1] = eb; RP[row * 2] = pa; RP[row * 2 + 1] = pb; RW[row * 2] = w1; RW[row * 2 + 1] = w2; }
        }
        __syncthreads();
    }
}

__device__ __forceinline__ void moe_prefix(Frame& F, int ncs) {
    LAS int* upre = (LAS int*)(F.lds + TPRE_OFF); LAS int* cpre = upre + 80;
    if (F.tid < 64) { const int c = (int)__hip_atomic_load(F.ctl + CW_CNT + 64 * F.tid, RLX_AGENT); int u = ((c + 383) / 384) * ncs, v = c;
#pragma unroll
        for (int o = 1; o < 64; o <<= 1) { const int y = __shfl_up(u, o), z = __shfl_up(v, o); if (F.lane >= o) { u += y; v += z; } }
        upre[F.tid + 1] = u; cpre[F.tid + 1] = v; if (F.tid == 0) { upre[0] = 0; cpre[0] = 0; } }
    __syncthreads();
}

__device__ __forceinline__ void p8_combine(Frame& F) {
    const LAS int* cpre = (const LAS int*)(F.lds + TPRE_OFF) + 80;
    const int* RE = (const int*)(F.ws + WS_ROUTE); const int* RP = RE + TF * 2; const bf16* Y = (const bf16*)(F.ws + WS_Y);
    for (int m = F.vcu * 8 + F.wave; m < TF; m += F.G * 8) {
        const int e0 = RE[m * 2], e1 = RE[m * 2 + 1], p0 = RP[m * 2], p1 = RP[m * 2 + 1];
        const size_t s0 = (size_t)(cpre[e0] + p0), s1 = (size_t)(cpre[e1] + p1);
        GAS f32x4* op = (GAS f32x4*)(F.out + (size_t)m * DM) + 2 * F.lane;
        const GAS v4u* y0 = (const GAS v4u*)(Y + s0 * DM) + F.lane; const GAS v4u* y1 = (const GAS v4u*)(Y + s1 * DM) + F.lane;
#pragma unroll
        for (int j = 0; j < 4; ++j) { f32x4 a = op[128 * j], b = op[128 * j + 1]; const v4u u0 = y0[64 * j], u1 = y1[64 * j];
            a.x += __uint_as_float(u0.x << 16) + __uint_as_float(u1.x << 16); a.y += __uint_as_float(u0.x & 0xffff0000u) + __uint_as_float(u1.x & 0xffff0000u);
            a.z += __uint_as_float(u0.y << 16) + __uint_as_float(u1.y << 16); a.w += __uint_as_float(u0.y & 0xffff0000u) + __uint_as_float(u1.y & 0xffff0000u);
            b.x += __uint_as_float(u0.z << 16) + __uint_as_float(u1.z << 16); b.y += __uint_as_float(u0.z & 0xffff0000u) + __uint_as_float(u1.z & 0xffff0000u);
            b.z += __uint_as_float(u0.w << 16) + __uint_as_float(u1.w << 16); b.w += __uint_as_float(u0.w & 0xffff0000u) + __uint_as_float(u1.w & 0xffff0000u);
            op[128 * j] = a; op[128 * j + 1] = b; }
    }
}

#define XB_TMO      128
#define XB_XCNT(j)  (256  + 64 * (j))
#define XB_XSUB(j)  (1280 + 64 * (j))
#define XB_XGEN(j)  (2304 + 64 * (j))
#define XB_TOP      3328
#define XB_TOPGEN   3392
#define XCD_BAR_WORDS 3456
#define XB_SPIN_CAP (1u << 18)

__device__ __forceinline__ unsigned xb_ld(unsigned* p)              { return __hip_atomic_load(p, __ATOMIC_RELAXED, __HIP_MEMORY_SCOPE_AGENT); }
__device__ __forceinline__ unsigned xb_add(unsigned* p, unsigned v) { return __hip_atomic_fetch_add(p, v, __ATOMIC_RELAXED, __HIP_MEMORY_SCOPE_AGENT); }
__device__ __forceinline__ unsigned xb_xcc_id() { return (unsigned)__builtin_amdgcn_s_getreg((3 << 11) | 20) & 0xFu; }
#define XB_SPIN(cond, bar) do { unsigned _sp = 0; while (cond) { __builtin_amdgcn_s_sleep(1); \
    if ((++_sp & 255u) == 0u) { if (xb_ld(&(bar)[XB_TMO])) break; if (_sp > XB_SPIN_CAP) { atomicAdd(&(bar)[XB_TMO], 1u); break; } } } } while (0)

struct XcdBarrier {
    unsigned* bar; unsigned x;
    volatile LAS unsigned* st;
};

__device__ __forceinline__ XcdBarrier xcd_barrier_post(unsigned* bar, volatile LAS unsigned* st) {
    XcdBarrier b; b.bar = bar; b.x = xb_xcc_id(); b.st = st;
    if (threadIdx.x == 0) (void)xb_add(&bar[XB_XCNT(b.x)], 1u);
    return b;
}
__device__ __forceinline__ void xcd_barrier_complete(unsigned* bar, unsigned x, unsigned& nloc, unsigned& nx) {
    const unsigned G = gridDim.x * gridDim.y * gridDim.z;
    unsigned sum, cnt, mine, sp = 0u;
    for (;;) {
        sum = 0u; cnt = 0u; mine = 0u;
#pragma unroll
        for (unsigned j = 0; j < 16; ++j) { const unsigned c = xb_ld(&bar[XB_XCNT(j)]); sum += c; cnt += (c > 0u) ? 1u : 0u; mine = (j == x) ? c : mine; }
        if (sum == G) break;
        __builtin_amdgcn_s_sleep(1);
        if ((++sp & 255u) == 0u) { if (xb_ld(&bar[XB_TMO])) break; if (sp > XB_SPIN_CAP) { atomicAdd(&bar[XB_TMO], 1u); break; } }
    }
    nloc = mine > 0u ? mine : 1u; nx = cnt > 0u ? cnt : 1u;
}

__device__ __forceinline__ void xcd_barrier(const XcdBarrier& b) {
    asm volatile("s_waitcnt vmcnt(0)" ::: "memory");
    __syncthreads();
    if (threadIdx.x == 0) {
        unsigned* bar = b.bar;
        __builtin_amdgcn_s_waitcnt(0);
        unsigned nloc = b.st[0], nx = b.st[1];
        if (nloc == 0u) { xcd_barrier_complete(bar, b.x, nloc, nx); b.st[0] = nloc; b.st[1] = nx; }
        const unsigned old = xb_add(&bar[XB_XSUB(b.x)], 1u);
        const unsigned gen = old / nloc;
        if (old + 1u == (gen + 1u) * nloc) {
            __builtin_amdgcn_fence(__ATOMIC_RELEASE, "agent");
            asm volatile("s_waitcnt vmcnt(0)" ::: "memory");
            const unsigned og = xb_add(&bar[XB_TOP], 1u);
            const unsigned tg = og / nx;
            if (og + 1u == (tg + 1u) * nx) xb_add(&bar[XB_TOPGEN], 1u);
            else XB_SPIN(xb_ld(&bar[XB_TOPGEN]) == tg, bar);
            __builtin_amdgcn_fence(__ATOMIC_ACQUIRE, "agent");
            xb_add(&bar[XB_XGEN(b.x)], 1u);
            asm volatile("s_waitcnt vmcnt(0)" ::: "memory");
        } else {
            XB_SPIN(xb_ld(&bar[XB_XGEN(b.x)]) == gen, bar);
            __builtin_amdgcn_fence(__ATOMIC_ACQUIRE, "agent");
            asm volatile("s_waitcnt vmcnt(0)" ::: "memory");
        }
    }
    __syncthreads();
}

struct Args { const float* in[18]; float* out; unsigned char* ws; int ph_lo, ph_hi; };
__global__ void __launch_bounds__(512, 2) fwd(Args args) {
    extern __shared__ __attribute__((aligned(16))) unsigned char lds[];
    Frame F;
    F.lds = (LAS unsigned char*)lds; F.ldsg = (char*)lds;
    F.MISC = (volatile LAS unsigned*)(F.lds + MISC_OFF);
    F.tid = threadIdx.x; F.lane = F.tid & 63; F.wave = __builtin_amdgcn_readfirstlane(F.tid >> 6);
    F.G = gridDim.x; { const int bx = blockIdx.x; F.vcu = (F.G % 8 == 0) ? (bx % 8) * (F.G / 8) + bx / 8 : bx; }
    F.ws = args.ws; F.ctl = (gu32*)(args.ws + WS_CTL); F.out = args.out;
    F.x = args.in[0]; F.meta = args.in[1]; F.g1 = args.in[2]; F.w_in = args.in[3]; F.b_f = args.in[4]; F.q_gain = args.in[5]; F.k_gain = args.in[6];
    F.fox_gain = args.in[7]; F.sb_gain = args.in[8]; F.w_out = args.in[9]; F.g2 = args.in[10]; F.w_coarse = args.in[11]; F.b_coarse = args.in[12];
    F.w_fine = args.in[13]; F.b_fine = args.in[14]; F.w1 = args.in[15]; F.w3 = args.in[16]; F.w2 = args.in[17];
    for (int u = F.tid; u < 32; u += 512) F.MISC[u] = 0u;
    __syncthreads();
    const int lo = args.ph_lo, hi = args.ph_hi;
    XcdBarrier bar; bar.bar = (unsigned*)(F.ctl + CW_BAR); bar.x = 0; bar.st = nullptr;
    if (hi - lo > 1) bar = xcd_barrier_post((unsigned*)(F.ctl + CW_BAR), F.MISC + 8);
#define IN(k) (lo <= (k) && (k) < hi)
#define SEAM(k) do { if (IN(k) && IN((k) + 1)) xcd_barrier(bar); } while (0)
    bf16* PROJ = (bf16*)(F.ws + WS_PROJ);

    if (IN(0)) { p0_prologue(F); if (REP_PHASE == 0) { __syncthreads(); p0_prologue(F); } SEAM(0); }

    if (IN(1)) {
        { const int bh = (int)blockIdx.x - (F.G - NB * NH); if (bh >= 0 && F.wave == 0) cum_scan(F, bh); }
        pg8::DenseOrder S; S.init(F.ws + WS_U1, F.ws + WS_WIN_T, MROWS, NPROJ, DM, F.G, (int)blockIdx.x);
        pg8::EpiProj E{PROJ, (float*)(F.ws + WS_SS)};
        pg8::gemm_phase<pg8::EpiProj, pg8::DenseOrder, false>(F.lds, DM, S, E, nullptr);
        if (REP_PHASE == 1) pg8::gemm_phase<pg8::EpiProj, pg8::DenseOrder, false>(F.lds, DM, S, E, nullptr);
        if (IN(1) && IN(3)) xcd_barrier(bar);
    }

    if (IN(3)) {
        att::Tensors T{PROJ, PROJ + PROJ_TS, PROJ + 2 * PROJ_TS, PROJ + 3 * PROJ_TS, PROJ + 4 * PROJ_TS, PROJ + 5 * PROJ_TS, PROJ + 6 * PROJ_TS,
                       (const float*)(F.ws + WS_SS), (const float*)(F.ws + WS_CUM), F.q_gain, F.k_gain, F.fox_gain, F.sb_gain, (bf16*)(F.ws + WS_MIX)};
        for (int rep = 0; rep < (REP_PHASE == 3 ? 2 : 1); ++rep)
        for (int w = F.vcu; w < 256; w += F.G) { const int bh = w >> 3, s = w & 7;
#ifndef NO_FOX
            att::attn_unit<0>(F.ldsg, T, bh >> 3, bh & 7, s);
#endif
#ifndef NO_SB
            att::attn_unit<1>(F.ldsg, T, bh >> 3, bh & 7, 7 - s);
#endif
        }
        __syncthreads();
        SEAM(3);
    }
    if (IN(4)) {
        pg8::DenseOrder S; S.init(F.ws + WS_MIX, F.ws + WS_WOUT_T, TF, DM, DM, F.G, (int)blockIdx.x);
        pg8::EpiOut E{F.x, F.out};
        pg8::gemm_phase<pg8::EpiOut, pg8::DenseOrder, false>(F.lds, DM, S, E, nullptr);
        if (REP_PHASE == 4) pg8::gemm_phase<pg8::EpiOut, pg8::DenseOrder, false>(F.lds, DM, S, E, nullptr);
        SEAM(4);
    }
    if (IN(5)) { p5_router(F); SEAM(5); }

    if (IN(6)) {
        moe_prefix(F, 8);
        const LAS int* upre = (const LAS int*)(F.lds + TPRE_OFF);
        moe::Order S{F.G, F.vcu, 8, upre, upre + 80};
        LAS int* tab = (LAS int*)(F.lds + TAB_OFF); const int* TOK = (const int*)(F.ws + WS_TOK);
        for (int i = 0; i < 8; ++i) { int e, cs, mt, cnt, cbase; if (!S.decode(i, e, cs, mt, cnt, cbase)) break;
            if (F.tid < 384) { const int p = mt * 384 + F.tid; tab[i * 384 + F.tid] = p < cnt ? (TOK[(size_t)e * TOKLD + p] >> 1) : TF; } }
        __syncthreads();
        for (int rep = 0; rep < (REP_PHASE == 6 ? 2 : 1); ++rep)
        moe::phase<DM, true>(F.lds, S, tab, (const char*)(F.ws + WS_U2), F.w1, F.w3, (bf16*)(F.ws + WS_HID));
        SEAM(6);
    }
    if (IN(7)) {
        moe_prefix(F, 16);
        const LAS int* upre = (const LAS int*)(F.lds + TPRE_OFF);
        moe::Order S{F.G, F.vcu, 16, upre, upre + 80};
        LAS float* wtab = (LAS float*)(F.lds + TAB_OFF); const int* TOK = (const int*)(F.ws + WS_TOK); const float* RW = (const float*)(F.ws + WS_ROUTE) + TF * 4;
        for (int i = 0; i < 8; ++i) { int e, cs, mt, cnt, cbase; if (!S.decode(i, e, cs, mt, cnt, cbase)) break;
            if (F.tid < 384) { const int p = mt * 384 + F.tid; wtab[i * 384 + F.tid] = p < cnt ? RW[TOK[(size_t)e * TOKLD + p]] : 0.f; } }
        __syncthreads();
        for (int rep = 0; rep < (REP_PHASE == 7 ? 2 : 1); ++rep)
        moe::phase<DE, false>(F.lds, S, (const LAS int*)wtab, (const char*)(F.ws + WS_HID), F.w2, nullptr, (bf16*)(F.ws + WS_Y));
        SEAM(7);
    }
    if (IN(8)) { moe_prefix(F, 16); p8_combine(F); }
#undef IN
#undef SEAM
}

extern "C" void kernel_launch(void* const* d_in, const int* in_sizes, int n_in, void* d_out, int out_size, void* d_ws, size_t ws_size, hipStream_t stream) {
    static int grid = 0;
    if (grid == 0) {
        if (n_in != 18 || out_size != TF * DM || ws_size < WS_END) { fprintf(stderr, "kernel_launch: unexpected shapes (n_in %d, out %d, ws %zu); nothing launched\n", n_in, out_size, ws_size); grid = -1; return; }
        int dev = 0, cus = 0, per_cu = 0;
        if (hipGetDevice(&dev) != hipSuccess || hipDeviceGetAttribute(&cus, hipDeviceAttributeMultiprocessorCount, dev) != hipSuccess) { grid = -1; return; }
        if (hipFuncSetAttribute((const void*)fwd, hipFuncAttributeMaxDynamicSharedMemorySize, LDS_BYTES) != hipSuccess) { fprintf(stderr, "kernel_launch: hipFuncSetAttribute failed\n"); grid = -1; return; }
        if (hipOccupancyMaxActiveBlocksPerMultiprocessor(&per_cu, (const void*)fwd, 512, LDS_BYTES) != hipSuccess || per_cu < 1) fprintf(stderr, "kernel_launch: occupancy query reports %d\n", per_cu);
        (void)hipGetLastError();
        grid = cus > 0 ? cus : 256;
    }
    if (grid < 0) return;
    (void)hipMemsetAsync((char*)d_ws + WS_CTL, 0, CTL_ZERO_BYTES, stream);
    Args a{};
    for (int i = 0; i < 18; ++i) a.in[i] = (const float*)d_in[i];
    a.out = (float*)d_out; a.ws = (unsigned char*)d_ws;
    constexpr int NL = MK_N_LAUNCHES;
    for (int li = 0; li < NL; ++li) {
        a.ph_lo = (NL == 1) ? 0 : li; a.ph_hi = (NL == 1) ? NPHASE : li + 1;
        hipLaunchKernelGGL(fwd, dim3(grid), dim3(512), LDS_BYTES, stream, a);
    }
}
```

```cpp
#include <hip/hip_runtime.h>
#include <hip/hip_bf16.h>
#include <cstdio>
#include <cstdint>

#ifndef REP_PHASE
#define REP_PHASE -1
#endif
#ifndef MK_N_LAUNCHES
#define MK_N_LAUNCHES 1
#endif

constexpr int DM = 2048, NB = 4, SEQ = 2048, NMETA = 16, HD = 128, NH = 8;
constexpr int TF = NB * SEQ;
constexpr int ROW_META = TF;
constexpr int NKEYROWS = TF + NMETA;
constexpr int MROWS = 8448;
constexpr int NPROJ = 7168, LDW_IN = 7176;
constexpr int NE = 64, DE = 512;
constexpr int LPOS = SEQ + NMETA;
constexpr int CUMLD = 2112;
constexpr float EPS = 1e-6f;
constexpr float LOG2E = 1.4426950408889634f;
constexpr float QSCALE2 = 0.08838834764831845f * 1.4426950408889634f;
constexpr int NPHASE = 9;

constexpr size_t MiB = 1u << 20;
constexpr size_t WS_CTL = 0, CTL_ZERO_BYTES = 1 * MiB;
constexpr size_t WS_WIN_T = 2 * MiB;
constexpr size_t WS_WOUT_T = 30 * MiB;
constexpr size_t WS_U1 = 38 * MiB;
constexpr size_t WS_PROJ = 72 * MiB;
constexpr size_t PROJ_TS = (size_t)MROWS * 1024;
constexpr size_t WS_F = 188 * MiB;
constexpr size_t WS_CUM = 189 * MiB;
constexpr size_t WS_SS = 190 * MiB;
constexpr size_t WS_RK = 194 * MiB;
constexpr size_t WS_MT = 195 * MiB;
constexpr size_t WS_MIX = 196 * MiB;
constexpr size_t WS_U2 = 228 * MiB;
constexpr size_t WS_ROUTE = 262 * MiB;
constexpr size_t WS_TOK = 263 * MiB;
constexpr int TOKLD = 16512;
constexpr size_t WS_RB = 268 * MiB;
constexpr int NASSIGN = TF * 2;
constexpr size_t WS_HID = 272 * MiB;
constexpr size_t WS_Y = 292 * MiB;
constexpr size_t WS_END = 360 * MiB;
constexpr int CW_TMO = 0;
constexpr int CW_CNT = 1024;
constexpr int CW_BAR = 8192;

constexpr int RING_BYTES = 139264;
constexpr int TAB_OFF = RING_BYTES, TAB_BYTES = 8 * 384 * 4;
constexpr int TPRE_OFF = TAB_OFF + TAB_BYTES;
constexpr int MISC_OFF = TPRE_OFF + 1024;
constexpr int LDS_BYTES = MISC_OFF + 128;

#define GAS __attribute__((address_space(1)))
#define LAS __attribute__((address_space(3)))
typedef unsigned short bf16;
typedef unsigned v4u __attribute__((ext_vector_type(4)));
typedef unsigned v2u __attribute__((ext_vector_type(2)));
typedef float f32x4 __attribute__((ext_vector_type(4)));
typedef float f32x2 __attribute__((ext_vector_type(2)));
typedef float f32x16 __attribute__((ext_vector_type(16)));
typedef short bf16x8 __attribute__((ext_vector_type(8)));
typedef short s16x4 __attribute__((ext_vector_type(4)));
typedef GAS unsigned gu32;
#define RLX_AGENT __ATOMIC_RELAXED, __HIP_MEMORY_SCOPE_AGENT
#define LDS_WAIT() asm volatile("s_waitcnt lgkmcnt(0)" ::: "memory")
#define VM_WAIT() asm volatile("s_waitcnt vmcnt(0)" ::: "memory")
__device__ __forceinline__ unsigned cvtpk(float lo, float hi) { unsigned r; asm volatile("v_cvt_pk_bf16_f32 %0, %1, %2" : "=v"(r) : "v"(lo), "v"(hi)); return r; }
__device__ __forceinline__ float bf2f(unsigned short h) { return __uint_as_float(((unsigned)h) << 16); }
__device__ __forceinline__ float wave_sum(float v) {
#pragma unroll
    for (int o = 1; o < 64; o <<= 1) v += __shfl_xor(v, o);
    return v;
}
__device__ __forceinline__ int opaque_tid() { int t = threadIdx.x; asm volatile("" : "+v"(t)); return t; }
__device__ __forceinline__ float fast_exp2(float x) { return __builtin_amdgcn_exp2f(x); }
__device__ __forceinline__ float fast_log2(float x) { return __builtin_amdgcn_logf(x); }
__device__ __forceinline__ float fast_rcp(float x) { return __builtin_amdgcn_rcpf(x); }

namespace pg8 {
#define PG8_LAS __attribute__((address_space(3)))
typedef unsigned short bf16_t;
typedef unsigned u32x4 __attribute__((ext_vector_type(4)));
constexpr int BM = 256, BK = 64, HALF = 128, HTB = HALF * BK * 2, STAGE_BYTES = 8 * HTB, NXCD = 8, WGM = 8;
__host__ __device__ __forceinline__ int lds_byte(int r, int c) { const int st = (r >> 4) * 2 + (c >> 5), rr = r & 15, cc = c & 31, ob = rr * 64 + cc * 2; return st * 1024 + (ob ^ (((ob >> 9) & 1) << 5)); }
__host__ __device__ __forceinline__ void stage_rc(int b, int& R, int& C) { const int st = b / 1024, sb = b % 1024, swz = sb ^ (((sb >> 9) & 1) << 5); R = (st >> 1) * 16 + swz / 64; C = (st & 1) * 32 + (swz % 64) / 2; }
__host__ __device__ __forceinline__ int perm32(int rho) { const int n = rho >> 4, i = rho & 15; return 8 * (i >> 2) + 4 * n + (i & 3); }

struct Unit { int pm, pn, li; const char* A; const char* B; };

struct DenseOrder {
    int nM, nN, nwg, G, c; const char* A; const char* B; size_t tstep;
    __device__ __forceinline__ void init(const void* A_, const void* B_, int M, int N, int K, int G_, int c_) { nM = M / BM; nN = N / BM; nwg = nM * nN; G = G_; c = c_; A = (const char*)A_; B = (const char*)B_; tstep = (size_t)BM * K * 2; }
    __device__ __forceinline__ bool next(int i, Unit& u) const {
        const long L = (long)i * G + c; if (L >= nwg) return false;
        int wgid = (int)L; { const int q = nwg / NXCD, r = nwg % NXCD, xcd = wgid % NXCD, off = wgid / NXCD; wgid = (xcd < r ? xcd * (q + 1) : r * (q + 1) + (xcd - r) * q) + off; }
        const int nig = WGM * nN, gid = wgid / nig, fm = gid * WGM, gsz = (nM - fm) < WGM ? (nM - fm) : WGM;
        u.pm = fm + ((wgid % nig) % gsz); u.pn = (wgid % nig) / gsz; u.li = 0;
        u.A = A + (size_t)u.pm * tstep; u.B = B + (size_t)u.pn * tstep; return true;
    }
};

template <class Epi, class Sched, bool GATHER>
__device__ __forceinline__ void gemm_phase(PG8_LAS unsigned char* lds, const int K, const Sched& S, const Epi& E, const PG8_LAS int* tab) {
    const int tid = opaque_tid(), wid = __builtin_amdgcn_readfirstlane(tid >> 6), lane = tid & 63, wr = wid >> 2, wc = wid & 3, fr = lane & 15, fq = lane >> 4;
    const int nt = K / BK;
    unsigned voffA[2], voffB[2]; int RA[2], CA[2];
#pragma unroll
    for (int i = 0; i < 2; ++i) { int R, C; stage_rc(tid * 16 + i * 8192, R, C); const int Rb = Epi::PERM ? ((R & ~31) + perm32(R & 31)) : R;
        voffA[i] = (unsigned)(R * K + C) * 2u; voffB[i] = (unsigned)(Rb * K + C) * 2u; RA[i] = R; CA[i] = C; }
    const size_t kstep = (size_t)(BK * 2);
    const size_t hstep = (size_t)HALF * K * 2;
    const unsigned ldsw = (unsigned)wid * 1024u;
    const int aoff = lds_byte(wr * 64 + fr, fq * 8), boff = lds_byte(wc * 32 + fr, fq * 8);
    unsigned gA[2][2], gAn[2][2];
#define PG8_SA(b, h) (((b) * 2 + (h)) * HTB)
#define PG8_SB(b, h) ((4 + (b) * 2 + (h)) * HTB)
#define PG8_GL(gptr, ldsoff) __builtin_amdgcn_global_load_lds((const unsigned*)(gptr), (PG8_LAS unsigned*)(lds + (ldsoff)), 16, 0, 0)
#define PG8_STAGE_B(bufoff, gbase) do { _Pragma("unroll") for (int _i = 0; _i < 2; ++_i) PG8_GL((const char*)(gbase) + voffB[_i], (bufoff) + ldsw + _i * 8192); } while (0)
#define PG8_STAGE_A(bufoff, gbase, h, NX) do { _Pragma("unroll") for (int _i = 0; _i < 2; ++_i) { \
        if constexpr (GATHER) { const unsigned _vo = (NX) ? gAn[h][_i] : gA[h][_i]; PG8_GL((const char*)(gbase) + _vo, (bufoff) + ldsw + _i * 8192); } \
        else { PG8_GL((const char*)(gbase) + (size_t)(h) * hstep + voffA[_i], (bufoff) + ldsw + _i * 8192); } } } while (0)
#define PG8_GIDX(dst, li) do { if constexpr (GATHER) { _Pragma("unroll") for (int _h = 0; _h < 2; ++_h) _Pragma("unroll") for (int _i = 0; _i < 2; ++_i) \
        dst[_h][_i] = ((unsigned)tab[(li) * 256 + _h * 128 + RA[_i]] * (unsigned)K + (unsigned)CA[_i]) * 2u; } } while (0)
#define PG8_LDA(dst, b, h) do { _Pragma("unroll") for (int m = 0; m < 4; ++m) _Pragma("unroll") for (int k = 0; k < 2; ++k) dst[m][k] = *(const PG8_LAS bf16x8*)(lds + PG8_SA(b, h) + aoff + m * 2048 + k * 1024); } while (0)
#define PG8_LDB(dst, b, h) do { _Pragma("unroll") for (int n = 0; n < 2; ++n) _Pragma("unroll") for (int k = 0; k < 2; ++k) dst[n][k] = *(const PG8_LAS bf16x8*)(lds + PG8_SB(b, h) + boff + n * 2048 + k * 1024); } while (0)
#define PG8_MMA(ai, bj, At, Bt) do { __builtin_amdgcn_s_setprio(1); _Pragma("unroll") for (int m = 0; m < 4; ++m) _Pragma("unroll") for (int n = 0; n < 2; ++n) _Pragma("unroll") for (int k = 0; k < 2; ++k) \
        acc[ai][bj][m][n] = __builtin_amdgcn_mfma_f32_16x16x32_bf16(Bt[n][k], At[m][k], acc[ai][bj][m][n], 0, 0, 0); __builtin_amdgcn_s_setprio(0); } while (0)
#define PG8_WAIT_V(n) asm volatile("s_waitcnt vmcnt(" #n ")" ::: "memory")
#define PG8_WAIT_L(n) asm volatile("s_waitcnt lgkmcnt(" #n ")" ::: "memory")
#define PG8_BAR __builtin_amdgcn_s_barrier()
#define PG8_SCHED __builtin_amdgcn_sched_barrier(0)
    Unit cur, nxt; int ui = 0;
    if (!S.next(0, cur)) return;
    f32x4 acc[2][2][4][2];
#pragma unroll
    for (int a = 0; a < 2; ++a)
#pragma unroll
        for (int b = 0; b < 2; ++b)
#pragma unroll
            for (int m = 0; m < 4; ++m)
#pragma unroll
                for (int n = 0; n < 2; ++n) acc[a][b][m][n] = (f32x4){0.f, 0.f, 0.f, 0.f};
    bf16x8 At[4][2], B0[2][2], B1[2][2];
    const char* cA = cur.A; const char* cB = cur.B;
    PG8_GIDX(gA, cur.li);
    PG8_STAGE_B(PG8_SB(0, 0), cB); PG8_STAGE_B(PG8_SB(0, 1), cB + hstep); PG8_STAGE_A(PG8_SA(0, 0), cA, 0, false); PG8_STAGE_A(PG8_SA(0, 1), cA, 1, false);
    if (wr == 1) PG8_BAR;
    PG8_WAIT_V(2); PG8_BAR;
    PG8_STAGE_B(PG8_SB(1, 0), cB + kstep); PG8_STAGE_A(PG8_SA(1, 0), cA + kstep, 0, false); PG8_STAGE_B(PG8_SB(1, 1), cB + hstep + kstep);
    PG8_WAIT_V(6); PG8_BAR;
    for (;;) {
        const bool has_next = S.next(ui + 1, nxt);
        const char* nA = has_next ? nxt.A : cA; const char* nB = has_next ? nxt.B : cB;
        if constexpr (GATHER) { if (has_next) { PG8_GIDX(gAn, nxt.li); } else {
#pragma unroll
            for (int _h = 0; _h < 2; ++_h)
#pragma unroll
                for (int _i = 0; _i < 2; ++_i) gAn[_h][_i] = gA[_h][_i]; } }
        for (int t = 0; t < nt; t += 2) {
            const bool last = (t == nt - 2);
            const char* a1 = cA + (size_t)(t + 1) * kstep;
            const char* a2 = last ? nA : cA + (size_t)(t + 2) * kstep; const char* b2 = last ? nB : cB + (size_t)(t + 2) * kstep;
            const char* a3 = a2 + kstep; const char* b3 = b2 + kstep;
            PG8_LDB(B0, 0, 0); PG8_LDB(B1, 0, 1); PG8_SCHED; PG8_LDA(At, 0, 0); PG8_STAGE_A(PG8_SA(1, 1), a1, 1, false);
            PG8_WAIT_V(8); PG8_WAIT_L(0); PG8_BAR; PG8_MMA(0, 0, At, B0); PG8_MMA(0, 1, At, B1); PG8_BAR; PG8_SCHED;
            PG8_LDA(At, 0, 1); PG8_STAGE_B(PG8_SB(0, 0), b2); PG8_STAGE_B(PG8_SB(0, 1), b2 + hstep); PG8_STAGE_A(PG8_SA(0, 0), a2, 0, last);
            PG8_WAIT_V(8); PG8_WAIT_L(0); PG8_BAR; PG8_MMA(1, 0, At, B0); PG8_MMA(1, 1, At, B1); PG8_BAR; PG8_SCHED;
            PG8_LDB(B0, 1, 0); PG8_LDB(B1, 1, 1); PG8_SCHED; PG8_LDA(At, 1, 0); PG8_STAGE_A(PG8_SA(0, 1), a2, 1, last);
            PG8_WAIT_V(8); PG8_WAIT_L(0); PG8_BAR; PG8_MMA(0, 0, At, B0); PG8_MMA(0, 1, At, B1); PG8_BAR; PG8_SCHED;
            PG8_LDA(At, 1, 1); PG8_STAGE_B(PG8_SB(1, 0), b3); PG8_STAGE_B(PG8_SB(1, 1), b3 + hstep); PG8_STAGE_A(PG8_SA(1, 0), a3, 0, last);
            PG8_WAIT_V(8); PG8_WAIT_L(0); PG8_BAR; PG8_MMA(1, 0, At, B0); PG8_MMA(1, 1, At, B1); PG8_BAR; PG8_SCHED;
        }
        if (wr == 0) PG8_BAR;
        E(acc, cur, wr, wc, fr, fq);
        if (!has_next) break;
#pragma unroll
        for (int a = 0; a < 2; ++a)
#pragma unroll
            for (int b = 0; b < 2; ++b)
#pragma unroll
                for (int m = 0; m < 4; ++m)
#pragma unroll
                    for (int n = 0; n < 2; ++n) acc[a][b][m][n] = (f32x4){0.f, 0.f, 0.f, 0.f};
        cur = nxt; cA = nA; cB = nB; ++ui;
        if constexpr (GATHER) {
#pragma unroll
            for (int _h = 0; _h < 2; ++_h)
#pragma unroll
                for (int _i = 0; _i < 2; ++_i) gA[_h][_i] = gAn[_h][_i]; }
        if (wr == 1) PG8_BAR;
    }
    PG8_WAIT_V(0);
    PG8_BAR;
#undef PG8_SA
#undef PG8_SB
#undef PG8_GL
#undef PG8_STAGE_A
#undef PG8_STAGE_B
#undef PG8_GIDX
#undef PG8_LDA
#undef PG8_LDB
#undef PG8_MMA
#undef PG8_WAIT_V
#undef PG8_WAIT_L
#undef PG8_BAR
#undef PG8_SCHED
}

struct EpiProj {
    static constexpr bool PERM = true;
    bf16_t* P; float* SS;
    __device__ __forceinline__ void operator()(const f32x4 (&acc)[2][2][4][2], const Unit& u, int wr, int wc, int fr, int fq) const {
        const int t = u.pn >> 2, colt = (u.pn & 3) * BM;
        bf16_t* base = P + (size_t)t * PROJ_TS;
        const int row0 = u.pm * BM + wr * 64 + fr, col0 = colt + wc * 32 + 8 * fq;
        if (t <= 1) {
#pragma unroll
            for (int ai = 0; ai < 2; ++ai)
#pragma unroll
                for (int m = 0; m < 4; ++m)
#pragma unroll
                    for (int bj = 0; bj < 2; ++bj) {
                        const f32x4 a = acc[ai][bj][m][0], b = acc[ai][bj][m][1];
                        float s = (a[0] * a[0] + a[1] * a[1]) + (a[2] * a[2] + a[3] * a[3]) + (b[0] * b[0] + b[1] * b[1]) + (b[2] * b[2] + b[3] * b[3]);
                        s += __shfl_xor(s, 16); s += __shfl_xor(s, 32);
                        if (fq == 0) SS[(((size_t)t * MROWS + (row0 + ai * HALF + m * 16)) * 8 + ((u.pn & 3) * 2 + bj)) * 4 + wc] = s;
                    }
        }
#pragma unroll
        for (int ai = 0; ai < 2; ++ai)
#pragma unroll
            for (int m = 0; m < 4; ++m) { bf16_t* rowp = base + (size_t)(row0 + ai * HALF + m * 16) * 1024 + col0;
#pragma unroll
                for (int bj = 0; bj < 2; ++bj) { f32x4 v0 = acc[ai][bj][m][0], v1 = acc[ai][bj][m][1];
                    if (t == 3) {
#pragma unroll
                        for (int j = 0; j < 4; ++j) { v0[j] = fast_rcp(1.f + fast_exp2(-v0[j] * LOG2E)); v1[j] = fast_rcp(1.f + fast_exp2(-v1[j] * LOG2E)); } }
                    if (t == 4) { v0 = v0 * QSCALE2; v1 = v1 * QSCALE2; }
                    u32x4 w; w.x = cvtpk(v0[0], v0[1]); w.y = cvtpk(v0[2], v0[3]); w.z = cvtpk(v1[0], v1[1]); w.w = cvtpk(v1[2], v1[3]);
                    *(u32x4*)(rowp + bj * HALF) = w; } }
    }
};
struct EpiOut {
    static constexpr bool PERM = false;
    const float* X; float* O;
    __device__ __forceinline__ void operator()(const f32x4 (&acc)[2][2][4][2], const Unit& u, int wr, int wc, int fr, int fq) const {
        const int row0 = u.pm * BM + wr * 64 + fr, col0 = u.pn * BM + wc * 32 + 4 * fq;
#pragma unroll
        for (int ai = 0; ai < 2; ++ai)
#pragma unroll
            for (int m = 0; m < 4; ++m) { const size_t off = (size_t)(row0 + ai * HALF + m * 16) * DM + col0;
#pragma unroll
                for (int bj = 0; bj < 2; ++bj)
#pragma unroll
                    for (int n = 0; n < 2; ++n) { const f32x4 xv = *(const f32x4*)(X + off + bj * HALF + n * 16); *(f32x4*)(O + off + bj * HALF + n * 16) = xv + acc[ai][bj][m][n]; } }
    }
};
}

namespace moe {
constexpr int MT = 384, BKT = 64, A_BYTES = MT * BKT * 2, B_PITCH = 320, B_BYTES = BKT * B_PITCH;
constexpr int OFF_A = 0, OFF_B = 2 * A_BYTES, STAGE_END = 2 * A_BYTES + 2 * B_BYTES;
typedef short v4i16_t __attribute__((ext_vector_type(4)));
__device__ __forceinline__ void glds16(const void* gsrc, unsigned lds_dst) { unsigned keep;
    asm volatile("s_mov_b32 %0, m0\n\ts_mov_b32 m0, %2\n\ts_nop 0\n\tglobal_load_lds_dwordx4 %1, off\n\ts_mov_b32 m0, %0" : "=&s"(keep) : "v"(gsrc), "s"(lds_dst) : "memory"); }
__device__ __forceinline__ s16x4 vtr(const LAS unsigned char* p) { return __builtin_bit_cast(s16x4, __builtin_amdgcn_ds_read_tr16_b64_v4i16((LAS v4i16_t*)p)); }

struct Order {
    int G, c, ncs; const LAS int* upre; const LAS int* cpre;
    __device__ __forceinline__ bool decode(int i, int& e, int& cs, int& mt, int& cnt, int& cbase) const {
        const int L = i * G + c; if (L >= __builtin_amdgcn_readfirstlane(upre[NE])) return false;
        int lo = 0, hi = NE;
        while (hi - lo > 1) { const int mid = (lo + hi) >> 1; const int v = __builtin_amdgcn_readfirstlane(upre[mid]); if (v <= L) lo = mid; else hi = mid; }
        e = lo; const int u0 = __builtin_amdgcn_readfirstlane(upre[e]), u1 = __builtin_amdgcn_readfirstlane(upre[e + 1]), ntm = (u1 - u0) / ncs, r = L - u0;
        cs = r / ntm; mt = r - cs * ntm; cbase = __builtin_amdgcn_readfirstlane(cpre[e]); cnt = __builtin_amdgcn_readfirstlane(cpre[e + 1]) - cbase; return true;
    }
};

template <int KDIM, bool G1, bool WW>
__device__ __forceinline__ void unit_kloop(LAS unsigned char* lds, f32x16 (&acc)[3][2], const int tid, const int wid, const int lane, const LAS int* tabrow, const int arow0, const char* Abase, const float* bsrc0, const float* bsrc1) {
    constexpr int NTK = KDIM / BKT; constexpr int LDB = G1 ? DE : DM;
    const int r32 = lane & 31, hi = lane >> 5, wr = wid >> 1, wc = wid & 1;
    unsigned aoff[12];
    if constexpr (!WW) {
#pragma unroll
        for (int q = 0; q < 12; ++q) { const int row = 8 * (4 * q + (wid & 3)) + (lane >> 3); const int arow = G1 ? tabrow[row] : arow0 + row;
            aoff[q] = (unsigned)arow * (unsigned)(KDIM * 2) + (unsigned)(((lane & 7) ^ (row & 7)) * 16); } }
    const int wv = wid - 4, tl2 = (wv & 1) * 64 + lane, bk = tl2 >> 4, bc = (wv >> 1) * 64 + (tl2 & 15) * 4;
    const float* bbase = (wv >> 1) ? bsrc1 : bsrc0;
    const unsigned boffl = (unsigned)(bk * LDB + (tl2 & 15) * 4) * 4u;
    const unsigned bwr = (unsigned)(bk * B_PITCH + bc * 2);
    const unsigned trbv = (unsigned)(uintptr_t)(lds + OFF_B + (8 * hi + ((lane & 15) >> 2)) * B_PITCH + (16 * ((lane >> 4) & 1) + 4 * (lane & 3)) * 2 + wc * 64);
    const unsigned ldsA = (unsigned)(uintptr_t)(lds + OFF_A) + (unsigned)(wid & 3) * 1024u;
    const LAS unsigned char* xa[4];
#pragma unroll
    for (int ks = 0; ks < 4; ++ks) xa[ks] = lds + OFF_A + (32 * wr + r32) * 128 + (((2 * ks + hi) ^ (r32 & 7)) * 16);
    f32x4 R0[8], R1[8], R2[8];
#define MOE_DMA_A(t, buf) do { if constexpr (!WW) { _Pragma("unroll") for (int q = 0; q < 12; ++q) \
        glds16(Abase + aoff[q] + (size_t)(t) * (BKT * 2), (unsigned)__builtin_amdgcn_readfirstlane((int)(ldsA + (buf) * A_BYTES + q * 4096))); } } while (0)
#define MOE_LDB(R, t) do { if constexpr (WW) { const int t_ = (t) < NTK ? (t) : NTK - 1; _Pragma("unroll") for (int i = 0; i < 8; ++i) R[i] = __builtin_nontemporal_load((const f32x4*)((const char*)(bbase + (size_t)(t_ * BKT + 8 * i) * LDB) + boffl)); } asm volatile("" ::: "memory"); __builtin_amdgcn_sched_barrier(0); } while (0)
#define MOE_WRB(R, buf) do { if constexpr (WW) { asm volatile("s_waitcnt vmcnt(16)" ::: "memory"); _Pragma("unroll") for (int i = 0; i < 8; ++i) *(LAS v2u*)(lds + OFF_B + (buf) * B_BYTES + bwr + i * 8 * B_PITCH) = (v2u){cvtpk(R[i].x, R[i].y), cvtpk(R[i].z, R[i].w)}; } } while (0)
#define MOE_TR4(W0, W1, W2, W3, off) asm volatile("ds_read_b64_tr_b16 %0, %4 offset:%5\n\tds_read_b64_tr_b16 %1, %4 offset:%6\n\tds_read_b64_tr_b16 %2, %4 offset:%7\n\tds_read_b64_tr_b16 %3, %4 offset:%8" \
        : "=&v"(W0), "=&v"(W1), "=&v"(W2), "=&v"(W3) : "v"(trbv), "i"(off), "i"((off) + 4 * B_PITCH), "i"((off) + 128), "i"((off) + 4 * B_PITCH + 128) : "memory")
#define MOE_COMPUTE(buf) do { _Pragma("unroll") for (int ks = 0; ks < 4; ++ks) { \
        s16x4 l0_, h0_, l1_, h1_; bf16x8 xf[3]; \
        MOE_TR4(l0_, h0_, l1_, h1_, (buf) * B_BYTES + ks * 16 * B_PITCH); \
        _Pragma("unroll") for (int j = 0; j < 3; ++j) xf[j] = *(const LAS bf16x8*)(xa[ks] + (buf) * A_BYTES + j * 16384); \
        asm volatile("s_waitcnt lgkmcnt(0)" ::: "memory"); __builtin_amdgcn_sched_barrier(0); \
        const bf16x8 wf0 = (bf16x8){l0_[0], l0_[1], l0_[2], l0_[3], h0_[0], h0_[1], h0_[2], h0_[3]}, wf1 = (bf16x8){l1_[0], l1_[1], l1_[2], l1_[3], h1_[0], h1_[1], h1_[2], h1_[3]}; \
        _Pragma("unroll") for (int j = 0; j < 3; ++j) { acc[j][0] = __builtin_amdgcn_mfma_f32_32x32x16_bf16(wf0, xf[j], acc[j][0], 0, 0, 0); acc[j][1] = __builtin_amdgcn_mfma_f32_32x32x16_bf16(wf1, xf[j], acc[j][1], 0, 0, 0); } } } while (0)
#define MOE_ENDT() do { if constexpr (!WW) asm volatile("s_waitcnt vmcnt(0)" ::: "memory"); LDS_WAIT(); __builtin_amdgcn_s_barrier(); } while (0)
#define MOE_STEP(t, buf, RN) do { MOE_DMA_A((t) + 1 < NTK ? (t) + 1 : (t), 1 - (buf)); MOE_COMPUTE(buf); MOE_WRB(RN, 1 - (buf)); MOE_LDB(RN, (t) + 4); MOE_ENDT(); } while (0)
    MOE_LDB(R0, 0); MOE_LDB(R1, 1); MOE_LDB(R2, 2); MOE_DMA_A(0, 0);
    MOE_WRB(R0, 0); MOE_LDB(R0, 3);
    MOE_ENDT();
    int t = 0;
    for (; t + 6 <= NTK; t += 6) { MOE_STEP(t, 0, R1); MOE_STEP(t + 1, 1, R2); MOE_STEP(t + 2, 0, R0); MOE_STEP(t + 3, 1, R1); MOE_STEP(t + 4, 0, R2); MOE_STEP(t + 5, 1, R0); }
    static_assert(NTK % 6 == 2, "K-tile count: 32 or 8");
    MOE_STEP(t, 0, R1); MOE_STEP(t + 1, 1, R2);
    asm volatile("s_waitcnt vmcnt(0)" ::: "memory");
#undef MOE_DMA_A
#undef MOE_LDB
#undef MOE_WRB
#undef MOE_TR4
#undef MOE_COMPUTE
#undef MOE_ENDT
#undef MOE_STEP
}

template <int KDIM, bool G1>
__device__ __forceinline__ void phase(LAS unsigned char* lds, const Order& S, const LAS int* tab, const char* Abase, const float* Wa, const float* Wb, bf16* Out) {
    for (int ui = 0;; ++ui) {
        int e, cs, mt, cnt, cbase; if (!S.decode(ui, e, cs, mt, cnt, cbase)) break;
        const int rows_valid = cnt - MT * mt;
        const float* bsrc0 = G1 ? (Wa + (size_t)e * DM * DE + 64 * cs) : (Wa + (size_t)e * DE * DM + 128 * cs);
        const float* bsrc1 = G1 ? (Wb + (size_t)e * DM * DE + 64 * cs) : (Wa + (size_t)e * DE * DM + 128 * cs + 64);
        f32x16 acc[3][2];
#pragma unroll
        for (int j = 0; j < 3; ++j) { acc[j][0] = f32x16{}; acc[j][1] = f32x16{}; }
        __syncthreads();
        { const int tid = opaque_tid(), wid = __builtin_amdgcn_readfirstlane(tid >> 6), lane = tid & 63;
        if (wid >= 4) unit_kloop<KDIM, G1, true>(lds, acc, tid, wid, lane, tab + ui * MT, cbase + MT * mt, Abase, bsrc0, bsrc1);
        else unit_kloop<KDIM, G1, false>(lds, acc, tid, wid, lane, tab + ui * MT, cbase + MT * mt, Abase, bsrc0, bsrc1); }
        const int tid = opaque_tid(), wid = __builtin_amdgcn_readfirstlane(tid >> 6), lane = tid & 63, r32 = lane & 31, hi = lane >> 5, wr = wid >> 1, wc = wid & 1;
#pragma unroll
        for (int j = 0; j < 3; ++j) { const int row = 32 * (wr + 4 * j) + r32;
            if (row < rows_valid) { const size_t orow = (size_t)(cbase + MT * mt + row);
                if (G1) { bf16* op = Out + orow * DE + 64 * cs + 32 * wc + 4 * hi;
#pragma unroll
                    for (int g = 0; g < 4; ++g) { float h4[4];
#pragma unroll
                        for (int i2 = 0; i2 < 4; ++i2) { const float a = acc[j][0][4 * g + i2], b = acc[j][1][4 * g + i2]; h4[i2] = a * fast_rcp(1.f + fast_exp2(-a * LOG2E)) * b; }
                        *(v2u*)(op + 8 * g) = (v2u){cvtpk(h4[0], h4[1]), cvtpk(h4[2], h4[3])}; } }
                else { const float w = ((const LAS float*)tab)[ui * MT + row]; bf16* op = Out + orow * DM + 128 * cs + 32 * wc + 4 * hi;
#pragma unroll
                    for (int nbi = 0; nbi < 2; ++nbi)
#pragma unroll
                        for (int g = 0; g < 4; ++g) *(v2u*)(op + 64 * nbi + 8 * g) = (v2u){cvtpk(acc[j][nbi][4 * g] * w, acc[j][nbi][4 * g + 1] * w), cvtpk(acc[j][nbi][4 * g + 2] * w, acc[j][nbi][4 * g + 3] * w)}; } } }
    }
}
}

namespace att {
#define KSWZ(row, colB) ((row) * 256 + ((colB) ^ (((row) & 7) << 4)))
#define SBAR() __builtin_amdgcn_sched_barrier(0)
constexpr int SHM_V = 16384, SHM_K = 16384;
constexpr int KS_OFF = 32768, WSF_OFF = 33792, WSF_FLOATS = 1152;
__device__ __forceinline__ int v_st(int k, int c) { const int kk = (k & ~0xC) | ((k & 4) << 1) | ((k & 8) >> 1); return ((kk >> 3) * 4 + (c >> 5)) * 512 + ((kk & 7) * 32 + (c & 31)) * 2; }
__device__ __forceinline__ int v_rd_base(int lane) { return ((lane & 3) << 3) | (((lane >> 2) & 3) << 6) | (((lane >> 4) & 1) << 5) | (((lane >> 5) & 1) << 8); }
constexpr int v_rd_off(int d0, int ks, int half) { return d0 * 512 + ks * 4096 + half * 2048; }
__device__ __forceinline__ int crow(int r, int hi) { return (r & 3) + 8 * (r >> 2) + 4 * hi; }

__device__ __forceinline__ void qkt(f32x16& p0, f32x16& p1, const char* K_lds, int r32, int hi, const bf16x8* qr) {
    p0 = f32x16{}; p1 = f32x16{};
    const char* kb[4];
#pragma unroll
    for (int dd = 0; dd < 4; ++dd) kb[dd] = K_lds + KSWZ(r32, (dd * 16 + hi * 8) * 2);
#pragma unroll
    for (int d0 = 0; d0 < 8; ++d0) { const char* a = kb[d0 & 3] + (d0 >> 2) * 128;
        bf16x8 b0 = *reinterpret_cast<const bf16x8*>(a);
        bf16x8 b1 = *reinterpret_cast<const bf16x8*>(a + 32 * 256);
        p0 = __builtin_amdgcn_mfma_f32_32x32x16_bf16(b0, qr[d0], p0, 0, 0, 0);
        p1 = __builtin_amdgcn_mfma_f32_32x32x16_bf16(b1, qr[d0], p1, 0, 0, 0); }
}
__device__ __forceinline__ void pv_tile(f32x16* o, int vb0, bf16x8 pa0, bf16x8 pa1, bf16x8 pa2, bf16x8 pa3) {
#define TRRD(dst, off) asm volatile("ds_read_b64_tr_b16 %0, %1 offset:%2" : "=&v"(dst) : "v"(vb0), "i"(off) : "memory")
#define PV_D0(d0) do { s16x4 l0, l1, l2, l3, h0, h1, h2, h3; constexpr int b_ = v_rd_off(d0, 0, 0); \
        TRRD(l0, b_); TRRD(h0, b_ + 2048); TRRD(l1, b_ + 4096); TRRD(h1, b_ + 6144); TRRD(l2, b_ + 8192); TRRD(h2, b_ + 10240); TRRD(l3, b_ + 12288); TRRD(h3, b_ + 14336); \
        asm volatile("s_waitcnt lgkmcnt(0)" ::: "memory"); SBAR(); \
        o[d0] = __builtin_amdgcn_mfma_f32_32x32x16_bf16(pa0, (bf16x8){l0[0], l0[1], l0[2], l0[3], h0[0], h0[1], h0[2], h0[3]}, o[d0], 0, 0, 0); \
        o[d0] = __builtin_amdgcn_mfma_f32_32x32x16_bf16(pa1, (bf16x8){l1[0], l1[1], l1[2], l1[3], h1[0], h1[1], h1[2], h1[3]}, o[d0], 0, 0, 0); \
        o[d0] = __builtin_amdgcn_mfma_f32_32x32x16_bf16(pa2, (bf16x8){l2[0], l2[1], l2[2], l2[3], h2[0], h2[1], h2[2], h2[3]}, o[d0], 0, 0, 0); \
        o[d0] = __builtin_amdgcn_mfma_f32_32x32x16_bf16(pa3, (bf16x8){l3[0], l3[1], l3[2], l3[3], h3[0], h3[1], h3[2], h3[3]}, o[d0], 0, 0, 0); } while (0)
    PV_D0(0); PV_D0(1); PV_D0(2); PV_D0(3);
#undef PV_D0
#undef TRRD
}
#define PK4(P, B_, OUT) do { unsigned a0 = cvtpk(P[B_+0], P[B_+1]), a1 = cvtpk(P[B_+2], P[B_+3]); \
        unsigned b0 = cvtpk(P[B_+4], P[B_+5]), b1 = cvtpk(P[B_+6], P[B_+7]); \
        auto r0 = __builtin_amdgcn_permlane32_swap(a0, b0, false, false); auto r1 = __builtin_amdgcn_permlane32_swap(a1, b1, false, false); \
        v4u w = {r0[0], r1[0], r0[1], r1[1]}; OUT = *reinterpret_cast<bf16x8*>(&w); } while (0)

struct Tensors {
    const bf16* QA; const bf16* KA; const bf16* VA; const bf16* GA; const bf16* QB; const bf16* KB; const bf16* VB;
    const float* SS; const float* CUM;
    const float* q_gain; const float* k_gain;
    const float* fox_gain; const float* sb_gain;
    bf16* MIX;
};

template <int TYP>
__device__ __forceinline__ void attn_wave(char* ldsw, const Tensors& T, const int b, const int h, const int f0) {
    const int lane = opaque_tid() & 63, r32 = lane & 31, hi = lane >> 5;
    char* V_lds = ldsw;
    float* ks_rk = (float*)(ldsw + 8192); float* ks_nc = ks_rk + 32;
    float* wsf = (float*)(ldsw + 8192 + 256); float* part = wsf; float* li_l = wsf + 1056; float* rs_l = wsf + 1088;
    const bf16* Qp = TYP == 0 ? T.QA : T.QB; const bf16* Kp = TYP == 0 ? T.KA : T.KB; const bf16* Vp = TYP == 0 ? T.VA : T.VB;
    const int frow0 = b * SEQ + f0;
    const int cbase = (b * NH + h) * CUMLD;
    const int jd = (64 + f0) >> 5;
    bf16x8 qr[8];
#pragma unroll
    for (int d0 = 0; d0 < 8; ++d0) qr[d0] = *reinterpret_cast<const bf16x8*>(Qp + (size_t)(frow0 + r32) * 1024 + h * HD + d0 * 16 + hi * 8);
    float mt2 = 0.f;
    if (TYP == 0) {
        const f32x4 sp = *(const f32x4*)(T.SS + ((size_t)(frow0 + r32) * 8 + h) * 4);
        const float rstd = (1.0f / sqrtf(((sp.x + sp.y) + (sp.z + sp.w)) * (1.f / HD) + EPS)) * QSCALE2;
        float n2 = 0.f;
#pragma unroll
        for (int d0 = 0; d0 < 8; ++d0) { const int db = d0 * 16 + hi * 8;
            const f32x4 ga = *(const f32x4*)(T.q_gain + db), gb = *(const f32x4*)(T.q_gain + db + 4), ka = *(const f32x4*)(T.k_gain + db), kb = *(const f32x4*)(T.k_gain + db + 4);
            const float g8[8] = {ga.x * ka.x, ga.y * ka.y, ga.z * ka.z, ga.w * ka.w, gb.x * kb.x, gb.y * kb.y, gb.z * kb.z, gb.w * kb.w};
            v4u w = *reinterpret_cast<v4u*>(&qr[d0]); unsigned ww[4] = {w.x, w.y, w.z, w.w};
#pragma unroll
            for (int i = 0; i < 4; ++i) { const float lo = __uint_as_float(ww[i] << 16) * rstd * g8[2 * i], hi2 = __uint_as_float(ww[i] & 0xffff0000u) * rstd * g8[2 * i + 1]; n2 += lo * lo + hi2 * hi2; ww[i] = cvtpk(lo, hi2); }
            w = (v4u){ww[0], ww[1], ww[2], ww[3]}; qr[d0] = *reinterpret_cast<bf16x8*>(&w); }
        n2 += __shfl_xor(n2, 32);
        mt2 = sqrtf(n2 * (float)HD);
    }
    const int qp = 64 + f0 + r32;
    float bias_t = 0.f, cum_t = 0.f, Rrun = 0.f, l_reg = 0.f;
    if (TYP == 0) { cum_t = T.CUM[cbase + qp - 48]; bias_t = cum_t - mt2; }
    f32x16 o[4] = {};
    const int vkey = lane >> 4, vcol = (lane & 15) * 8;
    const int vb0 = (int)(uintptr_t)V_lds + v_rd_base(lane);
    for (int j = jd; j >= 1; --j) {
        const int kr0 = (j >= 2) ? b * SEQ + 32 * j - 64 : ROW_META - 16;
        const int krow = (j >= 2 || r32 >= 16) ? kr0 + r32 : ROW_META;
        bf16x8 kf[8], vs[8];
#pragma unroll
        for (int d0 = 0; d0 < 8; ++d0) kf[d0] = *reinterpret_cast<const bf16x8*>(Kp + (size_t)krow * 1024 + h * HD + d0 * 16 + hi * 8);
#pragma unroll
        for (int i = 0; i < 8; ++i) { const int vk = vkey + 4 * i; const int vrow = (j >= 2 || vk >= 16) ? kr0 + vk : ROW_META;
            vs[i] = *reinterpret_cast<const bf16x8*>(Vp + (size_t)vrow * 1024 + h * HD + vcol); }
        float sc = 0.f;
        if (TYP == 0) { const int ki = lane & 31; const int srow = (j >= 2 || ki >= 16) ? kr0 + ki : ROW_META; const int pos = (j >= 2) ? 32 * j - 48 + ki : (ki >= 16 ? ki - 16 : 0);
            if (lane < 32) { const f32x4 sk = *(const f32x4*)(T.SS + (((size_t)MROWS + srow) * 8 + h) * 4); sc = 1.0f / sqrtf(((sk.x + sk.y) + (sk.z + sk.w)) * (1.f / HD) + EPS); }
            else sc = -T.CUM[cbase + pos]; }
#pragma unroll
        for (int i = 0; i < 8; ++i) *(bf16x8*)(V_lds + v_st(vkey + 4 * i, vcol)) = vs[i];
        if (TYP == 0) ks_rk[lane] = sc;
        LDS_WAIT();
        f32x16 p0 = f32x16{};
#pragma unroll
        for (int d0 = 0; d0 < 8; ++d0) p0 = __builtin_amdgcn_mfma_f32_32x32x16_bf16(kf[d0], qr[d0], p0, 0, 0, 0);
        const bool need_mask = (j == jd) || (j == 1);
        const int kp0 = 32 * j + 4 * hi;
        bf16x8 pa0, pa1;
        if (TYP == 0) {
#pragma unroll
            for (int q = 0; q < 4; ++q) { const f32x4 rkv = *(const f32x4*)(ks_rk + 8 * q + 4 * hi), ncv = *(const f32x4*)(ks_nc + 8 * q + 4 * hi);
#pragma unroll
                for (int i = 0; i < 4; ++i) p0[4 * q + i] = fmaf(p0[4 * q + i], rkv[i], ncv[i]) + bias_t; }
            if (need_mask) {
#pragma unroll
                for (int r = 0; r < 16; ++r) { const int kp = kp0 + (r & 3) + 8 * (r >> 2); if (!(kp <= qp && kp >= 48)) p0[r] = -__builtin_inff(); } }
            float ps = 0.f;
#pragma unroll
            for (int r = 0; r < 16; ++r) { p0[r] = fast_exp2(p0[r]); ps += p0[r]; }
            l_reg += ps;
        } else {
            f32x16 k0;
#pragma unroll
            for (int r = 0; r < 16; ++r) { const float z = p0[r], sp = fmaxf(z, 0.f) + fast_log2(1.f + fast_exp2(-fabsf(z))); k0[r] = -sp; p0[r] = z - sp; }
            if (need_mask) {
#pragma unroll
                for (int r = 0; r < 16; ++r) { const int kp = kp0 + (r & 3) + 8 * (r >> 2); if (!(kp < qp && kp >= 48)) { p0[r] = -__builtin_inff(); k0[r] = 0.f; } } }
            float so = 0.f, spi = 0.f;
#pragma unroll
            for (int i = 3; i >= 0; --i) {
                const float g = (k0[4 * i] + k0[4 * i + 1]) + (k0[4 * i + 2] + k0[4 * i + 3]);
                const float spn = spi + __shfl_xor(g, 32);
                const float off = Rrun + so + (hi ? spi : spn);
                const float l3 = off, l2 = l3 + k0[4 * i + 3], l1 = l2 + k0[4 * i + 2], l0 = l1 + k0[4 * i + 1];
                p0[4 * i + 3] = fast_exp2(p0[4 * i + 3] + l3); p0[4 * i + 2] = fast_exp2(p0[4 * i + 2] + l2); p0[4 * i + 1] = fast_exp2(p0[4 * i + 1] + l1); p0[4 * i] = fast_exp2(p0[4 * i] + l0);
                so += g; spi = spn;
            }
            Rrun += so + spi;
        }
        PK4(p0, 0, pa0); PK4(p0, 8, pa1);
        {
#define TRRD(dst, off) asm volatile("ds_read_b64_tr_b16 %0, %1 offset:%2" : "=&v"(dst) : "v"(vb0), "i"(off) : "memory")
#define PV_D0(d0) do { s16x4 l0, l1, h0, h1; constexpr int b_ = v_rd_off(d0, 0, 0); \
            TRRD(l0, b_); TRRD(h0, b_ + 2048); TRRD(l1, b_ + 4096); TRRD(h1, b_ + 6144); \
            asm volatile("s_waitcnt lgkmcnt(0)" ::: "memory"); SBAR(); \
            o[d0] = __builtin_amdgcn_mfma_f32_32x32x16_bf16(pa0, (bf16x8){l0[0], l0[1], l0[2], l0[3], h0[0], h0[1], h0[2], h0[3]}, o[d0], 0, 0, 0); \
            o[d0] = __builtin_amdgcn_mfma_f32_32x32x16_bf16(pa1, (bf16x8){l1[0], l1[1], l1[2], l1[3], h1[0], h1[1], h1[2], h1[3]}, o[d0], 0, 0, 0); } while (0)
            PV_D0(0); PV_D0(1); PV_D0(2); PV_D0(3);
#undef PV_D0
#undef TRRD
        }
        if (j > 1) { bool conv;
            if (TYP == 0) { const float lt = l_reg + __shfl_xor(l_reg, 32); conv = (cum_t + ks_nc[0]) <= fast_log2(lt) - 41.f; }
            else conv = Rrun <= -30.f;
            if (__all(conv)) break; }
    }
    int lane_e = lane, frow_e = frow0;
    asm volatile("" : "+v"(lane_e), "+s"(frow_e));
    const int r32e = lane_e & 31, hie = lane_e >> 5;
    if (TYP == 0) {
        l_reg += __shfl_xor(l_reg, 32);
        if (hie == 0) li_l[r32e] = fast_rcp(l_reg);
        LDS_WAIT();
#pragma unroll
        for (int r = 0; r < 16; ++r) { const float il = li_l[crow(r, hie)];
#pragma unroll
            for (int d0 = 0; d0 < 4; ++d0) o[d0][r] *= il; }
    }
#pragma unroll
    for (int r = 0; r < 16; ++r) { float s = 0.f;
#pragma unroll
        for (int d0 = 0; d0 < 4; ++d0) s += o[d0][r] * o[d0][r];
        part[crow(r, hie) * 33 + r32e] = s; }
    LDS_WAIT();
    { float s = 0.f;
#pragma unroll
      for (int c = 0; c < 16; ++c) s += part[r32e * 33 + hie * 16 + c];
      s += __shfl_xor(s, 32);
      if (hie == 0) rs_l[r32e] = 1.0f / sqrtf(s * (1.f / HD) + EPS); }
    LDS_WAIT();
    const float* gain = (TYP == 0 ? T.fox_gain : T.sb_gain) + h * HD;
    float gn[4];
#pragma unroll
    for (int d0 = 0; d0 < 4; ++d0) gn[d0] = gain[d0 * 32 + r32e];
    unsigned short* stg = (unsigned short*)V_lds;
    if (TYP == 0) {
#pragma unroll
        for (int i = 0; i < 8; ++i) { const int c = lane_e + 64 * i, row = c >> 4, ch = c & 15;
            *(v4u*)(stg + row * 128 + ch * 8) = *(const v4u*)(T.GA + (size_t)(frow_e + row) * 1024 + h * HD + ch * 8); }
        LDS_WAIT();
#pragma unroll
        for (int r = 0; r < 16; ++r) { const int orow = crow(r, hie);
#pragma unroll
            for (int d0 = 0; d0 < 4; ++d0) o[d0][r] *= bf2f(stg[orow * 128 + d0 * 32 + r32e]); }
        LDS_WAIT();
    }
#pragma unroll
    for (int r = 0; r < 16; ++r) { const int orow = crow(r, hie); const float rs = rs_l[orow];
#pragma unroll
        for (int d0 = 0; d0 < 4; ++d0) { const float v = o[d0][r] * rs * gn[d0]; const float vn = __shfl_xor(v, 1);
            if ((r32e & 1) == 0) *(unsigned*)(stg + orow * 128 + d0 * 32 + r32e) = cvtpk(v, vn); } }
    LDS_WAIT();
#pragma unroll
    for (int i = 0; i < 8; ++i) { const int c = lane_e + 64 * i, row = c >> 4, ch = c & 15;
        *(v4u*)(T.MIX + (size_t)(frow_e + row) * DM + TYP * 1024 + h * HD + ch * 8) = *(const v4u*)(stg + row * 128 + ch * 8); }
    LDS_WAIT();
}
#undef PK4
#undef SBAR
#undef KSWZ
}

struct Frame {
    LAS unsigned char* lds; char* ldsg;
    volatile LAS unsigned* MISC;
    gu32* ctl;
    int tid, lane, wave, vcu, G;
    unsigned char* ws;
    const float *x, *meta, *g1, *w_in, *b_f, *q_gain, *k_gain, *fox_gain, *sb_gain, *w_out, *g2, *w_coarse, *b_coarse, *w_fine, *b_fine, *w1, *w3, *w2;
    float* out;
};

__device__ __forceinline__ void transpose_item(const float* W, size_t ldw, int k0, int n0, bf16* WT, size_t Kd, size_t drow0, LAS float* scr, int lane) {
    { const int r = lane >> 4, c4 = (lane & 15) * 4; const float* src = W + (size_t)(k0 + r) * ldw + n0 + c4; LAS float* dst = scr + r * 65 + c4;
#pragma unroll
      for (int hlf = 0; hlf < 2; ++hlf) { f32x4 v[8];
#pragma unroll
          for (int i = 0; i < 8; ++i) v[i] = *(const f32x4*)(src + (size_t)(4 * (8 * hlf + i)) * ldw);
#pragma unroll
          for (int i = 0; i < 8; ++i) { LAS float* d = dst + 4 * (8 * hlf + i) * 65; d[0] = v[i].x; d[1] = v[i].y; d[2] = v[i].z; d[3] = v[i].w; } } }
    LDS_WAIT(); asm volatile("" ::: "memory");
    const int c = lane & 7;
#pragma unroll
    for (int j = 0; j < 8; ++j) { const int n = (lane >> 3) + 8 * j; const LAS float* s = scr + (8 * c) * 65 + n;
        v4u o; o.x = cvtpk(s[0 * 65], s[1 * 65]); o.y = cvtpk(s[2 * 65], s[3 * 65]); o.z = cvtpk(s[4 * 65], s[5 * 65]); o.w = cvtpk(s[6 * 65], s[7 * 65]);
        *(GAS v4u*)(WT + (drow0 + n) * Kd + k0 + 8 * c) = o; }
    LDS_WAIT(); asm volatile("" ::: "memory");
}

__device__ __forceinline__ void p0_prologue(Frame& F) {
    const int gw = F.vcu * 8 + F.wave, NGW = F.G * 8;
    LAS float* wf = (LAS float*)F.lds;
    for (int e = F.tid; e < 8 * DM; e += 512) { const int k = e >> 3, jj = e & 7; wf[jj * DM + k] = F.w_in[(size_t)k * LDW_IN + NPROJ + jj]; }
    __syncthreads();
    bf16* U1 = (bf16*)(F.ws + WS_U1); float* Fp = (float*)(F.ws + WS_F);
    for (int m = gw; m < MROWS; m += NGW) {
        GAS v2u* o8 = (GAS v2u*)(U1 + (size_t)m * DM) + F.lane;
        if (m >= NKEYROWS) {
#pragma unroll
            for (int j = 0; j < 8; ++j) o8[64 * j] = (v2u){0u, 0u};
            continue; }
        const float* xrow = m < TF ? F.x + (size_t)m * DM : F.meta + (size_t)(m - TF) * DM;
        const GAS f32x4* xr = (const GAS f32x4*)xrow + F.lane;
        f32x4 v[8]; float s = 0.f;
#pragma unroll
        for (int j = 0; j < 8; ++j) { v[j] = xr[64 * j]; s += (v[j].x * v[j].x + v[j].y * v[j].y) + (v[j].z * v[j].z + v[j].w * v[j].w); }
        const float rstd = 1.0f / sqrtf(wave_sum(s) * (1.f / DM) + EPS);
        float fa[8] = {0.f, 0.f, 0.f, 0.f, 0.f, 0.f, 0.f, 0.f};
#pragma unroll
        for (int j = 0; j < 8; ++j) { const f32x4 g = *((const GAS f32x4*)F.g1 + F.lane + 64 * j); v[j] = v[j] * rstd * g;
            o8[64 * j] = (v2u){cvtpk(v[j].x, v[j].y), cvtpk(v[j].z, v[j].w)};
#pragma unroll
            for (int jj = 0; jj < 8; ++jj) { const f32x4 w = *(const LAS f32x4*)(wf + jj * DM + 256 * j + 4 * F.lane); fa[jj] += (v[j].x * w.x + v[j].y * w.y) + (v[j].z * w.z + v[j].w * w.w); } }
#pragma unroll
        for (int jj = 0; jj < 8; ++jj) fa[jj] = wave_sum(fa[jj]);
        if (F.lane == 0) {
#pragma unroll
            for (int jj = 0; jj < 8; ++jj) Fp[(size_t)m * 8 + jj] = fa[jj]; }
    }
    { bf16* U2 = (bf16*)(F.ws + WS_U2);
      for (int m = TF + gw; m < MROWS; m += NGW) { GAS v2u* o8 = (GAS v2u*)(U2 + (size_t)m * DM) + F.lane;
#pragma unroll
          for (int j = 0; j < 8; ++j) o8[64 * j] = (v2u){0u, 0u}; } }
    { bf16* HID = (bf16*)(F.ws + WS_HID);
      for (int m = NASSIGN + gw; m < NASSIGN + 384; m += NGW) { GAS v2u* o8 = (GAS v2u*)(HID + (size_t)m * DE) + F.lane; o8[0] = (v2u){0u, 0u}; o8[64] = (v2u){0u, 0u}; } }
    { v4u* RB = (v4u*)(F.ws + WS_RB);
      for (int it = gw * 64 + F.lane; it < 64 * 5 * 64; it += NGW * 64) { const int ln = it & 63, kc = it >> 6, ks = kc / 5, cb = kc % 5, col = 16 * cb + (ln & 15), k0 = 32 * ks + 8 * (ln >> 4);
          float w[8], lo[8]; unsigned hb[4], lb[4];
#pragma unroll
          for (int i = 0; i < 8; ++i) { w[i] = col < 8 ? F.w_coarse[(size_t)(k0 + i) * 8 + col] : (col < 72 ? F.w_fine[(size_t)(k0 + i) * 64 + col - 8] : 0.f); }
#pragma unroll
          for (int i = 0; i < 4; ++i) { hb[i] = cvtpk(w[2 * i], w[2 * i + 1]); lo[2 * i] = w[2 * i] - __uint_as_float(hb[i] << 16); lo[2 * i + 1] = w[2 * i + 1] - __uint_as_float(hb[i] & 0xffff0000u); lb[i] = cvtpk(lo[2 * i], lo[2 * i + 1]); }
          RB[(size_t)(kc * 2 + 0) * 64 + ln] = (v4u){hb[0], hb[1], hb[2], hb[3]}; RB[(size_t)(kc * 2 + 1) * 64 + ln] = (v4u){lb[0], lb[1], lb[2], lb[3]}; } }
    __syncthreads();
    LAS float* scr = (LAS float*)(F.lds + F.wave * 16640);
    bf16* WinT = (bf16*)(F.ws + WS_WIN_T); bf16* WoutT = (bf16*)(F.ws + WS_WOUT_T);
    constexpr int I_IN = (DM / 64) * (NPROJ / 64), I_OUT = (DM / 64) * (DM / 64);
    constexpr int NITEMS = I_IN + I_OUT;
    for (int it = gw; it < NITEMS; it += NGW) {
        int r = it;
        if (r < I_IN) { const int kb = r / (NPROJ / 64), nb = r % (NPROJ / 64); transpose_item(F.w_in, LDW_IN, kb * 64, nb * 64, WinT, DM, nb * 64, scr, F.lane); continue; } r -= I_IN;
        { const int kb = r / (DM / 64), nb = r % (DM / 64); transpose_item(F.w_out, DM, kb * 64, nb * 64, WoutT, DM, nb * 64, scr, F.lane); }
    }
}

__device__ __forceinline__ void cum_scan(Frame& F, int bh) {
    const float* Fp = (const float*)(F.ws + WS_F); float* CUM = (float*)(F.ws + WS_CUM);
    const int b = bh >> 3, h = bh & 7; const float bf = F.b_f[h]; float carry = 0.f;
    for (int c0 = 0; c0 < LPOS; c0 += 64) { const int pos = c0 + F.lane; float v = 0.f;
        if (pos < LPOS) { const int row = pos < NMETA ? ROW_META + pos : b * SEQ + pos - NMETA; const float xv = Fp[(size_t)row * 8 + h] + bf;
            v = (fminf(xv, 0.f) - log1pf(expf(-fabsf(xv)))) * LOG2E; }
#pragma unroll
        for (int o = 1; o < 64; o <<= 1) { const float t = __shfl_up(v, o); if (F.lane >= o) v += t; }
        v += carry;
        if (pos < LPOS) CUM[(size_t)bh * CUMLD + pos] = v;
        carry = __shfl(v, 63); }
}

__device__ __forceinline__ void p5_router(Frame& F) {
    const int ntask = TF / 16;
    const float* H1 = F.out; bf16* U2 = (bf16*)(F.ws + WS_U2); const v4u* RB = (const v4u*)(F.ws + WS_RB);
    int* RE = (int*)(F.ws + WS_ROUTE); int* RP = RE + TF * 2; float* RW = (float*)(RP + TF * 2); int* TOK = (int*)(F.ws + WS_TOK);
    const int tid = opaque_tid(), lane = tid & 63, wave = __builtin_amdgcn_readfirstlane(tid >> 6), tk = wave >> 2, kp = wave & 3;
    LAS float* pacc = (LAS float*)F.lds;
    LAS float* ssp = (LAS float*)(F.lds + 40960);
    LAS float* lg = (LAS float*)(F.lds + 41472) + tk * 16 * 88;
    const int i = lane & 15, kq = lane >> 4;
    for (int base = 0; base < ntask; base += 2 * F.G) {
        const int task = base + 2 * (int)blockIdx.x + tk; const bool live = task < ntask;
        const int row0 = (live ? task : 0) * 16; const float* hrow = H1 + (size_t)(row0 + i) * DM + 8 * kq + 512 * kp;
        float ss = 0.f;
#pragma unroll 8
        for (int ks = 0; ks < 16; ++ks) { const f32x4 a = *(const f32x4*)(hrow + 32 * ks), b = *(const f32x4*)(hrow + 32 * ks + 4);
            ss += (a.x * a.x + a.y * a.y) + (a.z * a.z + a.w * a.w) + (b.x * b.x + b.y * b.y) + (b.z * b.z + b.w * b.w); }
        ss += __shfl_xor(ss, 16); ss += __shfl_xor(ss, 32);
        if (lane < 16) ssp[wave * 16 + i] = ss;
        __syncthreads();
        const float rstd = 1.0f / sqrtf(((ssp[(4 * tk) * 16 + i] + ssp[(4 * tk + 1) * 16 + i]) + (ssp[(4 * tk + 2) * 16 + i] + ssp[(4 * tk + 3) * 16 + i])) * (1.f / DM) + EPS);
        f32x4 acc[5];
#pragma unroll
        for (int cb = 0; cb < 5; ++cb) acc[cb] = (f32x4){0.f, 0.f, 0.f, 0.f};
#pragma unroll 2
        for (int ks = 0; ks < 16; ++ks) { const int kg = 16 * kp + ks;
            const f32x4 a = *(const f32x4*)(hrow + 32 * ks), b = *(const f32x4*)(hrow + 32 * ks + 4);
            const f32x4 ga = *(const f32x4*)(F.g2 + 32 * kg + 8 * kq), gb = *(const f32x4*)(F.g2 + 32 * kg + 8 * kq + 4);
            float u[8] = {a.x * rstd * ga.x, a.y * rstd * ga.y, a.z * rstd * ga.z, a.w * rstd * ga.w, b.x * rstd * gb.x, b.y * rstd * gb.y, b.z * rstd * gb.z, b.w * rstd * gb.w};
            unsigned hb[4], lb[4];
#pragma unroll
            for (int q = 0; q < 4; ++q) { hb[q] = cvtpk(u[2 * q], u[2 * q + 1]); lb[q] = cvtpk(u[2 * q] - __uint_as_float(hb[q] << 16), u[2 * q + 1] - __uint_as_float(hb[q] & 0xffff0000u)); }
            v4u hv = {hb[0], hb[1], hb[2], hb[3]}, lv = {lb[0], lb[1], lb[2], lb[3]};
            if (live) *(v4u*)(U2 + (size_t)(row0 + i) * DM + 32 * kg + 8 * kq) = hv;
            const bf16x8 Ah = *reinterpret_cast<bf16x8*>(&hv), Al = *reinterpret_cast<bf16x8*>(&lv);
#pragma unroll
            for (int cb = 0; cb < 5; ++cb) { v4u bh = RB[(size_t)((kg * 5 + cb) * 2 + 0) * 64 + lane], bl = RB[(size_t)((kg * 5 + cb) * 2 + 1) * 64 + lane];
                const bf16x8 Bh = *reinterpret_cast<bf16x8*>(&bh), Bl = *reinterpret_cast<bf16x8*>(&bl);
                acc[cb] = __builtin_amdgcn_mfma_f32_16x16x32_bf16(Ah, Bh, acc[cb], 0, 0, 0);
                acc[cb] = __builtin_amdgcn_mfma_f32_16x16x32_bf16(Ah, Bl, acc[cb], 0, 0, 0);
                acc[cb] = __builtin_amdgcn_mfma_f32_16x16x32_bf16(Al, Bh, acc[cb], 0, 0, 0); }
        }
#pragma unroll
        for (int cb = 0; cb < 5; ++cb)
#pragma unroll
            for (int j = 0; j < 4; ++j) pacc[(wave * 16 + 4 * kq + j) * 80 + 16 * cb + i] = acc[cb][j];
        __syncthreads();
        if (kp == 0) {
#pragma unroll
            for (int m = 0; m < 20; ++m) { const int idx = lane + 64 * m, r = idx / 80, c = idx - r * 80;
                lg[r * 88 + c] = (pacc[((4 * tk) * 16 + r) * 80 + c] + pacc[((4 * tk + 1) * 16 + r) * 80 + c]) + (pacc[((4 * tk + 2) * 16 + r) * 80 + c] + pacc[((4 * tk + 3) * 16 + r) * 80 + c]); }
            LDS_WAIT(); asm volatile("" ::: "memory");
            if (lane < 16 && live) { const LAS float* L = lg + lane * 88; const int row = row0 + lane;
                float cmax = L[0] + F.b_coarse[0]; int gs = 0; float cv[8]; cv[0] = cmax;
#pragma unroll
                for (int g = 1; g < 8; ++g) { cv[g] = L[g] + F.b_coarse[g]; if (cv[g] > cmax) { cmax = cv[g]; gs = g; } }
                float den = 0.f;
#pragma unroll
                for (int g = 0; g < 8; ++g) den += expf(cv[g] - cmax);
                const float ggate = 1.0f / den;
                float f1 = -__builtin_inff(), f2 = -__builtin_inff(); int i1 = 0, i2 = 0;
#pragma unroll
                for (int jx = 0; jx < 8; ++jx) { const float fv = L[8 + gs * 8 + jx] + F.b_fine[gs * 8 + jx];
                    if (fv > f1) { f2 = f1; i2 = i1; f1 = fv; i1 = jx; } else if (fv > f2) { f2 = fv; i2 = jx; } }
                const float e2 = expf(f2 - f1), w1 = ggate / (1.f + e2), w2 = ggate * e2 / (1.f + e2);
                const int ea = gs * 8 + i1, eb = gs * 8 + i2;
                const int pa = (int)__hip_atomic_fetch_add(F.ctl + CW_CNT + 64 * ea, 1u, RLX_AGENT), pb = (int)__hip_atomic_fetch_add(F.ctl + CW_CNT + 64 * eb, 1u, RLX_AGENT);
                TOK[(size_t)ea * TOKLD + pa] = row * 2; TOK[(size_t)eb * TOKLD + pb] = row * 2 + 1;
                RE[row * 2] = ea; RE[row * 2 + 1] = eb; RP[row * 2] = pa; RP[row * 2 + 1] = pb; RW[row * 2] = w1; RW[row * 2 + 1] = w2; }
        }
        __syncthreads();
    }
}

__device__ __forceinline__ void moe_prefix(Frame& F, int ncs) {
    LAS int* upre = (LAS int*)(F.lds + TPRE_OFF); LAS int* cpre = upre + 80;
    if (F.tid < 64) { const int c = (int)__hip_atomic_load(F.ctl + CW_CNT + 64 * F.tid, RLX_AGENT); int u = ((c + 383) / 384) * ncs, v = c;
#pragma unroll
        for (int o = 1; o < 64; o <<= 1) { const int y = __shfl_up(u, o), z = __shfl_up(v, o); if (F.lane >= o) { u += y; v += z; } }
        upre[F.tid + 1] = u; cpre[F.tid + 1] = v; if (F.tid == 0) { upre[0] = 0; cpre[0] = 0; } }
    __syncthreads();
}

__device__ __forceinline__ void p8_combine(Frame& F) {
    const LAS int* cpre = (const LAS int*)(F.lds + TPRE_OFF) + 80;
    const int* RE = (const int*)(F.ws + WS_ROUTE); const int* RP = RE + TF * 2; const bf16* Y = (const bf16*)(F.ws + WS_Y);
    for (int m = F.vcu * 8 + F.wave; m < TF; m += F.G * 8) {
        const int e0 = RE[m * 2], e1 = RE[m * 2 + 1], p0 = RP[m * 2], p1 = RP[m * 2 + 1];
        const size_t s0 = (size_t)(cpre[e0] + p0), s1 = (size_t)(cpre[e1] + p1);
        GAS f32x4* op = (GAS f32x4*)(F.out + (size_t)m * DM) + 2 * F.lane;
        const GAS v4u* y0 = (const GAS v4u*)(Y + s0 * DM) + F.lane; const GAS v4u* y1 = (const GAS v4u*)(Y + s1 * DM) + F.lane;
#pragma unroll
        for (int j = 0; j < 4; ++j) { f32x4 a = op[128 * j], b = op[128 * j + 1]; const v4u u0 = y0[64 * j], u1 = y1[64 * j];
            a.x += __uint_as_float(u0.x << 16) + __uint_as_float(u1.x << 16); a.y += __uint_as_float(u0.x & 0xffff0000u) + __uint_as_float(u1.x & 0xffff0000u);
            a.z += __uint_as_float(u0.y << 16) + __uint_as_float(u1.y << 16); a.w += __uint_as_float(u0.y & 0xffff0000u) + __uint_as_float(u1.y & 0xffff0000u);
            b.x += __uint_as_float(u0.z << 16) + __uint_as_float(u1.z << 16); b.y += __uint_as_float(u0.z & 0xffff0000u) + __uint_as_float(u1.z & 0xffff0000u);
            b.z += __uint_as_float(u0.w << 16) + __uint_as_float(u1.w << 16); b.w += __uint_as_float(u0.w & 0xffff0000u) + __uint_as_float(u1.w & 0xffff0000u);
            op[128 * j] = a; op[128 * j + 1] = b; }
    }
}

#define XB_TMO      128
#define XB_XCNT(j)  (256  + 64 * (j))
#define XB_XSUB(j)  (1280 + 64 * (j))
#define XB_XGEN(j)  (2304 + 64 * (j))
#define XB_TOP      3328
#define XB_TOPGEN   3392
#define XCD_BAR_WORDS 3456
#define XB_SPIN_CAP (1u << 18)

__device__ __forceinline__ unsigned xb_ld(unsigned* p)              { return __hip_atomic_load(p, __ATOMIC_RELAXED, __HIP_MEMORY_SCOPE_AGENT); }
__device__ __forceinline__ unsigned xb_add(unsigned* p, unsigned v) { return __hip_atomic_fetch_add(p, v, __ATOMIC_RELAXED, __HIP_MEMORY_SCOPE_AGENT); }
__device__ __forceinline__ unsigned xb_xcc_id() { return (unsigned)__builtin_amdgcn_s_getreg((3 << 11) | 20) & 0xFu; }
#define XB_SPIN(cond, bar) do { unsigned _sp = 0; while (cond) { __builtin_amdgcn_s_sleep(1); \
    if ((++_sp & 255u) == 0u) { if (xb_ld(&(bar)[XB_TMO])) break; if (_sp > XB_SPIN_CAP) { atomicAdd(&(bar)[XB_TMO], 1u); break; } } } } while (0)

struct XcdBarrier {
    unsigned* bar; unsigned x;
    volatile LAS unsigned* st;
};

__device__ __forceinline__ XcdBarrier xcd_barrier_post(unsigned* bar, volatile LAS unsigned* st) {
    XcdBarrier b; b.bar = bar; b.x = xb_xcc_id(); b.st = st;
    if (threadIdx.x == 0) (void)xb_add(&bar[XB_XCNT(b.x)], 1u);
    return b;
}
__device__ __forceinline__ void xcd_barrier_complete(unsigned* bar, unsigned x, unsigned& nloc, unsigned& nx) {
    const unsigned G = gridDim.x * gridDim.y * gridDim.z;
    unsigned sum, cnt, mine, sp = 0u;
    for (;;) {
        sum = 0u; cnt = 0u; mine = 0u;
#pragma unroll
        for (unsigned j = 0; j < 16; ++j) { const unsigned c = xb_ld(&bar[XB_XCNT(j)]); sum += c; cnt += (c > 0u) ? 1u : 0u; mine = (j == x) ? c : mine; }
        if (sum == G) break;
        __builtin_amdgcn_s_sleep(1);
        if ((++sp & 255u) == 0u) { if (xb_ld(&bar[XB_TMO])) break; if (sp > XB_SPIN_CAP) { atomicAdd(&bar[XB_TMO], 1u); break; } }
    }
    nloc = mine > 0u ? mine : 1u; nx = cnt > 0u ? cnt : 1u;
}

__device__ __forceinline__ void xcd_barrier(const XcdBarrier& b) {
    asm volatile("s_waitcnt vmcnt(0)" ::: "memory");
    __syncthreads();
    if (threadIdx.x == 0) {
        unsigned* bar = b.bar;
        __builtin_amdgcn_s_waitcnt(0);
        unsigned nloc = b.st[0], nx = b.st[1];
        if (nloc == 0u) { xcd_barrier_complete(bar, b.x, nloc, nx); b.st[0] = nloc; b.st[1] = nx; }
        const unsigned old = xb_add(&bar[XB_XSUB(b.x)], 1u);
        const unsigned gen = old / nloc;
        if (old + 1u == (gen + 1u) * nloc) {
            __builtin_amdgcn_fence(__ATOMIC_RELEASE, "agent");
            asm volatile("s_waitcnt vmcnt(0)" ::: "memory");
            const unsigned og = xb_add(&bar[XB_TOP], 1u);
            const unsigned tg = og / nx;
            if (og + 1u == (tg + 1u) * nx) xb_add(&bar[XB_TOPGEN], 1u);
            else XB_SPIN(xb_ld(&bar[XB_TOPGEN]) == tg, bar);
            __builtin_amdgcn_fence(__ATOMIC_ACQUIRE, "agent");
            xb_add(&bar[XB_XGEN(b.x)], 1u);
            asm volatile("s_waitcnt vmcnt(0)" ::: "memory");
        } else {
            XB_SPIN(xb_ld(&bar[XB_XGEN(b.x)]) == gen, bar);
            __builtin_amdgcn_fence(__ATOMIC_ACQUIRE, "agent");
            asm volatile("s_waitcnt vmcnt(0)" ::: "memory");
        }
    }
    __syncthreads();
}

struct Args { const float* in[18]; float* out; unsigned char* ws; int ph_lo, ph_hi; };
__global__ void __launch_bounds__(512, 2) fwd(Args args) {
    extern __shared__ __attribute__((aligned(16))) unsigned char lds[];
    Frame F;
    F.lds = (LAS unsigned char*)lds; F.ldsg = (char*)lds;
    F.MISC = (volatile LAS unsigned*)(F.lds + MISC_OFF);
    F.tid = threadIdx.x; F.lane = F.tid & 63; F.wave = __builtin_amdgcn_readfirstlane(F.tid >> 6);
    F.G = gridDim.x; { const int bx = blockIdx.x; F.vcu = (F.G % 8 == 0) ? (bx % 8) * (F.G / 8) + bx / 8 : bx; }
    F.ws = args.ws; F.ctl = (gu32*)(args.ws + WS_CTL); F.out = args.out;
    F.x = args.in[0]; F.meta = args.in[1]; F.g1 = args.in[2]; F.w_in = args.in[3]; F.b_f = args.in[4]; F.q_gain = args.in[5]; F.k_gain = args.in[6];
    F.fox_gain = args.in[7]; F.sb_gain = args.in[8]; F.w_out = args.in[9]; F.g2 = args.in[10]; F.w_coarse = args.in[11]; F.b_coarse = args.in[12];
    F.w_fine = args.in[13]; F.b_fine = args.in[14]; F.w1 = args.in[15]; F.w3 = args.in[16]; F.w2 = args.in[17];
    for (int u = F.tid; u < 32; u += 512) F.MISC[u] = 0u;
    __syncthreads();
    const int lo = args.ph_lo, hi = args.ph_hi;
    XcdBarrier bar; bar.bar = (unsigned*)(F.ctl + CW_BAR); bar.x = 0; bar.st = nullptr;
    if (hi - lo > 1) bar = xcd_barrier_post((unsigned*)(F.ctl + CW_BAR), F.MISC + 8);
#define IN(k) (lo <= (k) && (k) < hi)
#define SEAM(k) do { if (IN(k) && IN((k) + 1)) xcd_barrier(bar); } while (0)
    bf16* PROJ = (bf16*)(F.ws + WS_PROJ);


    if (IN(0)) { p0_prologue(F); if (REP_PHASE == 0) { __syncthreads(); p0_prologue(F); } SEAM(0); }

    if (IN(1)) {
        { const int bh = (int)blockIdx.x - (F.G - NB * NH); if (bh >= 0 && F.wave == 0) cum_scan(F, bh); }
        pg8::DenseOrder S; S.init(F.ws + WS_U1, F.ws + WS_WIN_T, MROWS, NPROJ, DM, F.G, (int)blockIdx.x);
        pg8::EpiProj E{PROJ, (float*)(F.ws + WS_SS)};
        pg8::gemm_phase<pg8::EpiProj, pg8::DenseOrder, false>(F.lds, DM, S, E, nullptr);
        if (REP_PHASE == 1) pg8::gemm_phase<pg8::EpiProj, pg8::DenseOrder, false>(F.lds, DM, S, E, nullptr);
        if (IN(1) && IN(3)) xcd_barrier(bar);
    }

    if (IN(3)) {
        att::Tensors T{PROJ, PROJ + PROJ_TS, PROJ + 2 * PROJ_TS, PROJ + 3 * PROJ_TS, PROJ + 4 * PROJ_TS, PROJ + 5 * PROJ_TS, PROJ + 6 * PROJ_TS,
                       (const float*)(F.ws + WS_SS), (const float*)(F.ws + WS_CUM), F.q_gain, F.k_gain, F.fox_gain, F.sb_gain, (bf16*)(F.ws + WS_MIX)};
        for (int rep = 0; rep < ((REP_PHASE == 3 || REP_PHASE == 31 || REP_PHASE == 32) ? 2 : 1); ++rep)
        for (int w = F.vcu; w < 256; w += F.G) { const int bh = w >> 3, s = w & 7;
            if (REP_PHASE != 32 || rep == 0) att::attn_wave<0>(F.ldsg + F.wave * 16384, T, bh >> 3, bh & 7, s * 256 + F.wave * 32);
            if (REP_PHASE != 31 || rep == 0) att::attn_wave<1>(F.ldsg + F.wave * 16384, T, bh >> 3, bh & 7, (7 - s) * 256 + F.wave * 32);
        }
        __syncthreads();
        SEAM(3);
    }
    if (IN(4)) {
        pg8::DenseOrder S; S.init(F.ws + WS_MIX, F.ws + WS_WOUT_T, TF, DM, DM, F.G, (int)blockIdx.x);
        pg8::EpiOut E{F.x, F.out};
        pg8::gemm_phase<pg8::EpiOut, pg8::DenseOrder, false>(F.lds, DM, S, E, nullptr);
        if (REP_PHASE == 4) pg8::gemm_phase<pg8::EpiOut, pg8::DenseOrder, false>(F.lds, DM, S, E, nullptr);
        SEAM(4);
    }
    if (IN(5)) { p5_router(F); SEAM(5); }

    if (IN(6)) {
        moe_prefix(F, 8);
        const LAS int* upre = (const LAS int*)(F.lds + TPRE_OFF);
        moe::Order S{F.G, F.vcu, 8, upre, upre + 80};
        LAS int* tab = (LAS int*)(F.lds + TAB_OFF); const int* TOK = (const int*)(F.ws + WS_TOK);
        for (int i = 0; i < 8; ++i) { int e, cs, mt, cnt, cbase; if (!S.decode(i, e, cs, mt, cnt, cbase)) break;
            if (F.tid < 384) { const int p = mt * 384 + F.tid; tab[i * 384 + F.tid] = p < cnt ? (TOK[(size_t)e * TOKLD + p] >> 1) : TF; } }
        __syncthreads();
        for (int rep = 0; rep < (REP_PHASE == 6 ? 2 : 1); ++rep)
        moe::phase<DM, true>(F.lds, S, tab, (const char*)(F.ws + WS_U2), F.w1, F.w3, (bf16*)(F.ws + WS_HID));
        SEAM(6);
    }
    if (IN(7)) {
        moe_prefix(F, 16);
        const LAS int* upre = (const LAS int*)(F.lds + TPRE_OFF);
        moe::Order S{F.G, F.vcu, 16, upre, upre + 80};
        LAS float* wtab = (LAS float*)(F.lds + TAB_OFF); const int* TOK = (const int*)(F.ws + WS_TOK); const float* RW = (const float*)(F.ws + WS_ROUTE) + TF * 4;
        for (int i = 0; i < 8; ++i) { int e, cs, mt, cnt, cbase; if (!S.decode(i, e, cs, mt, cnt, cbase)) break;
            if (F.tid < 384) { const int p = mt * 384 + F.tid; wtab[i * 384 + F.tid] = p < cnt ? RW[TOK[(size_t)e * TOKLD + p]] : 0.f; } }
        __syncthreads();
        for (int rep = 0; rep < (REP_PHASE == 7 ? 2 : 1); ++rep)
        moe::phase<DE, false>(F.lds, S, (const LAS int*)wtab, (const char*)(F.ws + WS_HID), F.w2, nullptr, (bf16*)(F.ws + WS_Y));
        SEAM(7);
    }
    if (IN(8)) { moe_prefix(F, 16); p8_combine(F); }
#undef IN
#undef SEAM
}

extern "C" void kernel_launch(void* const* d_in, const int* in_sizes, int n_in, void* d_out, int out_size, void* d_ws, size_t ws_size, hipStream_t stream) {
    static int grid = 0;
    if (grid == 0) {
        if (n_in != 18 || out_size != TF * DM || ws_size < WS_END) { fprintf(stderr, "kernel_launch: unexpected shapes (n_in %d, out %d, ws %zu); nothing launched\n", n_in, out_size, ws_size); grid = -1; return; }
        int dev = 0, cus = 0, per_cu = 0;
        if (hipGetDevice(&dev) != hipSuccess || hipDeviceGetAttribute(&cus, hipDeviceAttributeMultiprocessorCount, dev) != hipSuccess) { grid = -1; return; }
        if (hipFuncSetAttribute((const void*)fwd, hipFuncAttributeMaxDynamicSharedMemorySize, LDS_BYTES) != hipSuccess) { fprintf(stderr, "kernel_launch: hipFuncSetAttribute failed\n"); grid = -1; return; }
        if (hipOccupancyMaxActiveBlocksPerMultiprocessor(&per_cu, (const void*)fwd, 512, LDS_BYTES) != hipSuccess || per_cu < 1) fprintf(stderr, "kernel_launch: occupancy query reports %d\n", per_cu);
        (void)hipGetLastError();
        grid = cus > 0 ? cus : 256;
    }
    if (grid < 0) return;
    (void)hipMemsetAsync((char*)d_ws + WS_CTL, 0, CTL_ZERO_BYTES, stream);
    Args a{};
    for (int i = 0; i < 18; ++i) a.in[i] = (const float*)d_in[i];
    a.out = (float*)d_out; a.ws = (unsigned char*)d_ws;
    constexpr int NL = MK_N_LAUNCHES;
    for (int li = 0; li < NL; ++li) {
        a.ph_lo = (NL == 1) ? 0 : li; a.ph_hi = (NL == 1) ? NPHASE : li + 1;
        hipLaunchKernelGGL(fwd, dim3(grid), dim3(512), LDS_BYTES, stream, a);
    }
}
```

```cpp
#include <hip/hip_runtime.h>
#include <hip/hip_bf16.h>
#include <cstdio>
#include <cstdint>

#ifndef REP_PHASE
#define REP_PHASE -1
#endif
#ifndef MK_N_LAUNCHES
#define MK_N_LAUNCHES 1
#endif

constexpr int DM = 2048, NB = 4, SEQ = 2048, NMETA = 16, HD = 128, NH = 8;
constexpr int TF = NB * SEQ;
constexpr int ROW_META = TF;
constexpr int NKEYROWS = TF + NMETA;
constexpr int MROWS = 8448;
constexpr int NPROJ = 7168, LDW_IN = 7176;
constexpr int NE = 64, DE = 512;
constexpr int LPOS = SEQ + NMETA;
constexpr int CUMLD = 2112;
constexpr float EPS = 1e-6f;
constexpr float LOG2E = 1.4426950408889634f;
constexpr float QSCALE2 = 0.08838834764831845f * 1.4426950408889634f;
constexpr int NPHASE = 9;

constexpr size_t MiB = 1u << 20;
constexpr size_t WS_CTL = 0, CTL_ZERO_BYTES = 1 * MiB;
constexpr size_t WS_WIN_T = 2 * MiB;
constexpr size_t WS_WOUT_T = 30 * MiB;
constexpr size_t WS_U1 = 38 * MiB;
constexpr size_t WS_PROJ = 72 * MiB;
constexpr size_t PROJ_TS = (size_t)MROWS * 1024;
constexpr size_t WS_F = 188 * MiB;
constexpr size_t WS_CUM = 189 * MiB;
constexpr size_t WS_SS = 190 * MiB;
constexpr size_t WS_RK = 194 * MiB;
constexpr size_t WS_MT = 195 * MiB;
constexpr size_t WS_MIX = 196 * MiB;
constexpr size_t WS_U2 = 228 * MiB;
constexpr size_t WS_ROUTE = 262 * MiB;
constexpr size_t WS_TOK = 263 * MiB;
constexpr int TOKLD = 16512;
constexpr size_t WS_RB = 268 * MiB;
constexpr int NASSIGN = TF * 2;
constexpr size_t WS_HID = 272 * MiB;
constexpr size_t WS_Y = 292 * MiB;
constexpr size_t WS_END = 360 * MiB;
constexpr int CW_TMO = 0;
constexpr int CW_CNT = 1024;
constexpr int CW_BAR = 8192;

constexpr int RING_BYTES = 139264;
constexpr int TAB_OFF = RING_BYTES, TAB_BYTES = 8 * 384 * 4;
constexpr int TPRE_OFF = TAB_OFF + TAB_BYTES;
constexpr int MISC_OFF = TPRE_OFF + 1024;
constexpr int LDS_BYTES = MISC_OFF + 128;

#define GAS __attribute__((address_space(1)))
#define LAS __attribute__((address_space(3)))
typedef unsigned short bf16;
typedef unsigned v4u __attribute__((ext_vector_type(4)));
typedef unsigned v2u __attribute__((ext_vector_type(2)));
typedef float f32x4 __attribute__((ext_vector_type(4)));
typedef float f32x2 __attribute__((ext_vector_type(2)));
typedef float f32x16 __attribute__((ext_vector_type(16)));
typedef short bf16x8 __attribute__((ext_vector_type(8)));
typedef short s16x4 __attribute__((ext_vector_type(4)));
typedef GAS unsigned gu32;
#define RLX_AGENT __ATOMIC_RELAXED, __HIP_MEMORY_SCOPE_AGENT
#define LDS_WAIT() asm volatile("s_waitcnt lgkmcnt(0)" ::: "memory")
#define VM_WAIT() asm volatile("s_waitcnt vmcnt(0)" ::: "memory")
__device__ __forceinline__ unsigned cvtpk(float lo, float hi) { unsigned r; asm volatile("v_cvt_pk_bf16_f32 %0, %1, %2" : "=v"(r) : "v"(lo), "v"(hi)); return r; }
__device__ __forceinline__ float bf2f(unsigned short h) { return __uint_as_float(((unsigned)h) << 16); }
__device__ __forceinline__ float wave_sum(float v) {
#pragma unroll
    for (int o = 1; o < 64; o <<= 1) v += __shfl_xor(v, o);
    return v;
}
__device__ __forceinline__ int opaque_tid() { int t = threadIdx.x; asm volatile("" : "+v"(t)); return t; }
__device__ __forceinline__ float fast_exp2(float x) { return __builtin_amdgcn_exp2f(x); }
__device__ __forceinline__ float fast_log2(float x) { return __builtin_amdgcn_logf(x); }
__device__ __forceinline__ float fast_rcp(float x) { return __builtin_amdgcn_rcpf(x); }

namespace pg8 {
#define PG8_LAS __attribute__((address_space(3)))
typedef unsigned short bf16_t;
typedef unsigned u32x4 __attribute__((ext_vector_type(4)));
constexpr int BM = 256, BK = 64, HALF = 128, HTB = HALF * BK * 2, STAGE_BYTES = 8 * HTB, NXCD = 8, WGM = 8;
__host__ __device__ __forceinline__ int lds_byte(int r, int c) { const int st = (r >> 4) * 2 + (c >> 5), rr = r & 15, cc = c & 31, ob = rr * 64 + cc * 2; return st * 1024 + (ob ^ (((ob >> 9) & 1) << 5)); }
__host__ __device__ __forceinline__ void stage_rc(int b, int& R, int& C) { const int st = b / 1024, sb = b % 1024, swz = sb ^ (((sb >> 9) & 1) << 5); R = (st >> 1) * 16 + swz / 64; C = (st & 1) * 32 + (swz % 64) / 2; }
__host__ __device__ __forceinline__ int perm32(int rho) { const int n = rho >> 4, i = rho & 15; return 8 * (i >> 2) + 4 * n + (i & 3); }

struct Unit { int pm, pn, li; const char* A; const char* B; };

struct DenseOrder {
    int nM, nN, nwg, G, c; const char* A; const char* B; size_t tstep;
    __device__ __forceinline__ void init(const void* A_, const void* B_, int M, int N, int K, int G_, int c_) { nM = M / BM; nN = N / BM; nwg = nM * nN; G = G_; c = c_; A = (const char*)A_; B = (const char*)B_; tstep = (size_t)BM * K * 2; }
    __device__ __forceinline__ bool next(int i, Unit& u) const {
        const long L = (long)i * G + c; if (L >= nwg) return false;
        int wgid = (int)L; { const int q = nwg / NXCD, r = nwg % NXCD, xcd = wgid % NXCD, off = wgid / NXCD; wgid = (xcd < r ? xcd * (q + 1) : r * (q + 1) + (xcd - r) * q) + off; }
        const int nig = WGM * nN, gid = wgid / nig, fm = gid * WGM, gsz = (nM - fm) < WGM ? (nM - fm) : WGM;
        u.pm = fm + ((wgid % nig) % gsz); u.pn = (wgid % nig) / gsz; u.li = 0;
        u.A = A + (size_t)u.pm * tstep; u.B = B + (size_t)u.pn * tstep; return true;
    }
};

template <class Epi, class Sched, bool GATHER>
__device__ __forceinline__ void gemm_phase(PG8_LAS unsigned char* lds, const int K, const Sched& S, const Epi& E, const PG8_LAS int* tab) {
    const int tid = opaque_tid(), wid = __builtin_amdgcn_readfirstlane(tid >> 6), lane = tid & 63, wr = wid >> 2, wc = wid & 3, fr = lane & 15, fq = lane >> 4;
    const int nt = K / BK;
    unsigned voffA[2], voffB[2]; int RA[2], CA[2];
#pragma unroll
    for (int i = 0; i < 2; ++i) { int R, C; stage_rc(tid * 16 + i * 8192, R, C); const int Rb = Epi::PERM ? ((R & ~31) + perm32(R & 31)) : R;
        voffA[i] = (unsigned)(R * K + C) * 2u; voffB[i] = (unsigned)(Rb * K + C) * 2u; RA[i] = R; CA[i] = C; }
    const size_t kstep = (size_t)(BK * 2);
    const size_t hstep = (size_t)HALF * K * 2;
    const unsigned ldsw = (unsigned)wid * 1024u;
    const int aoff = lds_byte(wr * 64 + fr, fq * 8), boff = lds_byte(wc * 32 + fr, fq * 8);
    unsigned gA[2][2], gAn[2][2];
#define PG8_SA(b, h) (((b) * 2 + (h)) * HTB)
#define PG8_SB(b, h) ((4 + (b) * 2 + (h)) * HTB)
#define PG8_GL(gptr, ldsoff) __builtin_amdgcn_global_load_lds((const unsigned*)(gptr), (PG8_LAS unsigned*)(lds + (ldsoff)), 16, 0, 0)
#define PG8_STAGE_B(bufoff, gbase) do { _Pragma("unroll") for (int _i = 0; _i < 2; ++_i) PG8_GL((const char*)(gbase) + voffB[_i], (bufoff) + ldsw + _i * 8192); } while (0)
#define PG8_STAGE_A(bufoff, gbase, h, NX) do { _Pragma("unroll") for (int _i = 0; _i < 2; ++_i) { \
        if constexpr (GATHER) { const unsigned _vo = (NX) ? gAn[h][_i] : gA[h][_i]; PG8_GL((const char*)(gbase) + _vo, (bufoff) + ldsw + _i * 8192); } \
        else { PG8_GL((const char*)(gbase) + (size_t)(h) * hstep + voffA[_i], (bufoff) + ldsw + _i * 8192); } } } while (0)
#define PG8_GIDX(dst, li) do { if constexpr (GATHER) { _Pragma("unroll") for (int _h = 0; _h < 2; ++_h) _Pragma("unroll") for (int _i = 0; _i < 2; ++_i) \
        dst[_h][_i] = ((unsigned)tab[(li) * 256 + _h * 128 + RA[_i]] * (unsigned)K + (unsigned)CA[_i]) * 2u; } } while (0)
#define PG8_LDA(dst, b, h) do { _Pragma("unroll") for (int m = 0; m < 4; ++m) _Pragma("unroll") for (int k = 0; k < 2; ++k) dst[m][k] = *(const PG8_LAS bf16x8*)(lds + PG8_SA(b, h) + aoff + m * 2048 + k * 1024); } while (0)
#define PG8_LDB(dst, b, h) do { _Pragma("unroll") for (int n = 0; n < 2; ++n) _Pragma("unroll") for (int k = 0; k < 2; ++k) dst[n][k] = *(const PG8_LAS bf16x8*)(lds + PG8_SB(b, h) + boff + n * 2048 + k * 1024); } while (0)
#define PG8_MMA(ai, bj, At, Bt) do { __builtin_amdgcn_s_setprio(1); _Pragma("unroll") for (int m = 0; m < 4; ++m) _Pragma("unroll") for (int n = 0; n < 2; ++n) _Pragma("unroll") for (int k = 0; k < 2; ++k) \
        acc[ai][bj][m][n] = __builtin_amdgcn_mfma_f32_16x16x32_bf16(Bt[n][k], At[m][k], acc[ai][bj][m][n], 0, 0, 0); __builtin_amdgcn_s_setprio(0); } while (0)
#define PG8_WAIT_V(n) asm volatile("s_waitcnt vmcnt(" #n ")" ::: "memory")
#define PG8_WAIT_L(n) asm volatile("s_waitcnt lgkmcnt(" #n ")" ::: "memory")
#define PG8_BAR __builtin_amdgcn_s_barrier()
#define PG8_SCHED __builtin_amdgcn_sched_barrier(0)
    Unit cur, nxt; int ui = 0;
    if (!S.next(0, cur)) return;
    f32x4 acc[2][2][4][2];
#pragma unroll
    for (int a = 0; a < 2; ++a)
#pragma unroll
        for (int b = 0; b < 2; ++b)
#pragma unroll
            for (int m = 0; m < 4; ++m)
#pragma unroll
                for (int n = 0; n < 2; ++n) acc[a][b][m][n] = (f32x4){0.f, 0.f, 0.f, 0.f};
    bf16x8 At[4][2], B0[2][2], B1[2][2];
    const char* cA = cur.A; const char* cB = cur.B;
    PG8_GIDX(gA, cur.li);
    PG8_STAGE_B(PG8_SB(0, 0), cB); PG8_STAGE_B(PG8_SB(0, 1), cB + hstep); PG8_STAGE_A(PG8_SA(0, 0), cA, 0, false); PG8_STAGE_A(PG8_SA(0, 1), cA, 1, false);
    if (wr == 1) PG8_BAR;
    PG8_WAIT_V(2); PG8_BAR;
    PG8_STAGE_B(PG8_SB(1, 0), cB + kstep); PG8_STAGE_A(PG8_SA(1, 0), cA + kstep, 0, false); PG8_STAGE_B(PG8_SB(1, 1), cB + hstep + kstep);
    PG8_WAIT_V(6); PG8_BAR;
    for (;;) {
        const bool has_next = S.next(ui + 1, nxt);
        const char* nA = has_next ? nxt.A : cA; const char* nB = has_next ? nxt.B : cB;
        if constexpr (GATHER) { if (has_next) { PG8_GIDX(gAn, nxt.li); } else {
#pragma unroll
            for (int _h = 0; _h < 2; ++_h)
#pragma unroll
                for (int _i = 0; _i < 2; ++_i) gAn[_h][_i] = gA[_h][_i]; } }
        for (int t = 0; t < nt; t += 2) {
            const bool last = (t == nt - 2);
            const char* a1 = cA + (size_t)(t + 1) * kstep;
            const char* a2 = last ? nA : cA + (size_t)(t + 2) * kstep; const char* b2 = last ? nB : cB + (size_t)(t + 2) * kstep;
            const char* a3 = a2 + kstep; const char* b3 = b2 + kstep;
            PG8_LDB(B0, 0, 0); PG8_LDB(B1, 0, 1); PG8_SCHED; PG8_LDA(At, 0, 0); PG8_STAGE_A(PG8_SA(1, 1), a1, 1, false);
            PG8_WAIT_V(8); PG8_WAIT_L(0); PG8_BAR; PG8_MMA(0, 0, At, B0); PG8_MMA(0, 1, At, B1); PG8_BAR; PG8_SCHED;
            PG8_LDA(At, 0, 1); PG8_STAGE_B(PG8_SB(0, 0), b2); PG8_STAGE_B(PG8_SB(0, 1), b2 + hstep); PG8_STAGE_A(PG8_SA(0, 0), a2, 0, last);
            PG8_WAIT_V(8); PG8_WAIT_L(0); PG8_BAR; PG8_MMA(1, 0, At, B0); PG8_MMA(1, 1, At, B1); PG8_BAR; PG8_SCHED;
            PG8_LDB(B0, 1, 0); PG8_LDB(B1, 1, 1); PG8_SCHED; PG8_LDA(At, 1, 0); PG8_STAGE_A(PG8_SA(0, 1), a2, 1, last);
            PG8_WAIT_V(8); PG8_WAIT_L(0); PG8_BAR; PG8_MMA(0, 0, At, B0); PG8_MMA(0, 1, At, B1); PG8_BAR; PG8_SCHED;
            PG8_LDA(At, 1, 1); PG8_STAGE_B(PG8_SB(1, 0), b3); PG8_STAGE_B(PG8_SB(1, 1), b3 + hstep); PG8_STAGE_A(PG8_SA(1, 0), a3, 0, last);
            PG8_WAIT_V(8); PG8_WAIT_L(0); PG8_BAR; PG8_MMA(1, 0, At, B0); PG8_MMA(1, 1, At, B1); PG8_BAR; PG8_SCHED;
        }
        if (wr == 0) PG8_BAR;
        E(acc, cur, wr, wc, fr, fq);
        if (!has_next) break;
#pragma unroll
        for (int a = 0; a < 2; ++a)
#pragma unroll
            for (int b = 0; b < 2; ++b)
#pragma unroll
                for (int m = 0; m < 4; ++m)
#pragma unroll
                    for (int n = 0; n < 2; ++n) acc[a][b][m][n] = (f32x4){0.f, 0.f, 0.f, 0.f};
        cur = nxt; cA = nA; cB = nB; ++ui;
        if constexpr (GATHER) {
#pragma unroll
            for (int _h = 0; _h < 2; ++_h)
#pragma unroll
                for (int _i = 0; _i < 2; ++_i) gA[_h][_i] = gAn[_h][_i]; }
        if (wr == 1) PG8_BAR;
    }
    PG8_WAIT_V(0);
    PG8_BAR;
#undef PG8_SA
#undef PG8_SB
#undef PG8_GL
#undef PG8_STAGE_A
#undef PG8_STAGE_B
#undef PG8_GIDX
#undef PG8_LDA
#undef PG8_LDB
#undef PG8_MMA
#undef PG8_WAIT_V
#undef PG8_WAIT_L
#undef PG8_BAR
#undef PG8_SCHED
}

struct EpiProj {
    static constexpr bool PERM = true;
    bf16_t* P; float* SS;
    __device__ __forceinline__ void operator()(const f32x4 (&acc)[2][2][4][2], const Unit& u, int wr, int wc, int fr, int fq) const {
        const int t = u.pn >> 2, colt = (u.pn & 3) * BM;
        bf16_t* base = P + (size_t)t * PROJ_TS;
        const int row0 = u.pm * BM + wr * 64 + fr, col0 = colt + wc * 32 + 8 * fq;
        if (t <= 1) {
#pragma unroll
            for (int ai = 0; ai < 2; ++ai)
#pragma unroll
                for (int m = 0; m < 4; ++m)
#pragma unroll
                    for (int bj = 0; bj < 2; ++bj) {
                        const f32x4 a = acc[ai][bj][m][0], b = acc[ai][bj][m][1];
                        float s = (a[0] * a[0] + a[1] * a[1]) + (a[2] * a[2] + a[3] * a[3]) + (b[0] * b[0] + b[1] * b[1]) + (b[2] * b[2] + b[3] * b[3]);
                        s += __shfl_xor(s, 16); s += __shfl_xor(s, 32);
                        if (fq == 0) SS[(((size_t)t * MROWS + (row0 + ai * HALF + m * 16)) * 8 + ((u.pn & 3) * 2 + bj)) * 4 + wc] = s;
                    }
        }
#pragma unroll
        for (int ai = 0; ai < 2; ++ai)
#pragma unroll
            for (int m = 0; m < 4; ++m) { bf16_t* rowp = base + (size_t)(row0 + ai * HALF + m * 16) * 1024 + col0;
#pragma unroll
                for (int bj = 0; bj < 2; ++bj) { f32x4 v0 = acc[ai][bj][m][0], v1 = acc[ai][bj][m][1];
                    if (t == 3) {
#pragma unroll
                        for (int j = 0; j < 4; ++j) { v0[j] = fast_rcp(1.f + fast_exp2(-v0[j] * LOG2E)); v1[j] = fast_rcp(1.f + fast_exp2(-v1[j] * LOG2E)); } }
                    if (t == 4) { v0 = v0 * QSCALE2; v1 = v1 * QSCALE2; }
                    u32x4 w; w.x = cvtpk(v0[0], v0[1]); w.y = cvtpk(v0[2], v0[3]); w.z = cvtpk(v1[0], v1[1]); w.w = cvtpk(v1[2], v1[3]);
                    *(u32x4*)(rowp + bj * HALF) = w; } }
    }
};
struct EpiOut {
    static constexpr bool PERM = false;
    const float* X; float* O;
    __device__ __forceinline__ void operator()(const f32x4 (&acc)[2][2][4][2], const Unit& u, int wr, int wc, int fr, int fq) const {
        const int row0 = u.pm * BM + wr * 64 + fr, col0 = u.pn * BM + wc * 32 + 4 * fq;
#pragma unroll
        for (int ai = 0; ai < 2; ++ai)
#pragma unroll
            for (int m = 0; m < 4; ++m) { const size_t off = (size_t)(row0 + ai * HALF + m * 16) * DM + col0;
#pragma unroll
                for (int bj = 0; bj < 2; ++bj)
#pragma unroll
                    for (int n = 0; n < 2; ++n) { const f32x4 xv = *(const f32x4*)(X + off + bj * HALF + n * 16); *(f32x4*)(O + off + bj * HALF + n * 16) = xv + acc[ai][bj][m][n]; } }
    }
};
}

namespace moe {
constexpr int MT = 384, BKT = 64, A_BYTES = MT * BKT * 2, B_PITCH = 320, B_BYTES = BKT * B_PITCH;
constexpr int OFF_A = 0, OFF_B = 2 * A_BYTES, STAGE_END = 2 * A_BYTES + 2 * B_BYTES;
typedef short v4i16_t __attribute__((ext_vector_type(4)));
__device__ __forceinline__ void glds16(const void* gsrc, unsigned lds_dst) { unsigned keep;
    asm volatile("s_mov_b32 %0, m0\n\ts_mov_b32 m0, %2\n\ts_nop 0\n\tglobal_load_lds_dwordx4 %1, off\n\ts_mov_b32 m0, %0" : "=&s"(keep) : "v"(gsrc), "s"(lds_dst) : "memory"); }
__device__ __forceinline__ s16x4 vtr(const LAS unsigned char* p) { return __builtin_bit_cast(s16x4, __builtin_amdgcn_ds_read_tr16_b64_v4i16((LAS v4i16_t*)p)); }

struct Order {
    int G, c, ncs; const LAS int* upre; const LAS int* cpre;
    __device__ __forceinline__ bool decode(int i, int& e, int& cs, int& mt, int& cnt, int& cbase) const {
        const int L = i * G + c; if (L >= __builtin_amdgcn_readfirstlane(upre[NE])) return false;
        int lo = 0, hi = NE;
        while (hi - lo > 1) { const int mid = (lo + hi) >> 1; const int v = __builtin_amdgcn_readfirstlane(upre[mid]); if (v <= L) lo = mid; else hi = mid; }
        e = lo; const int u0 = __builtin_amdgcn_readfirstlane(upre[e]), u1 = __builtin_amdgcn_readfirstlane(upre[e + 1]), ntm = (u1 - u0) / ncs, r = L - u0;
        cs = r / ntm; mt = r - cs * ntm; cbase = __builtin_amdgcn_readfirstlane(cpre[e]); cnt = __builtin_amdgcn_readfirstlane(cpre[e + 1]) - cbase; return true;
    }
};

template <int KDIM, bool G1, bool WW>
__device__ __forceinline__ void role_loop(LAS unsigned char* lds, const Order& S, const LAS int* tab, const char* Abase, const float* Wa, const float* Wb, bf16* Out) {
    constexpr int NTK = KDIM / BKT; constexpr int LDB = G1 ? DE : DM;
    const int tid = opaque_tid(), wid = __builtin_amdgcn_readfirstlane(tid >> 6), lane = tid & 63, r32 = lane & 31, hi = lane >> 5, wr = wid >> 1, wc = wid & 1;
    int e, cs, mt, cnt, cbase; if (!S.decode(0, e, cs, mt, cnt, cbase)) return;
    const int wv = wid - 4, tl2 = (wv & 1) * 64 + lane, bk = tl2 >> 4, bc = (wv >> 1) * 64 + (tl2 & 15) * 4;
    const unsigned boffl = (unsigned)(bk * LDB + (tl2 & 15) * 4) * 4u;
    const unsigned bwr = (unsigned)(bk * B_PITCH + bc * 2);
    const unsigned trbv = (unsigned)(uintptr_t)(lds + OFF_B + (8 * hi + ((lane & 15) >> 2)) * B_PITCH + (16 * ((lane >> 4) & 1) + 4 * (lane & 3)) * 2 + wc * 64);
    const unsigned ldsA = (unsigned)(uintptr_t)(lds + OFF_A) + (unsigned)(wid & 3) * 1024u;
    const LAS unsigned char* xa[4];
#pragma unroll
    for (int ks = 0; ks < 4; ++ks) xa[ks] = lds + OFF_A + (32 * wr + r32) * 128 + (((2 * ks + hi) ^ (r32 & 7)) * 16);
#define MOE_BBASE(e_, cs_) ((G1 ? ((wv >> 1) ? Wb : Wa) + (size_t)(e_) * DM * DE + 64 * (cs_) : Wa + (size_t)(e_) * DE * DM + 128 * (cs_) + 64 * (wv >> 1)))
#define MOE_AOFF(dst, ui_, cbase_, mt_) do { if constexpr (!WW) { _Pragma("unroll") for (int q = 0; q < 12; ++q) { const int row = 8 * (4 * q + (wid & 3)) + (lane >> 3); \
        const int arow = G1 ? tab[(ui_) * MT + row] : (cbase_) + MT * (mt_) + row; dst[q] = (unsigned)arow * (unsigned)(KDIM * 2) + (unsigned)(((lane & 7) ^ (row & 7)) * 16); } } } while (0)
    unsigned aoff[12], aoffn[12];
    MOE_AOFF(aoff, 0, cbase, mt);
    const float* bbase = MOE_BBASE(e, cs); const float* bbasen = bbase;
    f32x4 R0[8], R1[8];
    bool has_next = false;
#define MOE_DMA_A(tt, buf) do { if constexpr (!WW) { const bool nx_ = (tt) >= NTK; const int t_ = nx_ ? (has_next ? (tt) - NTK : NTK - 1) : (tt); _Pragma("unroll") for (int q = 0; q < 12; ++q) \
        glds16(Abase + ((nx_ && has_next) ? aoffn[q] : aoff[q]) + (size_t)t_ * (BKT * 2), (unsigned)__builtin_amdgcn_readfirstlane((int)(ldsA + (buf) * A_BYTES + q * 4096))); } } while (0)
#define MOE_LDB(R, tt) do { if constexpr (WW) { const bool nx_ = (tt) >= NTK; const int t_ = nx_ ? (has_next ? (tt) - NTK : NTK - 1) : (tt); const float* bb_ = (nx_ && has_next) ? bbasen : bbase; \
        _Pragma("unroll") for (int i = 0; i < 8; ++i) R[i] = __builtin_nontemporal_load((const f32x4*)((const char*)(bb_ + (size_t)(t_ * BKT + 8 * i) * LDB) + boffl)); } asm volatile("" ::: "memory"); __builtin_amdgcn_sched_barrier(0); } while (0)
#define MOE_WRB(R, buf) do { if constexpr (WW) { asm volatile("s_waitcnt vmcnt(8)" ::: "memory"); _Pragma("unroll") for (int i = 0; i < 8; ++i) *(LAS v2u*)(lds + OFF_B + (buf) * B_BYTES + bwr + i * 8 * B_PITCH) = (v2u){cvtpk(R[i].x, R[i].y), cvtpk(R[i].z, R[i].w)}; } } while (0)
#define MOE_TR4(W0, W1, W2, W3, off) asm volatile("ds_read_b64_tr_b16 %0, %4 offset:%5\n\tds_read_b64_tr_b16 %1, %4 offset:%6\n\tds_read_b64_tr_b16 %2, %4 offset:%7\n\tds_read_b64_tr_b16 %3, %4 offset:%8" \
        : "=&v"(W0), "=&v"(W1), "=&v"(W2), "=&v"(W3) : "v"(trbv), "i"(off), "i"((off) + 4 * B_PITCH), "i"((off) + 128), "i"((off) + 4 * B_PITCH + 128) : "memory")
#define MOE_COMPUTE(buf) do { _Pragma("unroll") for (int ks = 0; ks < 4; ++ks) { \
        s16x4 l0_, h0_, l1_, h1_; bf16x8 xf[3]; \
        MOE_TR4(l0_, h0_, l1_, h1_, (buf) * B_BYTES + ks * 16 * B_PITCH); \
        _Pragma("unroll") for (int j = 0; j < 3; ++j) xf[j] = *(const LAS bf16x8*)(xa[ks] + (buf) * A_BYTES + j * 16384); \
        asm volatile("s_waitcnt lgkmcnt(0)" ::: "memory"); __builtin_amdgcn_sched_barrier(0); \
        const bf16x8 wf0 = (bf16x8){l0_[0], l0_[1], l0_[2], l0_[3], h0_[0], h0_[1], h0_[2], h0_[3]}, wf1 = (bf16x8){l1_[0], l1_[1], l1_[2], l1_[3], h1_[0], h1_[1], h1_[2], h1_[3]}; \
        _Pragma("unroll") for (int j = 0; j < 3; ++j) { acc[j][0] = __builtin_amdgcn_mfma_f32_32x32x16_bf16(wf0, xf[j], acc[j][0], 0, 0, 0); acc[j][1] = __builtin_amdgcn_mfma_f32_32x32x16_bf16(wf1, xf[j], acc[j][1], 0, 0, 0); } } } while (0)
#define MOE_ENDT() do { if constexpr (!WW) asm volatile("s_waitcnt vmcnt(0)" ::: "memory"); LDS_WAIT(); __builtin_amdgcn_s_barrier(); } while (0)
#define MOE_STEP(t, buf, RN) do { MOE_DMA_A((t) + 1, 1 - (buf)); MOE_COMPUTE(buf); MOE_WRB(RN, 1 - (buf)); MOE_LDB(RN, (t) + 3); MOE_ENDT(); } while (0)
    MOE_LDB(R0, 0); MOE_LDB(R1, 1); MOE_DMA_A(0, 0);
    MOE_WRB(R0, 0); MOE_LDB(R0, 2);
    MOE_ENDT();
    for (int ui = 0;; ++ui) {
        int en, csn, mtn, cntn, cbasen; has_next = S.decode(ui + 1, en, csn, mtn, cntn, cbasen);
        if (has_next) { MOE_AOFF(aoffn, ui + 1, cbasen, mtn); bbasen = MOE_BBASE(en, csn); }
        const int rows_valid = cnt - MT * mt;
        f32x16 acc[3][2];
#pragma unroll
        for (int j = 0; j < 3; ++j) { acc[j][0] = f32x16{}; acc[j][1] = f32x16{}; }
        for (int t = 0; t < NTK; t += 2) { MOE_STEP(t, 0, R1); MOE_STEP(t + 1, 1, R0); }
#pragma unroll
        for (int j = 0; j < 3; ++j) { const int row = 32 * (wr + 4 * j) + r32;
            if (row < rows_valid) { const size_t orow = (size_t)(cbase + MT * mt + row);
                if (G1) { bf16* op = Out + orow * DE + 64 * cs + 32 * wc + 4 * hi;
#pragma unroll
                    for (int g = 0; g < 4; ++g) { float h4[4];
#pragma unroll
                        for (int i2 = 0; i2 < 4; ++i2) { const float a = acc[j][0][4 * g + i2], b = acc[j][1][4 * g + i2]; h4[i2] = a * fast_rcp(1.f + fast_exp2(-a * LOG2E)) * b; }
                        *(v2u*)(op + 8 * g) = (v2u){cvtpk(h4[0], h4[1]), cvtpk(h4[2], h4[3])}; } }
                else { const float w = ((const LAS float*)tab)[ui * MT + row]; bf16* op = Out + orow * DM + 128 * cs + 32 * wc + 4 * hi;
#pragma unroll
                    for (int nbi = 0; nbi < 2; ++nbi)
#pragma unroll
                        for (int g = 0; g < 4; ++g) *(v2u*)(op + 64 * nbi + 8 * g) = (v2u){cvtpk(acc[j][nbi][4 * g] * w, acc[j][nbi][4 * g + 1] * w), cvtpk(acc[j][nbi][4 * g + 2] * w, acc[j][nbi][4 * g + 3] * w)}; } } }
        if (!has_next) break;
        e = en; cs = csn; mt = mtn; cnt = cntn; cbase = cbasen; bbase = bbasen;
        if constexpr (!WW) {
#pragma unroll
            for (int q = 0; q < 12; ++q) aoff[q] = aoffn[q]; }
    }
    asm volatile("s_waitcnt vmcnt(0)" ::: "memory");
#undef MOE_BBASE
#undef MOE_AOFF
#undef MOE_DMA_A
#undef MOE_LDB
#undef MOE_WRB
#undef MOE_TR4
#undef MOE_COMPUTE
#undef MOE_ENDT
#undef MOE_STEP
}

template <int KDIM, bool G1>
__device__ __forceinline__ void phase(LAS unsigned char* lds, const Order& S, const LAS int* tab, const char* Abase, const float* Wa, const float* Wb, bf16* Out) {
    __syncthreads();
    if (__builtin_amdgcn_readfirstlane((int)(threadIdx.x >> 6)) >= 4) role_loop<KDIM, G1, true>(lds, S, tab, Abase, Wa, Wb, Out);
    else role_loop<KDIM, G1, false>(lds, S, tab, Abase, Wa, Wb, Out);
    __syncthreads();
}
}

namespace att {
#define KSWZ(row, colB) ((row) * 256 + ((colB) ^ (((row) & 7) << 4)))
#define SBAR() __builtin_amdgcn_sched_barrier(0)
constexpr int SHM_V = 16384, SHM_K = 16384;
constexpr int KS_OFF = 32768, WSF_OFF = 33792, WSF_FLOATS = 1152;
__device__ __forceinline__ int v_st(int k, int c) { const int kk = (k & ~0xC) | ((k & 4) << 1) | ((k & 8) >> 1); return ((kk >> 3) * 4 + (c >> 5)) * 512 + ((kk & 7) * 32 + (c & 31)) * 2; }
__device__ __forceinline__ int v_rd_base(int lane) { return ((lane & 3) << 3) | (((lane >> 2) & 3) << 6) | (((lane >> 4) & 1) << 5) | (((lane >> 5) & 1) << 8); }
constexpr int v_rd_off(int d0, int ks, int half) { return d0 * 512 + ks * 4096 + half * 2048; }
__device__ __forceinline__ int crow(int r, int hi) { return (r & 3) + 8 * (r >> 2) + 4 * hi; }

__device__ __forceinline__ void qkt(f32x16& p0, f32x16& p1, const char* K_lds, int r32, int hi, const bf16x8* qr) {
    p0 = f32x16{}; p1 = f32x16{};
    const char* kb[4];
#pragma unroll
    for (int dd = 0; dd < 4; ++dd) kb[dd] = K_lds + KSWZ(r32, (dd * 16 + hi * 8) * 2);
#pragma unroll
    for (int d0 = 0; d0 < 8; ++d0) { const char* a = kb[d0 & 3] + (d0 >> 2) * 128;
        bf16x8 b0 = *reinterpret_cast<const bf16x8*>(a);
        bf16x8 b1 = *reinterpret_cast<const bf16x8*>(a + 32 * 256);
        p0 = __builtin_amdgcn_mfma_f32_32x32x16_bf16(b0, qr[d0], p0, 0, 0, 0);
        p1 = __builtin_amdgcn_mfma_f32_32x32x16_bf16(b1, qr[d0], p1, 0, 0, 0); }
}
__device__ __forceinline__ void pv_tile(f32x16* o, int vb0, bf16x8 pa0, bf16x8 pa1, bf16x8 pa2, bf16x8 pa3) {
#define TRRD(dst, off) asm volatile("ds_read_b64_tr_b16 %0, %1 offset:%2" : "=&v"(dst) : "v"(vb0), "i"(off) : "memory")
#define PV_D0(d0) do { s16x4 l0, l1, l2, l3, h0, h1, h2, h3; constexpr int b_ = v_rd_off(d0, 0, 0); \
        TRRD(l0, b_); TRRD(h0, b_ + 2048); TRRD(l1, b_ + 4096); TRRD(h1, b_ + 6144); TRRD(l2, b_ + 8192); TRRD(h2, b_ + 10240); TRRD(l3, b_ + 12288); TRRD(h3, b_ + 14336); \
        asm volatile("s_waitcnt lgkmcnt(0)" ::: "memory"); SBAR(); \
        o[d0] = __builtin_amdgcn_mfma_f32_32x32x16_bf16(pa0, (bf16x8){l0[0], l0[1], l0[2], l0[3], h0[0], h0[1], h0[2], h0[3]}, o[d0], 0, 0, 0); \
        o[d0] = __builtin_amdgcn_mfma_f32_32x32x16_bf16(pa1, (bf16x8){l1[0], l1[1], l1[2], l1[3], h1[0], h1[1], h1[2], h1[3]}, o[d0], 0, 0, 0); \
        o[d0] = __builtin_amdgcn_mfma_f32_32x32x16_bf16(pa2, (bf16x8){l2[0], l2[1], l2[2], l2[3], h2[0], h2[1], h2[2], h2[3]}, o[d0], 0, 0, 0); \
        o[d0] = __builtin_amdgcn_mfma_f32_32x32x16_bf16(pa3, (bf16x8){l3[0], l3[1], l3[2], l3[3], h3[0], h3[1], h3[2], h3[3]}, o[d0], 0, 0, 0); } while (0)
    PV_D0(0); PV_D0(1); PV_D0(2); PV_D0(3);
#undef PV_D0
#undef TRRD
}
#define PK4(P, B_, OUT) do { unsigned a0 = cvtpk(P[B_+0], P[B_+1]), a1 = cvtpk(P[B_+2], P[B_+3]); \
        unsigned b0 = cvtpk(P[B_+4], P[B_+5]), b1 = cvtpk(P[B_+6], P[B_+7]); \
        auto r0 = __builtin_amdgcn_permlane32_swap(a0, b0, false, false); auto r1 = __builtin_amdgcn_permlane32_swap(a1, b1, false, false); \
        v4u w = {r0[0], r1[0], r0[1], r1[1]}; OUT = *reinterpret_cast<bf16x8*>(&w); } while (0)

struct Tensors {
    const bf16* QA; const bf16* KA; const bf16* VA; const bf16* GA; const bf16* QB; const bf16* KB; const bf16* VB;
    const float* SS; const float* CUM;
    const float* q_gain; const float* k_gain;
    const float* fox_gain; const float* sb_gain;
    bf16* MIX;
};

template <int TYP>
__device__ __forceinline__ void attn_wave(char* ldsw, const Tensors& T, const int b, const int h, const int f0) {
    const int lane = opaque_tid() & 63, r32 = lane & 31, hi = lane >> 5;
    char* V_lds = ldsw;
    float* ks_rk = (float*)(ldsw + 8192); float* ks_nc = ks_rk + 32;
    float* wsf = (float*)(ldsw + 8192 + 256); float* part = wsf; float* li_l = wsf + 1056; float* rs_l = wsf + 1088;
    const bf16* Qp = TYP == 0 ? T.QA : T.QB; const bf16* Kp = TYP == 0 ? T.KA : T.KB; const bf16* Vp = TYP == 0 ? T.VA : T.VB;
    const int frow0 = b * SEQ + f0;
    const int cbase = (b * NH + h) * CUMLD;
    const int jd = (64 + f0) >> 5;
    bf16x8 qr[8];
#pragma unroll
    for (int d0 = 0; d0 < 8; ++d0) qr[d0] = *reinterpret_cast<const bf16x8*>(Qp + (size_t)(frow0 + r32) * 1024 + h * HD + d0 * 16 + hi * 8);
    float mt2 = 0.f;
    if (TYP == 0) {
        const f32x4 sp = *(const f32x4*)(T.SS + ((size_t)(frow0 + r32) * 8 + h) * 4);
        const float rstd = (1.0f / sqrtf(((sp.x + sp.y) + (sp.z + sp.w)) * (1.f / HD) + EPS)) * QSCALE2;
        float n2 = 0.f;
#pragma unroll
        for (int d0 = 0; d0 < 8; ++d0) { const int db = d0 * 16 + hi * 8;
            const f32x4 ga = *(const f32x4*)(T.q_gain + db), gb = *(const f32x4*)(T.q_gain + db + 4), ka = *(const f32x4*)(T.k_gain + db), kb = *(const f32x4*)(T.k_gain + db + 4);
            const float g8[8] = {ga.x * ka.x, ga.y * ka.y, ga.z * ka.z, ga.w * ka.w, gb.x * kb.x, gb.y * kb.y, gb.z * kb.z, gb.w * kb.w};
            v4u w = *reinterpret_cast<v4u*>(&qr[d0]); unsigned ww[4] = {w.x, w.y, w.z, w.w};
#pragma unroll
            for (int i = 0; i < 4; ++i) { const float lo = __uint_as_float(ww[i] << 16) * rstd * g8[2 * i], hi2 = __uint_as_float(ww[i] & 0xffff0000u) * rstd * g8[2 * i + 1]; n2 += lo * lo + hi2 * hi2; ww[i] = cvtpk(lo, hi2); }
            w = (v4u){ww[0], ww[1], ww[2], ww[3]}; qr[d0] = *reinterpret_cast<bf16x8*>(&w); }
        n2 += __shfl_xor(n2, 32);
        mt2 = sqrtf(n2 * (float)HD);
    }
    const int qp = 64 + f0 + r32;
    float bias_t = 0.f, cum_t = 0.f, Rrun = 0.f, l_reg = 0.f;
    if (TYP == 0) { cum_t = T.CUM[cbase + qp - 48]; bias_t = cum_t - mt2; }
    f32x16 o[4] = {};
    const int vkey = lane >> 4, vcol = (lane & 15) * 8;
    const int vb0 = (int)(uintptr_t)V_lds + v_rd_base(lane);
    for (int j = jd; j >= 1; --j) {
        const int kr0 = (j >= 2) ? b * SEQ + 32 * j - 64 : ROW_META - 16;
        const int krow = (j >= 2 || r32 >= 16) ? kr0 + r32 : ROW_META;
        bf16x8 kf[8], vs[8];
#pragma unroll
        for (int d0 = 0; d0 < 8; ++d0) kf[d0] = *reinterpret_cast<const bf16x8*>(Kp + (size_t)krow * 1024 + h * HD + d0 * 16 + hi * 8);
#pragma unroll
        for (int i = 0; i < 8; ++i) { const int vk = vkey + 4 * i; const int vrow = (j >= 2 || vk >= 16) ? kr0 + vk : ROW_META;
            vs[i] = *reinterpret_cast<const bf16x8*>(Vp + (size_t)vrow * 1024 + h * HD + vcol); }
        float sc = 0.f;
        if (TYP == 0) { const int ki = lane & 31; const int srow = (j >= 2 || ki >= 16) ? kr0 + ki : ROW_META; const int pos = (j >= 2) ? 32 * j - 48 + ki : (ki >= 16 ? ki - 16 : 0);
            if (lane < 32) { const f32x4 sk = *(const f32x4*)(T.SS + (((size_t)MROWS + srow) * 8 + h) * 4); sc = 1.0f / sqrtf(((sk.x + sk.y) + (sk.z + sk.w)) * (1.f / HD) + EPS); }
            else sc = -T.CUM[cbase + pos]; }
#pragma unroll
        for (int i = 0; i < 8; ++i) *(bf16x8*)(V_lds + v_st(vkey + 4 * i, vcol)) = vs[i];
        if (TYP == 0) ks_rk[lane] = sc;
        LDS_WAIT();
        f32x16 p0 = f32x16{};
#pragma unroll
        for (int d0 = 0; d0 < 8; ++d0) p0 = __builtin_amdgcn_mfma_f32_32x32x16_bf16(kf[d0], qr[d0], p0, 0, 0, 0);
        const bool need_mask = (j == jd) || (j == 1);
        const int kp0 = 32 * j + 4 * hi;
        bf16x8 pa0, pa1;
        if (TYP == 0) {
#pragma unroll
            for (int q = 0; q < 4; ++q) { const f32x4 rkv = *(const f32x4*)(ks_rk + 8 * q + 4 * hi), ncv = *(const f32x4*)(ks_nc + 8 * q + 4 * hi);
#pragma unroll
                for (int i = 0; i < 4; ++i) p0[4 * q + i] = fmaf(p0[4 * q + i], rkv[i], ncv[i]) + bias_t; }
            if (need_mask) {
#pragma unroll
                for (int r = 0; r < 16; ++r) { const int kp = kp0 + (r & 3) + 8 * (r >> 2); if (!(kp <= qp && kp >= 48)) p0[r] = -__builtin_inff(); } }
            float ps = 0.f;
#pragma unroll
            for (int r = 0; r < 16; ++r) { p0[r] = fast_exp2(p0[r]); ps += p0[r]; }
            l_reg += ps;
        } else {
            f32x16 k0;
#pragma unroll
            for (int r = 0; r < 16; ++r) { const float z = p0[r], sp = fmaxf(z, 0.f) + fast_log2(1.f + fast_exp2(-fabsf(z))); k0[r] = -sp; p0[r] = z - sp; }
            if (need_mask) {
#pragma unroll
                for (int r = 0; r < 16; ++r) { const int kp = kp0 + (r & 3) + 8 * (r >> 2); if (!(kp < qp && kp >= 48)) { p0[r] = -__builtin_inff(); k0[r] = 0.f; } } }
            float so = 0.f, spi = 0.f;
#pragma unroll
            for (int i = 3; i >= 0; --i) {
                const float g = (k0[4 * i] + k0[4 * i + 1]) + (k0[4 * i + 2] + k0[4 * i + 3]);
                const float spn = spi + __shfl_xor(g, 32);
                const float off = Rrun + so + (hi ? spi : spn);
                const float l3 = off, l2 = l3 + k0[4 * i + 3], l1 = l2 + k0[4 * i + 2], l0 = l1 + k0[4 * i + 1];
                p0[4 * i + 3] = fast_exp2(p0[4 * i + 3] + l3); p0[4 * i + 2] = fast_exp2(p0[4 * i + 2] + l2); p0[4 * i + 1] = fast_exp2(p0[4 * i + 1] + l1); p0[4 * i] = fast_exp2(p0[4 * i] + l0);
                so += g; spi = spn;
            }
            Rrun += so + spi;
        }
        PK4(p0, 0, pa0); PK4(p0, 8, pa1);
        {
#define TRRD(dst, off) asm volatile("ds_read_b64_tr_b16 %0, %1 offset:%2" : "=&v"(dst) : "v"(vb0), "i"(off) : "memory")
#define PV_D0(d0) do { s16x4 l0, l1, h0, h1; constexpr int b_ = v_rd_off(d0, 0, 0); \
            TRRD(l0, b_); TRRD(h0, b_ + 2048); TRRD(l1, b_ + 4096); TRRD(h1, b_ + 6144); \
            asm volatile("s_waitcnt lgkmcnt(0)" ::: "memory"); SBAR(); \
            o[d0] = __builtin_amdgcn_mfma_f32_32x32x16_bf16(pa0, (bf16x8){l0[0], l0[1], l0[2], l0[3], h0[0], h0[1], h0[2], h0[3]}, o[d0], 0, 0, 0); \
            o[d0] = __builtin_amdgcn_mfma_f32_32x32x16_bf16(pa1, (bf16x8){l1[0], l1[1], l1[2], l1[3], h1[0], h1[1], h1[2], h1[3]}, o[d0], 0, 0, 0); } while (0)
            PV_D0(0); PV_D0(1); PV_D0(2); PV_D0(3);
#undef PV_D0
#undef TRRD
        }
        if (j > 1) { bool conv;
            if (TYP == 0) { const float lt = l_reg + __shfl_xor(l_reg, 32); conv = (cum_t + ks_nc[0]) <= fast_log2(lt) - 41.f; }
            else conv = Rrun <= -30.f;
            if (__all(conv)) break; }
    }
    int lane_e = lane, frow_e = frow0;
    asm volatile("" : "+v"(lane_e), "+s"(frow_e));
    const int r32e = lane_e & 31, hie = lane_e >> 5;
    if (TYP == 0) {
        l_reg += __shfl_xor(l_reg, 32);
        if (hie == 0) li_l[r32e] = fast_rcp(l_reg);
        LDS_WAIT();
#pragma unroll
        for (int r = 0; r < 16; ++r) { const float il = li_l[crow(r, hie)];
#pragma unroll
            for (int d0 = 0; d0 < 4; ++d0) o[d0][r] *= il; }
    }
#pragma unroll
    for (int r = 0; r < 16; ++r) { float s = 0.f;
#pragma unroll
        for (int d0 = 0; d0 < 4; ++d0) s += o[d0][r] * o[d0][r];
        part[crow(r, hie) * 33 + r32e] = s; }
    LDS_WAIT();
    { float s = 0.f;
#pragma unroll
      for (int c = 0; c < 16; ++c) s += part[r32e * 33 + hie * 16 + c];
      s += __shfl_xor(s, 32);
      if (hie == 0) rs_l[r32e] = 1.0f / sqrtf(s * (1.f / HD) + EPS); }
    LDS_WAIT();
    const float* gain = (TYP == 0 ? T.fox_gain : T.sb_gain) + h * HD;
    float gn[4];
#pragma unroll
    for (int d0 = 0; d0 < 4; ++d0) gn[d0] = gain[d0 * 32 + r32e];
    unsigned short* stg = (unsigned short*)V_lds;
    if (TYP == 0) {
#pragma unroll
        for (int i = 0; i < 8; ++i) { const int c = lane_e + 64 * i, row = c >> 4, ch = c & 15;
            *(v4u*)(stg + row * 128 + ch * 8) = *(const v4u*)(T.GA + (size_t)(frow_e + row) * 1024 + h * HD + ch * 8); }
        LDS_WAIT();
#pragma unroll
        for (int r = 0; r < 16; ++r) { const int orow = crow(r, hie);
#pragma unroll
            for (int d0 = 0; d0 < 4; ++d0) o[d0][r] *= bf2f(stg[orow * 128 + d0 * 32 + r32e]); }
        LDS_WAIT();
    }
#pragma unroll
    for (int r = 0; r < 16; ++r) { const int orow = crow(r, hie); const float rs = rs_l[orow];
#pragma unroll
        for (int d0 = 0; d0 < 4; ++d0) { const float v = o[d0][r] * rs * gn[d0]; const float vn = __shfl_xor(v, 1);
            if ((r32e & 1) == 0) *(unsigned*)(stg + orow * 128 + d0 * 32 + r32e) = cvtpk(v, vn); } }
    LDS_WAIT();
#pragma unroll
    for (int i = 0; i < 8; ++i) { const int c = lane_e + 64 * i, row = c >> 4, ch = c & 15;
        *(v4u*)(T.MIX + (size_t)(frow_e + row) * DM + TYP * 1024 + h * HD + ch * 8) = *(const v4u*)(stg + row * 128 + ch * 8); }
    LDS_WAIT();
}
#undef PK4
#undef SBAR
#undef KSWZ
}

struct Frame {
    LAS unsigned char* lds; char* ldsg;
    volatile LAS unsigned* MISC;
    gu32* ctl;
    int tid, lane, wave, vcu, G;
    unsigned char* ws;
    const float *x, *meta, *g1, *w_in, *b_f, *q_gain, *k_gain, *fox_gain, *sb_gain, *w_out, *g2, *w_coarse, *b_coarse, *w_fine, *b_fine, *w1, *w3, *w2;
    float* out;
};

__device__ __forceinline__ void transpose_item(const float* W, size_t ldw, int k0, int n0, bf16* WT, size_t Kd, size_t drow0, LAS float* scr, int lane) {
    { const int r = lane >> 4, c4 = (lane & 15) * 4; const float* src = W + (size_t)(k0 + r) * ldw + n0 + c4; LAS float* dst = scr + r * 65 + c4;
#pragma unroll
      for (int hlf = 0; hlf < 2; ++hlf) { f32x4 v[8];
#pragma unroll
          for (int i = 0; i < 8; ++i) v[i] = *(const f32x4*)(src + (size_t)(4 * (8 * hlf + i)) * ldw);
#pragma unroll
          for (int i = 0; i < 8; ++i) { LAS float* d = dst + 4 * (8 * hlf + i) * 65; d[0] = v[i].x; d[1] = v[i].y; d[2] = v[i].z; d[3] = v[i].w; } } }
    LDS_WAIT(); asm volatile("" ::: "memory");
    const int c = lane & 7;
#pragma unroll
    for (int j = 0; j < 8; ++j) { const int n = (lane >> 3) + 8 * j; const LAS float* s = scr + (8 * c) * 65 + n;
        v4u o; o.x = cvtpk(s[0 * 65], s[1 * 65]); o.y = cvtpk(s[2 * 65], s[3 * 65]); o.z = cvtpk(s[4 * 65], s[5 * 65]); o.w = cvtpk(s[6 * 65], s[7 * 65]);
        *(GAS v4u*)(WT + (drow0 + n) * Kd + k0 + 8 * c) = o; }
    LDS_WAIT(); asm volatile("" ::: "memory");
}

__device__ __forceinline__ void p0_prologue(Frame& F) {
    const int gw = F.vcu * 8 + F.wave, NGW = F.G * 8;
    LAS float* wf = (LAS float*)F.lds;
    for (int e = F.tid; e < 8 * DM; e += 512) { const int k = e >> 3, jj = e & 7; wf[jj * DM + k] = F.w_in[(size_t)k * LDW_IN + NPROJ + jj]; }
    __syncthreads();
    bf16* U1 = (bf16*)(F.ws + WS_U1); float* Fp = (float*)(F.ws + WS_F);
    for (int m = gw; m < MROWS; m += NGW) {
        GAS v2u* o8 = (GAS v2u*)(U1 + (size_t)m * DM) + F.lane;
        if (m >= NKEYROWS) {
#pragma unroll
            for (int j = 0; j < 8; ++j) o8[64 * j] = (v2u){0u, 0u};
            continue; }
        const float* xrow = m < TF ? F.x + (size_t)m * DM : F.meta + (size_t)(m - TF) * DM;
        const GAS f32x4* xr = (const GAS f32x4*)xrow + F.lane;
        f32x4 v[8]; float s = 0.f;
#pragma unroll
        for (int j = 0; j < 8; ++j) { v[j] = xr[64 * j]; s += (v[j].x * v[j].x + v[j].y * v[j].y) + (v[j].z * v[j].z + v[j].w * v[j].w); }
        const float rstd = 1.0f / sqrtf(wave_sum(s) * (1.f / DM) + EPS);
        float fa[8] = {0.f, 0.f, 0.f, 0.f, 0.f, 0.f, 0.f, 0.f};
#pragma unroll
        for (int j = 0; j < 8; ++j) { const f32x4 g = *((const GAS f32x4*)F.g1 + F.lane + 64 * j); v[j] = v[j] * rstd * g;
            o8[64 * j] = (v2u){cvtpk(v[j].x, v[j].y), cvtpk(v[j].z, v[j].w)};
#pragma unroll
            for (int jj = 0; jj < 8; ++jj) { const f32x4 w = *(const LAS f32x4*)(wf + jj * DM + 256 * j + 4 * F.lane); fa[jj] += (v[j].x * w.x + v[j].y * w.y) + (v[j].z * w.z + v[j].w * w.w); } }
#pragma unroll
        for (int jj = 0; jj < 8; ++jj) fa[jj] = wave_sum(fa[jj]);
        if (F.lane == 0) {
#pragma unroll
            for (int jj = 0; jj < 8; ++jj) Fp[(size_t)m * 8 + jj] = fa[jj]; }
    }
    { bf16* U2 = (bf16*)(F.ws + WS_U2);
      for (int m = TF + gw; m < MROWS; m += NGW) { GAS v2u* o8 = (GAS v2u*)(U2 + (size_t)m * DM) + F.lane;
#pragma unroll
          for (int j = 0; j < 8; ++j) o8[64 * j] = (v2u){0u, 0u}; } }
    { bf16* HID = (bf16*)(F.ws + WS_HID);
      for (int m = NASSIGN + gw; m < NASSIGN + 384; m += NGW) { GAS v2u* o8 = (GAS v2u*)(HID + (size_t)m * DE) + F.lane; o8[0] = (v2u){0u, 0u}; o8[64] = (v2u){0u, 0u}; } }
    { v4u* RB = (v4u*)(F.ws + WS_RB);
      for (int it = gw * 64 + F.lane; it < 64 * 5 * 64; it += NGW * 64) { const int ln = it & 63, kc = it >> 6, ks = kc / 5, cb = kc % 5, col = 16 * cb + (ln & 15), k0 = 32 * ks + 8 * (ln >> 4);
          float w[8], lo[8]; unsigned hb[4], lb[4];
#pragma unroll
          for (int i = 0; i < 8; ++i) { w[i] = col < 8 ? F.w_coarse[(size_t)(k0 + i) * 8 + col] : (col < 72 ? F.w_fine[(size_t)(k0 + i) * 64 + col - 8] : 0.f); }
#pragma unroll
          for (int i = 0; i < 4; ++i) { hb[i] = cvtpk(w[2 * i], w[2 * i + 1]); lo[2 * i] = w[2 * i] - __uint_as_float(hb[i] << 16); lo[2 * i + 1] = w[2 * i + 1] - __uint_as_float(hb[i] & 0xffff0000u); lb[i] = cvtpk(lo[2 * i], lo[2 * i + 1]); }
          RB[(size_t)(kc * 2 + 0) * 64 + ln] = (v4u){hb[0], hb[1], hb[2], hb[3]}; RB[(size_t)(kc * 2 + 1) * 64 + ln] = (v4u){lb[0], lb[1], lb[2], lb[3]}; } }
    __syncthreads();
    LAS float* scr = (LAS float*)(F.lds + F.wave * 16640);
    bf16* WinT = (bf16*)(F.ws + WS_WIN_T); bf16* WoutT = (bf16*)(F.ws + WS_WOUT_T);
    constexpr int I_IN = (DM / 64) * (NPROJ / 64), I_OUT = (DM / 64) * (DM / 64);
    constexpr int NITEMS = I_IN + I_OUT;
    for (int it = gw; it < NITEMS; it += NGW) {
        int r = it;
        if (r < I_IN) { const int kb = r / (NPROJ / 64), nb = r % (NPROJ / 64); transpose_item(F.w_in, LDW_IN, kb * 64, nb * 64, WinT, DM, nb * 64, scr, F.lane); continue; } r -= I_IN;
        { const int kb = r / (DM / 64), nb = r % (DM / 64); transpose_item(F.w_out, DM, kb * 64, nb * 64, WoutT, DM, nb * 64, scr, F.lane); }
    }
}

__device__ __forceinline__ void cum_scan(Frame& F, int bh) {
    const float* Fp = (const float*)(F.ws + WS_F); float* CUM = (float*)(F.ws + WS_CUM);
    const int b = bh >> 3, h = bh & 7; const float bf = F.b_f[h]; float carry = 0.f;
    for (int c0 = 0; c0 < LPOS; c0 += 64) { const int pos = c0 + F.lane; float v = 0.f;
        if (pos < LPOS) { const int row = pos < NMETA ? ROW_META + pos : b * SEQ + pos - NMETA; const float xv = Fp[(size_t)row * 8 + h] + bf;
            v = (fminf(xv, 0.f) - log1pf(expf(-fabsf(xv)))) * LOG2E; }
#pragma unroll
        for (int o = 1; o < 64; o <<= 1) { const float t = __shfl_up(v, o); if (F.lane >= o) v += t; }
        v += carry;
        if (pos < LPOS) CUM[(size_t)bh * CUMLD + pos] = v;
        carry = __shfl(v, 63); }
}

__device__ __forceinline__ void p5_router(Frame& F) {
    const int ntask = TF / 16;
    const float* H1 = F.out; bf16* U2 = (bf16*)(F.ws + WS_U2); const v4u* RB = (const v4u*)(F.ws + WS_RB);
    int* RE = (int*)(F.ws + WS_ROUTE); int* RP = RE + TF * 2; float* RW = (float*)(RP + TF * 2); int* TOK = (int*)(F.ws + WS_TOK);
    const int tid = opaque_tid(), lane = tid & 63, wave = __builtin_amdgcn_readfirstlane(tid >> 6), tk = wave >> 2, kp = wave & 3;
    LAS float* pacc = (LAS float*)F.lds;
    LAS float* ssp = (LAS float*)(F.lds + 40960);
    LAS float* lg = (LAS float*)(F.lds + 41472) + tk * 16 * 88;
    const int i = lane & 15, kq = lane >> 4;
    for (int base = 0; base < ntask; base += 2 * F.G) {
        const int task = base + 2 * (int)blockIdx.x + tk; const bool live = task < ntask;
        const int row0 = (live ? task : 0) * 16; const float* hrow = H1 + (size_t)(row0 + i) * DM + 8 * kq + 512 * kp;
        float ss = 0.f;
#pragma unroll 8
        for (int ks = 0; ks < 16; ++ks) { const f32x4 a = *(const f32x4*)(hrow + 32 * ks), b = *(const f32x4*)(hrow + 32 * ks + 4);
            ss += (a.x * a.x + a.y * a.y) + (a.z * a.z + a.w * a.w) + (b.x * b.x + b.y * b.y) + (b.z * b.z + b.w * b.w); }
        ss += __shfl_xor(ss, 16); ss += __shfl_xor(ss, 32);
        if (lane < 16) ssp[wave * 16 + i] = ss;
        __syncthreads();
        const float rstd = 1.0f / sqrtf(((ssp[(4 * tk) * 16 + i] + ssp[(4 * tk + 1) * 16 + i]) + (ssp[(4 * tk + 2) * 16 + i] + ssp[(4 * tk + 3) * 16 + i])) * (1.f / DM) + EPS);
        f32x4 acc[5];
#pragma unroll
        for (int cb = 0; cb < 5; ++cb) acc[cb] = (f32x4){0.f, 0.f, 0.f, 0.f};
#pragma unroll 2
        for (int ks = 0; ks < 16; ++ks) { const int kg = 16 * kp + ks;
            const f32x4 a = *(const f32x4*)(hrow + 32 * ks), b = *(const f32x4*)(hrow + 32 * ks + 4);
            const f32x4 ga = *(const f32x4*)(F.g2 + 32 * kg + 8 * kq), gb = *(const f32x4*)(F.g2 + 32 * kg + 8 * kq + 4);
            float u[8] = {a.x * rstd * ga.x, a.y * rstd * ga.y, a.z * rstd * ga.z, a.w * rstd * ga.w, b.x * rstd * gb.x, b.y * rstd * gb.y, b.z * rstd * gb.z, b.w * rstd * gb.w};
            unsigned hb[4], lb[4];
#pragma unroll
            for (int q = 0; q < 4; ++q) { hb[q] = cvtpk(u[2 * q], u[2 * q + 1]); lb[q] = cvtpk(u[2 * q] - __uint_as_float(hb[q] << 16), u[2 * q + 1] - __uint_as_float(hb[q] & 0xffff0000u)); }
            v4u hv = {hb[0], hb[1], hb[2], hb[3]}, lv = {lb[0], lb[1], lb[2], lb[3]};
            if (live) *(v4u*)(U2 + (size_t)(row0 + i) * DM + 32 * kg + 8 * kq) = hv;
            const bf16x8 Ah = *reinterpret_cast<bf16x8*>(&hv), Al = *reinterpret_cast<bf16x8*>(&lv);
#pragma unroll
            for (int cb = 0; cb < 5; ++cb) { v4u bh = RB[(size_t)((kg * 5 + cb) * 2 + 0) * 64 + lane], bl = RB[(size_t)((kg * 5 + cb) * 2 + 1) * 64 + lane];
                const bf16x8 Bh = *reinterpret_cast<bf16x8*>(&bh), Bl = *reinterpret_cast<bf16x8*>(&bl);
                acc[cb] = __builtin_amdgcn_mfma_f32_16x16x32_bf16(Ah, Bh, acc[cb], 0, 0, 0);
                acc[cb] = __builtin_amdgcn_mfma_f32_16x16x32_bf16(Ah, Bl, acc[cb], 0, 0, 0);
                acc[cb] = __builtin_amdgcn_mfma_f32_16x16x32_bf16(Al, Bh, acc[cb], 0, 0, 0); }
        }
#pragma unroll
        for (int cb = 0; cb < 5; ++cb)
#pragma unroll
            for (int j = 0; j < 4; ++j) pacc[(wave * 16 + 4 * kq + j) * 80 + 16 * cb + i] = acc[cb][j];
        __syncthreads();
        if (kp == 0) {
#pragma unroll
            for (int m = 0; m < 20; ++m) { const int idx = lane + 64 * m, r = idx / 80, c = idx - r * 80;
                lg[r * 88 + c] = (pacc[((4 * tk) * 16 + r) * 80 + c] + pacc[((4 * tk + 1) * 16 + r) * 80 + c]) + (pacc[((4 * tk + 2) * 16 + r) * 80 + c] + pacc[((4 * tk + 3) * 16 + r) * 80 + c]); }
            LDS_WAIT(); asm volatile("" ::: "memory");
            if (lane < 16 && live) { const LAS float* L = lg + lane * 88; const int row = row0 + lane;
                float cmax = L[0] + F.b_coarse[0]; int gs = 0; float cv[8]; cv[0] = cmax;
#pragma unroll
                for (int g = 1; g < 8; ++g) { cv[g] = L[g] + F.b_coarse[g]; if (cv[g] > cmax) { cmax = cv[g]; gs = g; } }
                float den = 0.f;
#pragma unroll
                for (int g = 0; g < 8; ++g) den += expf(cv[g] - cmax);
                const float ggate = 1.0f / den;
                float f1 = -__builtin_inff(), f2 = -__builtin_inff(); int i1 = 0, i2 = 0;
#pragma unroll
                for (int jx = 0; jx < 8; ++jx) { const float fv = L[8 + gs * 8 + jx] + F.b_fine[gs * 8 + jx];
                    if (fv > f1) { f2 = f1; i2 = i1; f1 = fv; i1 = jx; } else if (fv > f2) { f2 = fv; i2 = jx; } }
                const float e2 = expf(f2 - f1), w1 = ggate / (1.f + e2), w2 = ggate * e2 / (1.f + e2);
                const int ea = gs * 8 + i1, eb = gs * 8 + i2;
                const int pa = (int)__hip_atomic_fetch_add(F.ctl + CW_CNT + 64 * ea, 1u, RLX_AGENT), pb = (int)__hip_atomic_fetch_add(F.ctl + CW_CNT + 64 * eb, 1u, RLX_AGENT);
                TOK[(size_t)ea * TOKLD + pa] = row * 2; TOK[(size_t)eb * TOKLD + pb] = row * 2 + 1;
                RE[row * 2] = ea; RE[row * 2 + 1] = eb; RP[row * 2] = pa; RP[row * 2 + 1] = pb; RW[row * 2] = w1; RW[row * 2 + 1] = w2; }
        }
        __syncthreads();
    }
}

__device__ __forceinline__ void moe_prefix(Frame& F, int ncs) {
    LAS int* upre = (LAS int*)(F.lds + TPRE_OFF); LAS int* cpre = upre + 80;
    if (F.tid < 64) { const int c = (int)__hip_atomic_load(F.ctl + CW_CNT + 64 * F.tid, RLX_AGENT); int u = ((c + 383) / 384) * ncs, v = c;
#pragma unroll
        for (int o = 1; o < 64; o <<= 1) { const int y = __shfl_up(u, o), z = __shfl_up(v, o); if (F.lane >= o) { u += y; v += z; } }
        upre[F.tid + 1] = u; cpre[F.tid + 1] = v; if (F.tid == 0) { upre[0] = 0; cpre[0] = 0; } }
    __syncthreads();
}

__device__ __forceinline__ void p8_combine(Frame& F) {
    const LAS int* cpre = (const LAS int*)(F.lds + TPRE_OFF) + 80;
    const int* RE = (const int*)(F.ws + WS_ROUTE); const int* RP = RE + TF * 2; const bf16* Y = (const bf16*)(F.ws + WS_Y);
    for (int m = F.vcu * 8 + F.wave; m < TF; m += F.G * 8) {
        const int e0 = RE[m * 2], e1 = RE[m * 2 + 1], p0 = RP[m * 2], p1 = RP[m * 2 + 1];
        const size_t s0 = (size_t)(cpre[e0] + p0), s1 = (size_t)(cpre[e1] + p1);
        GAS f32x4* op = (GAS f32x4*)(F.out + (size_t)m * DM) + 2 * F.lane;
        const GAS v4u* y0 = (const GAS v4u*)(Y + s0 * DM) + F.lane; const GAS v4u* y1 = (const GAS v4u*)(Y + s1 * DM) + F.lane;
#pragma unroll
        for (int j = 0; j < 4; ++j) { f32x4 a = op[128 * j], b = op[128 * j + 1]; const v4u u0 = y0[64 * j], u1 = y1[64 * j];
            a.x += __uint_as_float(u0.x << 16) + __uint_as_float(u1.x << 16); a.y += __uint_as_float(u0.x & 0xffff0000u) + __uint_as_float(u1.x & 0xffff0000u);
            a.z += __uint_as_float(u0.y << 16) + __uint_as_float(u1.y << 16); a.w += __uint_as_float(u0.y & 0xffff0000u) + __uint_as_float(u1.y & 0xffff0000u);
            b.x += __uint_as_float(u0.z << 16) + __uint_as_float(u1.z << 16); b.y += __uint_as_float(u0.z & 0xffff0000u) + __uint_as_float(u1.z & 0xffff0000u);
            b.z += __uint_as_float(u0.w << 16) + __uint_as_float(u1.w << 16); b.w += __uint_as_float(u0.w & 0xffff0000u) + __uint_as_float(u1.w & 0xffff0000u);
            op[128 * j] = a; op[128 * j + 1] = b; }
    }
}

#define XB_TMO      128
#define XB_XCNT(j)  (256  + 64 * (j))
#define XB_XSUB(j)  (1280 + 64 * (j))
#define XB_XGEN(j)  (2304 + 64 * (j))
#define XB_TOP      3328
#define XB_TOPGEN   3392
#define XCD_BAR_WORDS 3456
#define XB_SPIN_CAP (1u << 18)

__device__ __forceinline__ unsigned xb_ld(unsigned* p)              { return __hip_atomic_load(p, __ATOMIC_RELAXED, __HIP_MEMORY_SCOPE_AGENT); }
__device__ __forceinline__ unsigned xb_add(unsigned* p, unsigned v) { return __hip_atomic_fetch_add(p, v, __ATOMIC_RELAXED, __HIP_MEMORY_SCOPE_AGENT); }
__device__ __forceinline__ unsigned xb_xcc_id() { return (unsigned)__builtin_amdgcn_s_getreg((3 << 11) | 20) & 0xFu; }
#define XB_SPIN(cond, bar) do { unsigned _sp = 0; while (cond) { __builtin_amdgcn_s_sleep(1); \
    if ((++_sp & 255u) == 0u) { if (xb_ld(&(bar)[XB_TMO])) break; if (_sp > XB_SPIN_CAP) { atomicAdd(&(bar)[XB_TMO], 1u); break; } } } } while (0)

struct XcdBarrier {
    unsigned* bar; unsigned x;
    volatile LAS unsigned* st;
};

__device__ __forceinline__ XcdBarrier xcd_barrier_post(unsigned* bar, volatile LAS unsigned* st) {
    XcdBarrier b; b.bar = bar; b.x = xb_xcc_id(); b.st = st;
    if (threadIdx.x == 0) (void)xb_add(&bar[XB_XCNT(b.x)], 1u);
    return b;
}
__device__ __forceinline__ void xcd_barrier_complete(unsigned* bar, unsigned x, unsigned& nloc, unsigned& nx) {
    const unsigned G = gridDim.x * gridDim.y * gridDim.z;
    unsigned sum, cnt, mine, sp = 0u;
    for (;;) {
        sum = 0u; cnt = 0u; mine = 0u;
#pragma unroll
        for (unsigned j = 0; j < 16; ++j) { const unsigned c = xb_ld(&bar[XB_XCNT(j)]); sum += c; cnt += (c > 0u) ? 1u : 0u; mine = (j == x) ? c : mine; }
        if (sum == G) break;
        __builtin_amdgcn_s_sleep(1);
        if ((++sp & 255u) == 0u) { if (xb_ld(&bar[XB_TMO])) break; if (sp > XB_SPIN_CAP) { atomicAdd(&bar[XB_TMO], 1u); break; } }
    }
    nloc = mine > 0u ? mine : 1u; nx = cnt > 0u ? cnt : 1u;
}

__device__ __forceinline__ void xcd_barrier(const XcdBarrier& b) {
    asm volatile("s_waitcnt vmcnt(0)" ::: "memory");
    __syncthreads();
    if (threadIdx.x == 0) {
        unsigned* bar = b.bar;
        __builtin_amdgcn_s_waitcnt(0);
        unsigned nloc = b.st[0], nx = b.st[1];
        if (nloc == 0u) { xcd_barrier_complete(bar, b.x, nloc, nx); b.st[0] = nloc; b.st[1] = nx; }
        const unsigned old = xb_add(&bar[XB_XSUB(b.x)], 1u);
        const unsigned gen = old / nloc;
        if (old + 1u == (gen + 1u) * nloc) {
            __builtin_amdgcn_fence(__ATOMIC_RELEASE, "agent");
            asm volatile("s_waitcnt vmcnt(0)" ::: "memory");
            const unsigned og = xb_add(&bar[XB_TOP], 1u);
            const unsigned tg = og / nx;
            if (og + 1u == (tg + 1u) * nx) xb_add(&bar[XB_TOPGEN], 1u);
            else XB_SPIN(xb_ld(&bar[XB_TOPGEN]) == tg, bar);
            __builtin_amdgcn_fence(__ATOMIC_ACQUIRE, "agent");
            xb_add(&bar[XB_XGEN(b.x)], 1u);
            asm volatile("s_waitcnt vmcnt(0)" ::: "memory");
        } else {
            XB_SPIN(xb_ld(&bar[XB_XGEN(b.x)]) == gen, bar);
            __builtin_amdgcn_fence(__ATOMIC_ACQUIRE, "agent");
            asm volatile("s_waitcnt vmcnt(0)" ::: "memory");
        }
    }
    __syncthreads();
}

struct Args { const float* in[18]; float* out; unsigned char* ws; int ph_lo, ph_hi; };
__global__ void __launch_bounds__(512, 2) fwd(Args args) {
    extern __shared__ __attribute__((aligned(16))) unsigned char lds[];
    Frame F;
    F.lds = (LAS unsigned char*)lds; F.ldsg = (char*)lds;
    F.MISC = (volatile LAS unsigned*)(F.lds + MISC_OFF);
    F.tid = threadIdx.x; F.lane = F.tid & 63; F.wave = __builtin_amdgcn_readfirstlane(F.tid >> 6);
    F.G = gridDim.x; { const int bx = blockIdx.x; F.vcu = (F.G % 8 == 0) ? (bx % 8) * (F.G / 8) + bx / 8 : bx; }
    F.ws = args.ws; F.ctl = (gu32*)(args.ws + WS_CTL); F.out = args.out;
    F.x = args.in[0]; F.meta = args.in[1]; F.g1 = args.in[2]; F.w_in = args.in[3]; F.b_f = args.in[4]; F.q_gain = args.in[5]; F.k_gain = args.in[6];
    F.fox_gain = args.in[7]; F.sb_gain = args.in[8]; F.w_out = args.in[9]; F.g2 = args.in[10]; F.w_coarse = args.in[11]; F.b_coarse = args.in[12];
    F.w_fine = args.in[13]; F.b_fine = args.in[14]; F.w1 = args.in[15]; F.w3 = args.in[16]; F.w2 = args.in[17];
    for (int u = F.tid; u < 32; u += 512) F.MISC[u] = 0u;
    __syncthreads();
    const int lo = args.ph_lo, hi = args.ph_hi;
    XcdBarrier bar; bar.bar = (unsigned*)(F.ctl + CW_BAR); bar.x = 0; bar.st = nullptr;
    if (hi - lo > 1) bar = xcd_barrier_post((unsigned*)(F.ctl + CW_BAR), F.MISC + 8);
#define IN(k) (lo <= (k) && (k) < hi)
#define SEAM(k) do { if (IN(k) && IN((k) + 1)) xcd_barrier(bar); } while (0)
    bf16* PROJ = (bf16*)(F.ws + WS_PROJ);


    if (IN(0)) { p0_prologue(F); if (REP_PHASE == 0) { __syncthreads(); p0_prologue(F); } SEAM(0); }

    if (IN(1)) {
        { const int bh = (int)blockIdx.x - (F.G - NB * NH); if (bh >= 0 && F.wave == 0) cum_scan(F, bh); }
        pg8::DenseOrder S; S.init(F.ws + WS_U1, F.ws + WS_WIN_T, MROWS, NPROJ, DM, F.G, (int)blockIdx.x);
        pg8::EpiProj E{PROJ, (float*)(F.ws + WS_SS)};
        pg8::gemm_phase<pg8::EpiProj, pg8::DenseOrder, false>(F.lds, DM, S, E, nullptr);
        if (REP_PHASE == 1) pg8::gemm_phase<pg8::EpiProj, pg8::DenseOrder, false>(F.lds, DM, S, E, nullptr);
        if (IN(1) && IN(3)) xcd_barrier(bar);
    }

    if (IN(3)) {
        att::Tensors T{PROJ, PROJ + PROJ_TS, PROJ + 2 * PROJ_TS, PROJ + 3 * PROJ_TS, PROJ + 4 * PROJ_TS, PROJ + 5 * PROJ_TS, PROJ + 6 * PROJ_TS,
                       (const float*)(F.ws + WS_SS), (const float*)(F.ws + WS_CUM), F.q_gain, F.k_gain, F.fox_gain, F.sb_gain, (bf16*)(F.ws + WS_MIX)};
        for (int rep = 0; rep < ((REP_PHASE == 3 || REP_PHASE == 31 || REP_PHASE == 32) ? 2 : 1); ++rep)
        for (int w = F.vcu; w < 256; w += F.G) { const int bh = w >> 3, s = w & 7;
            if (REP_PHASE != 32 || rep == 0) att::attn_wave<0>(F.ldsg + F.wave * 16384, T, bh >> 3, bh & 7, s * 256 + F.wave * 32);
            if (REP_PHASE != 31 || rep == 0) att::attn_wave<1>(F.ldsg + F.wave * 16384, T, bh >> 3, bh & 7, (7 - s) * 256 + F.wave * 32);
        }
        __syncthreads();
        SEAM(3);
    }
    if (IN(4)) {
        pg8::DenseOrder S; S.init(F.ws + WS_MIX, F.ws + WS_WOUT_T, TF, DM, DM, F.G, (int)blockIdx.x);
        pg8::EpiOut E{F.x, F.out};
        pg8::gemm_phase<pg8::EpiOut, pg8::DenseOrder, false>(F.lds, DM, S, E, nullptr);
        if (REP_PHASE == 4) pg8::gemm_phase<pg8::EpiOut, pg8::DenseOrder, false>(F.lds, DM, S, E, nullptr);
        SEAM(4);
    }
    if (IN(5)) { p5_router(F); SEAM(5); }

    if (IN(6)) {
        moe_prefix(F, 8);
        const LAS int* upre = (const LAS int*)(F.lds + TPRE_OFF);
        moe::Order S{F.G, F.vcu, 8, upre, upre + 80};
        LAS int* tab = (LAS int*)(F.lds + TAB_OFF); const int* TOK = (const int*)(F.ws + WS_TOK);
        for (int i = 0; i < 8; ++i) { int e, cs, mt, cnt, cbase; if (!S.decode(i, e, cs, mt, cnt, cbase)) break;
            if (F.tid < 384) { const int p = mt * 384 + F.tid; tab[i * 384 + F.tid] = p < cnt ? (TOK[(size_t)e * TOKLD + p] >> 1) : TF; } }
        __syncthreads();
        for (int rep = 0; rep < (REP_PHASE == 6 ? 2 : 1); ++rep)
        moe::phase<DM, true>(F.lds, S, tab, (const char*)(F.ws + WS_U2), F.w1, F.w3, (bf16*)(F.ws + WS_HID));
        SEAM(6);
    }
    if (IN(7)) {
        moe_prefix(F, 16);
        const LAS int* upre = (const LAS int*)(F.lds + TPRE_OFF);
        moe::Order S{F.G, F.vcu, 16, upre, upre + 80};
        LAS float* wtab = (LAS float*)(F.lds + TAB_OFF); const int* TOK = (const int*)(F.ws + WS_TOK); const float* RW = (const float*)(F.ws + WS_ROUTE) + TF * 4;
        for (int i = 0; i < 8; ++i) { int e, cs, mt, cnt, cbase; if (!S.decode(i, e, cs, mt, cnt, cbase)) break;
            if (F.tid < 384) { const int p = mt * 384 + F.tid; wtab[i * 384 + F.tid] = p < cnt ? RW[TOK[(size_t)e * TOKLD + p]] : 0.f; } }
        __syncthreads();
        for (int rep = 0; rep < (REP_PHASE == 7 ? 2 : 1); ++rep)
        moe::phase<DE, false>(F.lds, S, (const LAS int*)wtab, (const char*)(F.ws + WS_HID), F.w2, nullptr, (bf16*)(F.ws + WS_Y));
        SEAM(7);
    }
    if (IN(8)) { moe_prefix(F, 16); p8_combine(F); }
#undef IN
#undef SEAM
}

extern "C" void kernel_launch(void* const* d_in, const int* in_sizes, int n_in, void* d_out, int out_size, void* d_ws, size_t ws_size, hipStream_t stream) {
    static int grid = 0;
    if (grid == 0) {
        if (n_in != 18 || out_size != TF * DM || ws_size < WS_END) { fprintf(stderr, "kernel_launch: unexpected shapes (n_in %d, out %d, ws %zu); nothing launched\n", n_in, out_size, ws_size); grid = -1; return; }
        int dev = 0, cus = 0, per_cu = 0;
        if (hipGetDevice(&dev) != hipSuccess || hipDeviceGetAttribute(&cus, hipDeviceAttributeMultiprocessorCount, dev) != hipSuccess) { grid = -1; return; }
        if (hipFuncSetAttribute((const void*)fwd, hipFuncAttributeMaxDynamicSharedMemorySize, LDS_BYTES) != hipSuccess) { fprintf(stderr, "kernel_launch: hipFuncSetAttribute failed\n"); grid = -1; return; }
        if (hipOccupancyMaxActiveBlocksPerMultiprocessor(&per_cu, (const void*)fwd, 512, LDS_BYTES) != hipSuccess || per_cu < 1) fprintf(stderr, "kernel_launch: occupancy query reports %d\n", per_cu);
        (void)hipGetLastError();
        grid = cus > 0 ? cus : 256;
    }
    if (grid < 0) return;
    (void)hipMemsetAsync((char*)d_ws + WS_CTL, 0, CTL_ZERO_BYTES, stream);
    Args a{};
    for (int i = 0; i < 18; ++i) a.in[i] = (const float*)d_in[i];
    a.out = (float*)d_out; a.ws = (unsigned char*)d_ws;
    constexpr int NL = MK_N_LAUNCHES;
    for (int li = 0; li < NL; ++li) {
        a.ph_lo = (NL == 1) ? 0 : li; a.ph_hi = (NL == 1) ? NPHASE : li + 1;
        hipLaunchKernelGGL(fwd, dim3(grid), dim3(512), LDS_BYTES, stream, a);
    }
}
```

```cpp
#include <hip/hip_runtime.h>
#include <hip/hip_bf16.h>
#include <cstdio>
#include <cstdint>

#ifndef REP_PHASE
#define REP_PHASE -1
#endif
#ifndef MK_N_LAUNCHES
#define MK_N_LAUNCHES 1
#endif

constexpr int DM = 2048, NB = 4, SEQ = 2048, NMETA = 16, HD = 128, NH = 8;
constexpr int TF = NB * SEQ;
constexpr int ROW_META = TF;
constexpr int NKEYROWS = TF + NMETA;
constexpr int MROWS = 8448;
constexpr int NPROJ = 7168, LDW_IN = 7176;
constexpr int NE = 64, DE = 512;
constexpr int LPOS = SEQ + NMETA;
constexpr int CUMLD = 2112;
constexpr float EPS = 1e-6f;
constexpr float LOG2E = 1.4426950408889634f;
constexpr float QSCALE2 = 0.08838834764831845f * 1.4426950408889634f;
constexpr int NPHASE = 9;

constexpr size_t MiB = 1u << 20;
constexpr size_t WS_CTL = 0, CTL_ZERO_BYTES = 1 * MiB;
constexpr size_t WS_WIN_T = 2 * MiB;
constexpr size_t WS_WOUT_T = 30 * MiB;
constexpr size_t WS_U1 = 38 * MiB;
constexpr size_t WS_PROJ = 72 * MiB;
constexpr size_t PROJ_TS = (size_t)MROWS * 1024;
constexpr size_t WS_F = 188 * MiB;
constexpr size_t WS_CUM = 189 * MiB;
constexpr size_t WS_SS = 190 * MiB;
constexpr size_t WS_RK = 194 * MiB;
constexpr size_t WS_MT = 195 * MiB;
constexpr size_t WS_MIX = 196 * MiB;
constexpr size_t WS_U2 = 228 * MiB;
constexpr size_t WS_ROUTE = 262 * MiB;
constexpr size_t WS_TOK = 263 * MiB;
constexpr int TOKLD = 16512;
constexpr size_t WS_RB = 268 * MiB;
constexpr int NASSIGN = TF * 2;
constexpr size_t WS_HID = 272 * MiB;
constexpr size_t WS_Y = 292 * MiB;
constexpr size_t WS_END = 360 * MiB;
constexpr int CW_TMO = 0;
constexpr int CW_CNT = 1024;
constexpr int CW_BAR = 8192;

constexpr int RING_BYTES = 139264;
constexpr int TAB_OFF = RING_BYTES, TAB_BYTES = 8 * 384 * 4;
constexpr int TPRE_OFF = TAB_OFF + TAB_BYTES;
constexpr int MISC_OFF = TPRE_OFF + 1024;
constexpr int LDS_BYTES = MISC_OFF + 128;

#define GAS __attribute__((address_space(1)))
#define LAS __attribute__((address_space(3)))
typedef unsigned short bf16;
typedef unsigned v4u __attribute__((ext_vector_type(4)));
typedef unsigned v2u __attribute__((ext_vector_type(2)));
typedef float f32x4 __attribute__((ext_vector_type(4)));
typedef float f32x2 __attribute__((ext_vector_type(2)));
typedef float f32x16 __attribute__((ext_vector_type(16)));
typedef short bf16x8 __attribute__((ext_vector_type(8)));
typedef short s16x4 __attribute__((ext_vector_type(4)));
typedef GAS unsigned gu32;
#define RLX_AGENT __ATOMIC_RELAXED, __HIP_MEMORY_SCOPE_AGENT
#define LDS_WAIT() asm volatile("s_waitcnt lgkmcnt(0)" ::: "memory")
#define VM_WAIT() asm volatile("s_waitcnt vmcnt(0)" ::: "memory")
__device__ __forceinline__ unsigned cvtpk(float lo, float hi) { unsigned r; asm volatile("v_cvt_pk_bf16_f32 %0, %1, %2" : "=v"(r) : "v"(lo), "v"(hi)); return r; }
__device__ __forceinline__ float bf2f(unsigned short h) { return __uint_as_float(((unsigned)h) << 16); }
__device__ __forceinline__ float wave_sum(float v) {
#pragma unroll
    for (int o = 1; o < 64; o <<= 1) v += __shfl_xor(v, o);
    return v;
}
__device__ __forceinline__ int opaque_tid() { int t = threadIdx.x; asm volatile("" : "+v"(t)); return t; }
__device__ __forceinline__ float fast_exp2(float x) { return __builtin_amdgcn_exp2f(x); }
__device__ __forceinline__ float fast_log2(float x) { return __builtin_amdgcn_logf(x); }
__device__ __forceinline__ float fast_rcp(float x) { return __builtin_amdgcn_rcpf(x); }

namespace pg8 {
#define PG8_LAS __attribute__((address_space(3)))
typedef unsigned short bf16_t;
typedef unsigned u32x4 __attribute__((ext_vector_type(4)));
constexpr int BM = 256, BK = 64, HALF = 128, HTB = HALF * BK * 2, STAGE_BYTES = 8 * HTB, NXCD = 8, WGM = 8;
__host__ __device__ __forceinline__ int lds_byte(int r, int c) { const int st = (r >> 4) * 2 + (c >> 5), rr = r & 15, cc = c & 31, ob = rr * 64 + cc * 2; return st * 1024 + (ob ^ (((ob >> 9) & 1) << 5)); }
__host__ __device__ __forceinline__ void stage_rc(int b, int& R, int& C) { const int st = b / 1024, sb = b % 1024, swz = sb ^ (((sb >> 9) & 1) << 5); R = (st >> 1) * 16 + swz / 64; C = (st & 1) * 32 + (swz % 64) / 2; }
__host__ __device__ __forceinline__ int perm32(int rho) { const int n = rho >> 4, i = rho & 15; return 8 * (i >> 2) + 4 * n + (i & 3); }

struct Unit { int pm, pn, li; const char* A; const char* B; };

struct DenseOrder {
    int nM, nN, nwg, G, c; const char* A; const char* B; size_t tstep;
    __device__ __forceinline__ void init(const void* A_, const void* B_, int M, int N, int K, int G_, int c_) { nM = M / BM; nN = N / BM; nwg = nM * nN; G = G_; c = c_; A = (const char*)A_; B = (const char*)B_; tstep = (size_t)BM * K * 2; }
    __device__ __forceinline__ bool next(int i, Unit& u) const {
        const long L = (long)i * G + c; if (L >= nwg) return false;
        int wgid = (int)L; { const int q = nwg / NXCD, r = nwg % NXCD, xcd = wgid % NXCD, off = wgid / NXCD; wgid = (xcd < r ? xcd * (q + 1) : r * (q + 1) + (xcd - r) * q) + off; }
        const int nig = WGM * nN, gid = wgid / nig, fm = gid * WGM, gsz = (nM - fm) < WGM ? (nM - fm) : WGM;
        u.pm = fm + ((wgid % nig) % gsz); u.pn = (wgid % nig) / gsz; u.li = 0;
        u.A = A + (size_t)u.pm * tstep; u.B = B + (size_t)u.pn * tstep; return true;
    }
};

template <class Epi, class Sched, bool GATHER>
__device__ __forceinline__ void gemm_phase(PG8_LAS unsigned char* lds, const int K, const Sched& S, const Epi& E, const PG8_LAS int* tab) {
    const int tid = opaque_tid(), wid = __builtin_amdgcn_readfirstlane(tid >> 6), lane = tid & 63, wr = wid >> 2, wc = wid & 3, fr = lane & 15, fq = lane >> 4;
    const int nt = K / BK;
    unsigned voffA[2], voffB[2]; int RA[2], CA[2];
#pragma unroll
    for (int i = 0; i < 2; ++i) { int R, C; stage_rc(tid * 16 + i * 8192, R, C); const int Rb = Epi::PERM ? ((R & ~31) + perm32(R & 31)) : R;
        voffA[i] = (unsigned)(R * K + C) * 2u; voffB[i] = (unsigned)(Rb * K + C) * 2u; RA[i] = R; CA[i] = C; }
    const size_t kstep = (size_t)(BK * 2);
    const size_t hstep = (size_t)HALF * K * 2;
    const unsigned ldsw = (unsigned)wid * 1024u;
    const int aoff = lds_byte(wr * 64 + fr, fq * 8), boff = lds_byte(wc * 32 + fr, fq * 8);
    unsigned gA[2][2], gAn[2][2];
#define PG8_SA(b, h) (((b) * 2 + (h)) * HTB)
#define PG8_SB(b, h) ((4 + (b) * 2 + (h)) * HTB)
#define PG8_GL(gptr, ldsoff) __builtin_amdgcn_global_load_lds((const unsigned*)(gptr), (PG8_LAS unsigned*)(lds + (ldsoff)), 16, 0, 0)
#define PG8_STAGE_B(bufoff, gbase) do { _Pragma("unroll") for (int _i = 0; _i < 2; ++_i) PG8_GL((const char*)(gbase) + voffB[_i], (bufoff) + ldsw + _i * 8192); } while (0)
#define PG8_STAGE_A(bufoff, gbase, h, NX) do { _Pragma("unroll") for (int _i = 0; _i < 2; ++_i) { \
        if constexpr (GATHER) { const unsigned _vo = (NX) ? gAn[h][_i] : gA[h][_i]; PG8_GL((const char*)(gbase) + _vo, (bufoff) + ldsw + _i * 8192); } \
        else { PG8_GL((const char*)(gbase) + (size_t)(h) * hstep + voffA[_i], (bufoff) + ldsw + _i * 8192); } } } while (0)
#define PG8_GIDX(dst, li) do { if constexpr (GATHER) { _Pragma("unroll") for (int _h = 0; _h < 2; ++_h) _Pragma("unroll") for (int _i = 0; _i < 2; ++_i) \
        dst[_h][_i] = ((unsigned)tab[(li) * 256 + _h * 128 + RA[_i]] * (unsigned)K + (unsigned)CA[_i]) * 2u; } } while (0)
#define PG8_LDA(dst, b, h) do { _Pragma("unroll") for (int m = 0; m < 4; ++m) _Pragma("unroll") for (int k = 0; k < 2; ++k) dst[m][k] = *(const PG8_LAS bf16x8*)(lds + PG8_SA(b, h) + aoff + m * 2048 + k * 1024); } while (0)
#define PG8_LDB(dst, b, h) do { _Pragma("unroll") for (int n = 0; n < 2; ++n) _Pragma("unroll") for (int k = 0; k < 2; ++k) dst[n][k] = *(const PG8_LAS bf16x8*)(lds + PG8_SB(b, h) + boff + n * 2048 + k * 1024); } while (0)
#define PG8_MMA(ai, bj, At, Bt) do { __builtin_amdgcn_s_setprio(1); _Pragma("unroll") for (int m = 0; m < 4; ++m) _Pragma("unroll") for (int n = 0; n < 2; ++n) _Pragma("unroll") for (int k = 0; k < 2; ++k) \
        acc[ai][bj][m][n] = __builtin_amdgcn_mfma_f32_16x16x32_bf16(Bt[n][k], At[m][k], acc[ai][bj][m][n], 0, 0, 0); __builtin_amdgcn_s_setprio(0); } while (0)
#define PG8_WAIT_V(n) asm volatile("s_waitcnt vmcnt(" #n ")" ::: "memory")
#define PG8_WAIT_L(n) asm volatile("s_waitcnt lgkmcnt(" #n ")" ::: "memory")
#define PG8_BAR __builtin_amdgcn_s_barrier()
#define PG8_SCHED __builtin_amdgcn_sched_barrier(0)
    Unit cur, nxt; int ui = 0;
    if (!S.next(0, cur)) return;
    f32x4 acc[2][2][4][2];
#pragma unroll
    for (int a = 0; a < 2; ++a)
#pragma unroll
        for (int b = 0; b < 2; ++b)
#pragma unroll
            for (int m = 0; m < 4; ++m)
#pragma unroll
                for (int n = 0; n < 2; ++n) acc[a][b][m][n] = (f32x4){0.f, 0.f, 0.f, 0.f};
    bf16x8 At[4][2], B0[2][2], B1[2][2];
    const char* cA = cur.A; const char* cB = cur.B;
    PG8_GIDX(gA, cur.li);
    PG8_STAGE_B(PG8_SB(0, 0), cB); PG8_STAGE_B(PG8_SB(0, 1), cB + hstep); PG8_STAGE_A(PG8_SA(0, 0), cA, 0, false); PG8_STAGE_A(PG8_SA(0, 1), cA, 1, false);
    if (wr == 1) PG8_BAR;
    PG8_WAIT_V(2); PG8_BAR;
    PG8_STAGE_B(PG8_SB(1, 0), cB + kstep); PG8_STAGE_A(PG8_SA(1, 0), cA + kstep, 0, false); PG8_STAGE_B(PG8_SB(1, 1), cB + hstep + kstep);
    PG8_WAIT_V(6); PG8_BAR;
    for (;;) {
        const bool has_next = S.next(ui + 1, nxt);
        const char* nA = has_next ? nxt.A : cA; const char* nB = has_next ? nxt.B : cB;
        if constexpr (GATHER) { if (has_next) { PG8_GIDX(gAn, nxt.li); } else {
#pragma unroll
            for (int _h = 0; _h < 2; ++_h)
#pragma unroll
                for (int _i = 0; _i < 2; ++_i) gAn[_h][_i] = gA[_h][_i]; } }
        for (int t = 0; t < nt; t += 2) {
            const bool last = (t == nt - 2);
            const char* a1 = cA + (size_t)(t + 1) * kstep;
            const char* a2 = last ? nA : cA + (size_t)(t + 2) * kstep; const char* b2 = last ? nB : cB + (size_t)(t + 2) * kstep;
            const char* a3 = a2 + kstep; const char* b3 = b2 + kstep;
            PG8_LDB(B0, 0, 0); PG8_LDB(B1, 0, 1); PG8_SCHED; PG8_LDA(At, 0, 0); PG8_STAGE_A(PG8_SA(1, 1), a1, 1, false);
            PG8_WAIT_V(8); PG8_WAIT_L(0); PG8_BAR; PG8_MMA(0, 0, At, B0); PG8_MMA(0, 1, At, B1); PG8_BAR; PG8_SCHED;
            PG8_LDA(At, 0, 1); PG8_STAGE_B(PG8_SB(0, 0), b2); PG8_STAGE_B(PG8_SB(0, 1), b2 + hstep); PG8_STAGE_A(PG8_SA(0, 0), a2, 0, last);
            PG8_WAIT_V(8); PG8_WAIT_L(0); PG8_BAR; PG8_MMA(1, 0, At, B0); PG8_MMA(1, 1, At, B1); PG8_BAR; PG8_SCHED;
            PG8_LDB(B0, 1, 0); PG8_LDB(B1, 1, 1); PG8_SCHED; PG8_LDA(At, 1, 0); PG8_STAGE_A(PG8_SA(0, 1), a2, 1, last);
            PG8_WAIT_V(8); PG8_WAIT_L(0); PG8_BAR; PG8_MMA(0, 0, At, B0); PG8_MMA(0, 1, At, B1); PG8_BAR; PG8_SCHED;
            PG8_LDA(At, 1, 1); PG8_STAGE_B(PG8_SB(1, 0), b3); PG8_STAGE_B(PG8_SB(1, 1), b3 + hstep); PG8_STAGE_A(PG8_SA(1, 0), a3, 0, last);
            PG8_WAIT_V(8); PG8_WAIT_L(0); PG8_BAR; PG8_MMA(1, 0, At, B0); PG8_MMA(1, 1, At, B1); PG8_BAR; PG8_SCHED;
        }
        if (wr == 0) PG8_BAR;
        E(acc, cur, wr, wc, fr, fq);
        if (!has_next) break;
#pragma unroll
        for (int a = 0; a < 2; ++a)
#pragma unroll
            for (int b = 0; b < 2; ++b)
#pragma unroll
                for (int m = 0; m < 4; ++m)
#pragma unroll
                    for (int n = 0; n < 2; ++n) acc[a][b][m][n] = (f32x4){0.f, 0.f, 0.f, 0.f};
        cur = nxt; cA = nA; cB = nB; ++ui;
        if constexpr (GATHER) {
#pragma unroll
            for (int _h = 0; _h < 2; ++_h)
#pragma unroll
                for (int _i = 0; _i < 2; ++_i) gA[_h][_i] = gAn[_h][_i]; }
        if (wr == 1) PG8_BAR;
    }
    PG8_WAIT_V(0);
    PG8_BAR;
#undef PG8_SA
#undef PG8_SB
#undef PG8_GL
#undef PG8_STAGE_A
#undef PG8_STAGE_B
#undef PG8_GIDX
#undef PG8_LDA
#undef PG8_LDB
#undef PG8_MMA
#undef PG8_WAIT_V
#undef PG8_WAIT_L
#undef PG8_BAR
#undef PG8_SCHED
}

struct EpiProj {
    static constexpr bool PERM = true;
    bf16_t* P; float* SS;
    __device__ __forceinline__ void operator()(const f32x4 (&acc)[2][2][4][2], const Unit& u, int wr, int wc, int fr, int fq) const {
        const int t = u.pn >> 2, colt = (u.pn & 3) * BM;
        bf16_t* base = P + (size_t)t * PROJ_TS;
        const int row0 = u.pm * BM + wr * 64 + fr, col0 = colt + wc * 32 + 8 * fq;
        if (t <= 1) {
#pragma unroll
            for (int ai = 0; ai < 2; ++ai)
#pragma unroll
                for (int m = 0; m < 4; ++m)
#pragma unroll
                    for (int bj = 0; bj < 2; ++bj) {
                        const f32x4 a = acc[ai][bj][m][0], b = acc[ai][bj][m][1];
                        float s = (a[0] * a[0] + a[1] * a[1]) + (a[2] * a[2] + a[3] * a[3]) + (b[0] * b[0] + b[1] * b[1]) + (b[2] * b[2] + b[3] * b[3]);
                        s += __shfl_xor(s, 16); s += __shfl_xor(s, 32);
                        if (fq == 0) SS[(((size_t)t * MROWS + (row0 + ai * HALF + m * 16)) * 8 + ((u.pn & 3) * 2 + bj)) * 4 + wc] = s;
                    }
        }
#pragma unroll
        for (int ai = 0; ai < 2; ++ai)
#pragma unroll
            for (int m = 0; m < 4; ++m) { bf16_t* rowp = base + (size_t)(row0 + ai * HALF + m * 16) * 1024 + col0;
#pragma unroll
                for (int bj = 0; bj < 2; ++bj) { f32x4 v0 = acc[ai][bj][m][0], v1 = acc[ai][bj][m][1];
                    if (t == 3) {
#pragma unroll
                        for (int j = 0; j < 4; ++j) { v0[j] = fast_rcp(1.f + fast_exp2(-v0[j] * LOG2E)); v1[j] = fast_rcp(1.f + fast_exp2(-v1[j] * LOG2E)); } }
                    if (t == 4) { v0 = v0 * QSCALE2; v1 = v1 * QSCALE2; }
                    u32x4 w; w.x = cvtpk(v0[0], v0[1]); w.y = cvtpk(v0[2], v0[3]); w.z = cvtpk(v1[0], v1[1]); w.w = cvtpk(v1[2], v1[3]);
                    *(u32x4*)(rowp + bj * HALF) = w; } }
    }
};
struct EpiOut {
    static constexpr bool PERM = false;
    const float* X; float* O;
    __device__ __forceinline__ void operator()(const f32x4 (&acc)[2][2][4][2], const Unit& u, int wr, int wc, int fr, int fq) const {
        const int row0 = u.pm * BM + wr * 64 + fr, col0 = u.pn * BM + wc * 32 + 4 * fq;
#pragma unroll
        for (int ai = 0; ai < 2; ++ai)
#pragma unroll
            for (int m = 0; m < 4; ++m) { const size_t off = (size_t)(row0 + ai * HALF + m * 16) * DM + col0;
#pragma unroll
                for (int bj = 0; bj < 2; ++bj)
#pragma unroll
                    for (int n = 0; n < 2; ++n) { const f32x4 xv = *(const f32x4*)(X + off + bj * HALF + n * 16); *(f32x4*)(O + off + bj * HALF + n * 16) = xv + acc[ai][bj][m][n]; } }
    }
};
}

namespace moe {
constexpr int MT = 384, BKT = 64, A_BYTES = MT * BKT * 2, B_PITCH = 320, B_BYTES = BKT * B_PITCH;
constexpr int OFF_A = 0, OFF_B = 2 * A_BYTES, STAGE_END = 2 * A_BYTES + 2 * B_BYTES;
typedef short v4i16_t __attribute__((ext_vector_type(4)));
__device__ __forceinline__ void glds16(const void* gsrc, unsigned lds_dst) { unsigned keep;
    asm volatile("s_mov_b32 %0, m0\n\ts_mov_b32 m0, %2\n\ts_nop 0\n\tglobal_load_lds_dwordx4 %1, off\n\ts_mov_b32 m0, %0" : "=&s"(keep) : "v"(gsrc), "s"(lds_dst) : "memory"); }
__device__ __forceinline__ s16x4 vtr(const LAS unsigned char* p) { return __builtin_bit_cast(s16x4, __builtin_amdgcn_ds_read_tr16_b64_v4i16((LAS v4i16_t*)p)); }

struct Order {
    int G, c, ncs; const LAS int* upre; const LAS int* cpre;
    __device__ __forceinline__ bool decode(int i, int& e, int& cs, int& mt, int& cnt, int& cbase) const {
        const int L = i * G + c; if (L >= __builtin_amdgcn_readfirstlane(upre[NE])) return false;
        int lo = 0, hi = NE;
        while (hi - lo > 1) { const int mid = (lo + hi) >> 1; const int v = __builtin_amdgcn_readfirstlane(upre[mid]); if (v <= L) lo = mid; else hi = mid; }
        e = lo; const int u0 = __builtin_amdgcn_readfirstlane(upre[e]), u1 = __builtin_amdgcn_readfirstlane(upre[e + 1]), ntm = (u1 - u0) / ncs, r = L - u0;
        cs = r / ntm; mt = r - cs * ntm; cbase = __builtin_amdgcn_readfirstlane(cpre[e]); cnt = __builtin_amdgcn_readfirstlane(cpre[e + 1]) - cbase; return true;
    }
};

template <int KDIM, bool G1, bool WW>
__device__ __forceinline__ void role_loop(LAS unsigned char* lds, const Order& S, const LAS int* tab, const char* Abase, const float* Wa, const float* Wb, bf16* Out) {
    constexpr int NTK = KDIM / BKT; constexpr int LDB = G1 ? DE : DM;
    const int tid = opaque_tid(), wid = __builtin_amdgcn_readfirstlane(tid >> 6), lane = tid & 63, r32 = lane & 31, hi = lane >> 5, wr = wid >> 1, wc = wid & 1;
    int e, cs, mt, cnt, cbase; if (!S.decode(0, e, cs, mt, cnt, cbase)) return;
    const int wv = wid - 4, tl2 = (wv & 1) * 64 + lane, bk = tl2 >> 4, bc = (wv >> 1) * 64 + (tl2 & 15) * 4;
    const unsigned boffl = (unsigned)(bk * LDB + (tl2 & 15) * 4) * 4u;
    const unsigned bwr = (unsigned)(bk * B_PITCH + bc * 2);
    const unsigned trbv = (unsigned)(uintptr_t)(lds + OFF_B + (8 * hi + ((lane & 15) >> 2)) * B_PITCH + (16 * ((lane >> 4) & 1) + 4 * (lane & 3)) * 2 + wc * 64);
    const unsigned ldsA = (unsigned)(uintptr_t)(lds + OFF_A) + (unsigned)(wid & 3) * 1024u;
    const LAS unsigned char* xa[4];
#pragma unroll
    for (int ks = 0; ks < 4; ++ks) xa[ks] = lds + OFF_A + (32 * wr + r32) * 128 + (((2 * ks + hi) ^ (r32 & 7)) * 16);
#define MOE_BBASE(e_, cs_) ((G1 ? ((wv >> 1) ? Wb : Wa) + (size_t)(e_) * DM * DE + 64 * (cs_) : Wa + (size_t)(e_) * DE * DM + 128 * (cs_) + 64 * (wv >> 1)))
#define MOE_AOFF(dst, ui_, cbase_, mt_) do { if constexpr (!WW) { _Pragma("unroll") for (int q = 0; q < 12; ++q) { const int row = 8 * (4 * q + (wid & 3)) + (lane >> 3); \
        const int arow = G1 ? tab[(ui_) * MT + row] : (cbase_) + MT * (mt_) + row; dst[q] = (unsigned)arow * (unsigned)(KDIM * 2) + (unsigned)(((lane & 7) ^ (row & 7)) * 16); } } } while (0)
    unsigned aoff[12], aoffn[12];
    MOE_AOFF(aoff, 0, cbase, mt);
    const float* bbase = MOE_BBASE(e, cs); const float* bbasen = bbase;
    f32x4 R0[8], R1[8];
    bool has_next = false;
#define MOE_DMA_A(tt, buf) do { if constexpr (!WW) { const bool nx_ = (tt) >= NTK; const int t_ = nx_ ? (has_next ? (tt) - NTK : NTK - 1) : (tt); _Pragma("unroll") for (int q = 0; q < 12; ++q) \
        glds16(Abase + ((nx_ && has_next) ? aoffn[q] : aoff[q]) + (size_t)t_ * (BKT * 2), (unsigned)__builtin_amdgcn_readfirstlane((int)(ldsA + (buf) * A_BYTES + q * 4096))); } } while (0)
#define MOE_LDB(R, tt) do { if constexpr (WW) { const bool nx_ = (tt) >= NTK; const int t_ = nx_ ? (has_next ? (tt) - NTK : NTK - 1) : (tt); const float* bb_ = (nx_ && has_next) ? bbasen : bbase; \
        _Pragma("unroll") for (int i = 0; i < 8; ++i) R[i] = __builtin_nontemporal_load((const f32x4*)((const char*)(bb_ + (size_t)(t_ * BKT + 8 * i) * LDB) + boffl)); } asm volatile("" ::: "memory"); __builtin_amdgcn_sched_barrier(0); } while (0)
#define MOE_WRB(R, buf) do { if constexpr (WW) { asm volatile("s_waitcnt vmcnt(8)" ::: "memory"); _Pragma("unroll") for (int i = 0; i < 8; ++i) *(LAS v2u*)(lds + OFF_B + (buf) * B_BYTES + bwr + i * 8 * B_PITCH) = (v2u){cvtpk(R[i].x, R[i].y), cvtpk(R[i].z, R[i].w)}; } } while (0)
#define MOE_TR4(W0, W1, W2, W3, off) asm volatile("ds_read_b64_tr_b16 %0, %4 offset:%5\n\tds_read_b64_tr_b16 %1, %4 offset:%6\n\tds_read_b64_tr_b16 %2, %4 offset:%7\n\tds_read_b64_tr_b16 %3, %4 offset:%8" \
        : "=&v"(W0), "=&v"(W1), "=&v"(W2), "=&v"(W3) : "v"(trbv), "i"(off), "i"((off) + 4 * B_PITCH), "i"((off) + 128), "i"((off) + 4 * B_PITCH + 128) : "memory")
#define MOE_COMPUTE(buf) do { _Pragma("unroll") for (int ks = 0; ks < 4; ++ks) { \
        s16x4 l0_, h0_, l1_, h1_; bf16x8 xf[3]; \
        MOE_TR4(l0_, h0_, l1_, h1_, (buf) * B_BYTES + ks * 16 * B_PITCH); \
        _Pragma("unroll") for (int j = 0; j < 3; ++j) xf[j] = *(const LAS bf16x8*)(xa[ks] + (buf) * A_BYTES + j * 16384); \
        asm volatile("s_waitcnt lgkmcnt(0)" ::: "memory"); __builtin_amdgcn_sched_barrier(0); \
        const bf16x8 wf0 = (bf16x8){l0_[0], l0_[1], l0_[2], l0_[3], h0_[0], h0_[1], h0_[2], h0_[3]}, wf1 = (bf16x8){l1_[0], l1_[1], l1_[2], l1_[3], h1_[0], h1_[1], h1_[2], h1_[3]}; \
        _Pragma("unroll") for (int j = 0; j < 3; ++j) { acc[j][0] = __builtin_amdgcn_mfma_f32_32x32x16_bf16(wf0, xf[j], acc[j][0], 0, 0, 0); acc[j][1] = __builtin_amdgcn_mfma_f32_32x32x16_bf16(wf1, xf[j], acc[j][1], 0, 0, 0); } } } while (0)
#define MOE_ENDT() do { if constexpr (!WW) asm volatile("s_waitcnt vmcnt(0)" ::: "memory"); LDS_WAIT(); __builtin_amdgcn_s_barrier(); } while (0)
#define MOE_STEP(t, buf, RN) do { MOE_DMA_A((t) + 1, 1 - (buf)); MOE_COMPUTE(buf); MOE_WRB(RN, 1 - (buf)); MOE_LDB(RN, (t) + 3); MOE_ENDT(); } while (0)
    MOE_LDB(R0, 0); MOE_LDB(R1, 1); MOE_DMA_A(0, 0);
    MOE_WRB(R0, 0); MOE_LDB(R0, 2);
    MOE_ENDT();
    for (int ui = 0;; ++ui) {
        int en, csn, mtn, cntn, cbasen; has_next = S.decode(ui + 1, en, csn, mtn, cntn, cbasen);
        if (has_next) { MOE_AOFF(aoffn, ui + 1, cbasen, mtn); bbasen = MOE_BBASE(en, csn); }
        const int rows_valid = cnt - MT * mt;
        f32x16 acc[3][2];
#pragma unroll
        for (int j = 0; j < 3; ++j) { acc[j][0] = f32x16{}; acc[j][1] = f32x16{}; }
        for (int t = 0; t < NTK; t += 2) { MOE_STEP(t, 0, R1); MOE_STEP(t + 1, 1, R0); }
#pragma unroll
        for (int j = 0; j < 3; ++j) { const int row = 32 * (wr + 4 * j) + r32;
            if (row < rows_valid) { const size_t orow = (size_t)(cbase + MT * mt + row);
                if (G1) { bf16* op = Out + orow * DE + 64 * cs + 32 * wc + 4 * hi;
#pragma unroll
                    for (int g = 0; g < 4; ++g) { float h4[4];
#pragma unroll
                        for (int i2 = 0; i2 < 4; ++i2) { const float a = acc[j][0][4 * g + i2], b = acc[j][1][4 * g + i2]; h4[i2] = a * fast_rcp(1.f + fast_exp2(-a * LOG2E)) * b; }
                        *(v2u*)(op + 8 * g) = (v2u){cvtpk(h4[0], h4[1]), cvtpk(h4[2], h4[3])}; } }
                else { const float w = ((const LAS float*)tab)[ui * MT + row]; bf16* op = Out + orow * DM + 128 * cs + 32 * wc + 4 * hi;
#pragma unroll
                    for (int nbi = 0; nbi < 2; ++nbi)
#pragma unroll
                        for (int g = 0; g < 4; ++g) *(v2u*)(op + 64 * nbi + 8 * g) = (v2u){cvtpk(acc[j][nbi][4 * g] * w, acc[j][nbi][4 * g + 1] * w), cvtpk(acc[j][nbi][4 * g + 2] * w, acc[j][nbi][4 * g + 3] * w)}; } } }
        if (!has_next) break;
        e = en; cs = csn; mt = mtn; cnt = cntn; cbase = cbasen; bbase = bbasen;
        if constexpr (!WW) {
#pragma unroll
            for (int q = 0; q < 12; ++q) aoff[q] = aoffn[q]; }
    }
    asm volatile("s_waitcnt vmcnt(0)" ::: "memory");
#undef MOE_BBASE
#undef MOE_AOFF
#undef MOE_DMA_A
#undef MOE_LDB
#undef MOE_WRB
#undef MOE_TR4
#undef MOE_COMPUTE
#undef MOE_ENDT
#undef MOE_STEP
}

template <int KDIM, bool G1>
__device__ __forceinline__ void phase(LAS unsigned char* lds, const Order& S, const LAS int* tab, const char* Abase, const float* Wa, const float* Wb, bf16* Out) {
    __syncthreads();
    if (__builtin_amdgcn_readfirstlane((int)(threadIdx.x >> 6)) >= 4) role_loop<KDIM, G1, true>(lds, S, tab, Abase, Wa, Wb, Out);
    else role_loop<KDIM, G1, false>(lds, S, tab, Abase, Wa, Wb, Out);
    __syncthreads();
}
}

namespace att {
#define KSWZ(row, colB) ((row) * 256 + ((colB) ^ (((row) & 7) << 4)))
#define SBAR() __builtin_amdgcn_sched_barrier(0)
constexpr int SHM_V = 16384, SHM_K = 16384;
constexpr int KS_OFF = 32768, WSF_OFF = 33792, WSF_FLOATS = 1152;
__device__ __forceinline__ int v_st(int k, int c) { const int kk = (k & ~0xC) | ((k & 4) << 1) | ((k & 8) >> 1); return ((kk >> 3) * 4 + (c >> 5)) * 512 + ((kk & 7) * 32 + (c & 31)) * 2; }
__device__ __forceinline__ int v_rd_base(int lane) { return ((lane & 3) << 3) | (((lane >> 2) & 3) << 6) | (((lane >> 4) & 1) << 5) | (((lane >> 5) & 1) << 8); }
constexpr int v_rd_off(int d0, int ks, int half) { return d0 * 512 + ks * 4096 + half * 2048; }
__device__ __forceinline__ int crow(int r, int hi) { return (r & 3) + 8 * (r >> 2) + 4 * hi; }

__device__ __forceinline__ void qkt(f32x16& p0, f32x16& p1, const char* K_lds, int r32, int hi, const bf16x8* qr) {
    p0 = f32x16{}; p1 = f32x16{};
    const char* kb[4];
#pragma unroll
    for (int dd = 0; dd < 4; ++dd) kb[dd] = K_lds + KSWZ(r32, (dd * 16 + hi * 8) * 2);
#pragma unroll
    for (int d0 = 0; d0 < 8; ++d0) { const char* a = kb[d0 & 3] + (d0 >> 2) * 128;
        bf16x8 b0 = *reinterpret_cast<const bf16x8*>(a);
        bf16x8 b1 = *reinterpret_cast<const bf16x8*>(a + 32 * 256);
        p0 = __builtin_amdgcn_mfma_f32_32x32x16_bf16(b0, qr[d0], p0, 0, 0, 0);
        p1 = __builtin_amdgcn_mfma_f32_32x32x16_bf16(b1, qr[d0], p1, 0, 0, 0); }
}
__device__ __forceinline__ void pv_tile(f32x16* o, int vb0, bf16x8 pa0, bf16x8 pa1, bf16x8 pa2, bf16x8 pa3) {
#define TRRD(dst, off) asm volatile("ds_read_b64_tr_b16 %0, %1 offset:%2" : "=&v"(dst) : "v"(vb0), "i"(off) : "memory")
#define PV_D0(d0) do { s16x4 l0, l1, l2, l3, h0, h1, h2, h3; constexpr int b_ = v_rd_off(d0, 0, 0); \
        TRRD(l0, b_); TRRD(h0, b_ + 2048); TRRD(l1, b_ + 4096); TRRD(h1, b_ + 6144); TRRD(l2, b_ + 8192); TRRD(h2, b_ + 10240); TRRD(l3, b_ + 12288); TRRD(h3, b_ + 14336); \
        asm volatile("s_waitcnt lgkmcnt(0)" ::: "memory"); SBAR(); \
        o[d0] = __builtin_amdgcn_mfma_f32_32x32x16_bf16(pa0, (bf16x8){l0[0], l0[1], l0[2], l0[3], h0[0], h0[1], h0[2], h0[3]}, o[d0], 0, 0, 0); \
        o[d0] = __builtin_amdgcn_mfma_f32_32x32x16_bf16(pa1, (bf16x8){l1[0], l1[1], l1[2], l1[3], h1[0], h1[1], h1[2], h1[3]}, o[d0], 0, 0, 0); \
        o[d0] = __builtin_amdgcn_mfma_f32_32x32x16_bf16(pa2, (bf16x8){l2[0], l2[1], l2[2], l2[3], h2[0], h2[1], h2[2], h2[3]}, o[d0], 0, 0, 0); \
        o[d0] = __builtin_amdgcn_mfma_f32_32x32x16_bf16(pa3, (bf16x8){l3[0], l3[1], l3[2], l3[3], h3[0], h3[1], h3[2], h3[3]}, o[d0], 0, 0, 0); } while (0)
    PV_D0(0); PV_D0(1); PV_D0(2); PV_D0(3);
#undef PV_D0
#undef TRRD
}
#define PK4(P, B_, OUT) do { unsigned a0 = cvtpk(P[B_+0], P[B_+1]), a1 = cvtpk(P[B_+2], P[B_+3]); \
        unsigned b0 = cvtpk(P[B_+4], P[B_+5]), b1 = cvtpk(P[B_+6], P[B_+7]); \
        auto r0 = __builtin_amdgcn_permlane32_swap(a0, b0, false, false); auto r1 = __builtin_amdgcn_permlane32_swap(a1, b1, false, false); \
        v4u w = {r0[0], r1[0], r0[1], r1[1]}; OUT = *reinterpret_cast<bf16x8*>(&w); } while (0)

struct Tensors {
    const bf16* QA; const bf16* KA; const bf16* VA; const bf16* GA; const bf16* QB; const bf16* KB; const bf16* VB;
    const float* SS; const float* CUM;
    const float* q_gain; const float* k_gain;
    const float* fox_gain; const float* sb_gain;
    bf16* MIX;
};

template <int TYP>
__device__ __forceinline__ void attn_wave(char* ldsw, const Tensors& T, const int b, const int h, const int f0) {
    const int lane = opaque_tid() & 63, r32 = lane & 31, hi = lane >> 5;
    char* V_lds = ldsw;
    float* ks_rk = (float*)(ldsw + 8192); float* ks_nc = ks_rk + 32;
    float* wsf = (float*)(ldsw + 8192 + 256); float* part = wsf; float* li_l = wsf + 1056; float* rs_l = wsf + 1088;
    const bf16* Qp = TYP == 0 ? T.QA : T.QB; const bf16* Kp = TYP == 0 ? T.KA : T.KB; const bf16* Vp = TYP == 0 ? T.VA : T.VB;
    const int frow0 = b * SEQ + f0;
    const int cbase = (b * NH + h) * CUMLD;
    const int jd = (64 + f0) >> 5;
    bf16x8 qr[8];
#pragma unroll
    for (int d0 = 0; d0 < 8; ++d0) qr[d0] = *reinterpret_cast<const bf16x8*>(Qp + (size_t)(frow0 + r32) * 1024 + h * HD + d0 * 16 + hi * 8);
    float mt2 = 0.f;
    if (TYP == 0) {
        const f32x4 sp = *(const f32x4*)(T.SS + ((size_t)(frow0 + r32) * 8 + h) * 4);
        const float rstd = (1.0f / sqrtf(((sp.x + sp.y) + (sp.z + sp.w)) * (1.f / HD) + EPS)) * QSCALE2;
        float n2 = 0.f;
#pragma unroll
        for (int d0 = 0; d0 < 8; ++d0) { const int db = d0 * 16 + hi * 8;
            const f32x4 ga = *(const f32x4*)(T.q_gain + db), gb = *(const f32x4*)(T.q_gain + db + 4), ka = *(const f32x4*)(T.k_gain + db), kb = *(const f32x4*)(T.k_gain + db + 4);
            const float g8[8] = {ga.x * ka.x, ga.y * ka.y, ga.z * ka.z, ga.w * ka.w, gb.x * kb.x, gb.y * kb.y, gb.z * kb.z, gb.w * kb.w};
            v4u w = *reinterpret_cast<v4u*>(&qr[d0]); unsigned ww[4] = {w.x, w.y, w.z, w.w};
#pragma unroll
            for (int i = 0; i < 4; ++i) { const float lo = __uint_as_float(ww[i] << 16) * rstd * g8[2 * i], hi2 = __uint_as_float(ww[i] & 0xffff0000u) * rstd * g8[2 * i + 1]; n2 += lo * lo + hi2 * hi2; ww[i] = cvtpk(lo, hi2); }
            w = (v4u){ww[0], ww[1], ww[2], ww[3]}; qr[d0] = *reinterpret_cast<bf16x8*>(&w); }
        n2 += __shfl_xor(n2, 32);
        mt2 = sqrtf(n2 * (float)HD);
    }
    const int qp = 64 + f0 + r32;
    float bias_t = 0.f, cum_t = 0.f, Rrun = 0.f, l_reg = 0.f;
    if (TYP == 0) { cum_t = T.CUM[cbase + qp - 48]; bias_t = cum_t - mt2; }
    f32x16 o[4] = {};
    const int vkey = lane >> 4, vcol = (lane & 15) * 8;
    const int vb0 = (int)(uintptr_t)V_lds + v_rd_base(lane);
    for (int j = jd; j >= 1; --j) {
        const int kr0 = (j >= 2) ? b * SEQ + 32 * j - 64 : ROW_META - 16;
        const int krow = (j >= 2 || r32 >= 16) ? kr0 + r32 : ROW_META;
        bf16x8 kf[8], vs[8];
#pragma unroll
        for (int d0 = 0; d0 < 8; ++d0) kf[d0] = *reinterpret_cast<const bf16x8*>(Kp + (size_t)krow * 1024 + h * HD + d0 * 16 + hi * 8);
#pragma unroll
        for (int i = 0; i < 8; ++i) { const int vk = vkey + 4 * i; const int vrow = (j >= 2 || vk >= 16) ? kr0 + vk : ROW_META;
            vs[i] = *reinterpret_cast<const bf16x8*>(Vp + (size_t)vrow * 1024 + h * HD + vcol); }
        float sc = 0.f;
        if (TYP == 0) { const int ki = lane & 31; const int srow = (j >= 2 || ki >= 16) ? kr0 + ki : ROW_META; const int pos = (j >= 2) ? 32 * j - 48 + ki : (ki >= 16 ? ki - 16 : 0);
            if (lane < 32) { const f32x4 sk = *(const f32x4*)(T.SS + (((size_t)MROWS + srow) * 8 + h) * 4); sc = 1.0f / sqrtf(((sk.x + sk.y) + (sk.z + sk.w)) * (1.f / HD) + EPS); }
            else sc = -T.CUM[cbase + pos]; }
#pragma unroll
        for (int i = 0; i < 8; ++i) *(bf16x8*)(V_lds + v_st(vkey + 4 * i, vcol)) = vs[i];
        if (TYP == 0) ks_rk[lane] = sc;
        LDS_WAIT();
        f32x16 p0 = f32x16{};
#pragma unroll
        for (int d0 = 0; d0 < 8; ++d0) p0 = __builtin_amdgcn_mfma_f32_32x32x16_bf16(kf[d0], qr[d0], p0, 0, 0, 0);
        const bool need_mask = (j == jd) || (j == 1);
        const int kp0 = 32 * j + 4 * hi;
        bf16x8 pa0, pa1;
        if (TYP == 0) {
#pragma unroll
            for (int q = 0; q < 4; ++q) { const f32x4 rkv = *(const f32x4*)(ks_rk + 8 * q + 4 * hi), ncv = *(const f32x4*)(ks_nc + 8 * q + 4 * hi);
#pragma unroll
                for (int i = 0; i < 4; ++i) p0[4 * q + i] = fmaf(p0[4 * q + i], rkv[i], ncv[i]) + bias_t; }
            if (need_mask) {
#pragma unroll
                for (int r = 0; r < 16; ++r) { const int kp = kp0 + (r & 3) + 8 * (r >> 2); if (!(kp <= qp && kp >= 48)) p0[r] = -__builtin_inff(); } }
            float ps = 0.f;
#pragma unroll
            for (int r = 0; r < 16; ++r) { p0[r] = fast_exp2(p0[r]); ps += p0[r]; }
            l_reg += ps;
        } else {
            f32x16 k0;
#pragma unroll
            for (int r = 0; r < 16; ++r) { const float z = p0[r], sp = fmaxf(z, 0.f) + fast_log2(1.f + fast_exp2(-fabsf(z))); k0[r] = -sp; p0[r] = z - sp; }
            if (need_mask) {
#pragma unroll
                for (int r = 0; r < 16; ++r) { const int kp = kp0 + (r & 3) + 8 * (r >> 2); if (!(kp < qp && kp >= 48)) { p0[r] = -__builtin_inff(); k0[r] = 0.f; } } }
            float so = 0.f, spi = 0.f;
#pragma unroll
            for (int i = 3; i >= 0; --i) {
                const float g = (k0[4 * i] + k0[4 * i + 1]) + (k0[4 * i + 2] + k0[4 * i + 3]);
                const float spn = spi + __shfl_xor(g, 32);
                const float off = Rrun + so + (hi ? spi : spn);
                const float l3 = off, l2 = l3 + k0[4 * i + 3], l1 = l2 + k0[4 * i + 2], l0 = l1 + k0[4 * i + 1];
                p0[4 * i + 3] = fast_exp2(p0[4 * i + 3] + l3); p0[4 * i + 2] = fast_exp2(p0[4 * i + 2] + l2); p0[4 * i + 1] = fast_exp2(p0[4 * i + 1] + l1); p0[4 * i] = fast_exp2(p0[4 * i] + l0);
                so += g; spi = spn;
            }
            Rrun += so + spi;
        }
        PK4(p0, 0, pa0); PK4(p0, 8, pa1);
        {
#define TRRD(dst, off) asm volatile("ds_read_b64_tr_b16 %0, %1 offset:%2" : "=&v"(dst) : "v"(vb0), "i"(off) : "memory")
#define PV_D0(d0) do { s16x4 l0, l1, h0, h1; constexpr int b_ = v_rd_off(d0, 0, 0); \
            TRRD(l0, b_); TRRD(h0, b_ + 2048); TRRD(l1, b_ + 4096); TRRD(h1, b_ + 6144); \
            asm volatile("s_waitcnt lgkmcnt(0)" ::: "memory"); SBAR(); \
            o[d0] = __builtin_amdgcn_mfma_f32_32x32x16_bf16(pa0, (bf16x8){l0[0], l0[1], l0[2], l0[3], h0[0], h0[1], h0[2], h0[3]}, o[d0], 0, 0, 0); \
            o[d0] = __builtin_amdgcn_mfma_f32_32x32x16_bf16(pa1, (bf16x8){l1[0], l1[1], l1[2], l1[3], h1[0], h1[1], h1[2], h1[3]}, o[d0], 0, 0, 0); } while (0)
            PV_D0(0); PV_D0(1); PV_D0(2); PV_D0(3);
#undef PV_D0
#undef TRRD
        }
        if (j > 1) { bool conv;
            if (TYP == 0) { const float lt = l_reg + __shfl_xor(l_reg, 32); conv = (cum_t + ks_nc[0]) <= fast_log2(lt) - 41.f; }
            else conv = Rrun <= -30.f;
            if (__all(conv)) break; }
    }
    int lane_e = lane, frow_e = frow0;
    asm volatile("" : "+v"(lane_e), "+s"(frow_e));
    const int r32e = lane_e & 31, hie = lane_e >> 5;
    if (TYP == 0) {
        l_reg += __shfl_xor(l_reg, 32);
        if (hie == 0) li_l[r32e] = fast_rcp(l_reg);
        LDS_WAIT();
#pragma unroll
        for (int r = 0; r < 16; ++r) { const float il = li_l[crow(r, hie)];
#pragma unroll
            for (int d0 = 0; d0 < 4; ++d0) o[d0][r] *= il; }
    }
#pragma unroll
    for (int r = 0; r < 16; ++r) { float s = 0.f;
#pragma unroll
        for (int d0 = 0; d0 < 4; ++d0) s += o[d0][r] * o[d0][r];
        part[crow(r, hie) * 33 + r32e] = s; }
    LDS_WAIT();
    { float s = 0.f;
#pragma unroll
      for (int c = 0; c < 16; ++c) s += part[r32e * 33 + hie * 16 + c];
      s += __shfl_xor(s, 32);
      if (hie == 0) rs_l[r32e] = 1.0f / sqrtf(s * (1.f / HD) + EPS); }
    LDS_WAIT();
    const float* gain = (TYP == 0 ? T.fox_gain : T.sb_gain) + h * HD;
    float gn[4];
#pragma unroll
    for (int d0 = 0; d0 < 4; ++d0) gn[d0] = gain[d0 * 32 + r32e];
    unsigned short* stg = (unsigned short*)V_lds;
    if (TYP == 0) {
#pragma unroll
        for (int i = 0; i < 8; ++i) { const int c = lane_e + 64 * i, row = c >> 4, ch = c & 15;
            *(v4u*)(stg + row * 128 + ch * 8) = *(const v4u*)(T.GA + (size_t)(frow_e + row) * 1024 + h * HD + ch * 8); }
        LDS_WAIT();
#pragma unroll
        for (int r = 0; r < 16; ++r) { const int orow = crow(r, hie);
#pragma unroll
            for (int d0 = 0; d0 < 4; ++d0) o[d0][r] *= bf2f(stg[orow * 128 + d0 * 32 + r32e]); }
        LDS_WAIT();
    }
#pragma unroll
    for (int r = 0; r < 16; ++r) { const int orow = crow(r, hie); const float rs = rs_l[orow];
#pragma unroll
        for (int d0 = 0; d0 < 4; ++d0) { const float v = o[d0][r] * rs * gn[d0]; const float vn = __shfl_xor(v, 1);
            if ((r32e & 1) == 0) *(unsigned*)(stg + orow * 128 + d0 * 32 + r32e) = cvtpk(v, vn); } }
    LDS_WAIT();
#pragma unroll
    for (int i = 0; i < 8; ++i) { const int c = lane_e + 64 * i, row = c >> 4, ch = c & 15;
        *(v4u*)(T.MIX + (size_t)(frow_e + row) * DM + TYP * 1024 + h * HD + ch * 8) = *(const v4u*)(stg + row * 128 + ch * 8); }
    LDS_WAIT();
}
#undef PK4
#undef SBAR
#undef KSWZ
}

struct Frame {
    LAS unsigned char* lds; char* ldsg;
    volatile LAS unsigned* MISC;
    gu32* ctl;
    int tid, lane, wave, vcu, G;
    unsigned char* ws;
    const float *x, *meta, *g1, *w_in, *b_f, *q_gain, *k_gain, *fox_gain, *sb_gain, *w_out, *g2, *w_coarse, *b_coarse, *w_fine, *b_fine, *w1, *w3, *w2;
    float* out;
};

__device__ __forceinline__ void transpose_item(const float* W, size_t ldw, int k0, int n0, bf16* WT, size_t Kd, size_t drow0, LAS float* scr, int lane) {
    { const int r = lane >> 4, c4 = (lane & 15) * 4; const float* src = W + (size_t)(k0 + r) * ldw + n0 + c4; LAS float* dst = scr + r * 65 + c4;
#pragma unroll
      for (int hlf = 0; hlf < 2; ++hlf) { f32x4 v[8];
#pragma unroll
          for (int i = 0; i < 8; ++i) v[i] = *(const f32x4*)(src + (size_t)(4 * (8 * hlf + i)) * ldw);
#pragma unroll
          for (int i = 0; i < 8; ++i) { LAS float* d = dst + 4 * (8 * hlf + i) * 65; d[0] = v[i].x; d[1] = v[i].y; d[2] = v[i].z; d[3] = v[i].w; } } }
    LDS_WAIT(); asm volatile("" ::: "memory");
    const int c = lane & 7;
#pragma unroll
    for (int j = 0; j < 8; ++j) { const int n = (lane >> 3) + 8 * j; const LAS float* s = scr + (8 * c) * 65 + n;
        v4u o; o.x = cvtpk(s[0 * 65], s[1 * 65]); o.y = cvtpk(s[2 * 65], s[3 * 65]); o.z = cvtpk(s[4 * 65], s[5 * 65]); o.w = cvtpk(s[6 * 65], s[7 * 65]);
        *(GAS v4u*)(WT + (drow0 + n) * Kd + k0 + 8 * c) = o; }
    LDS_WAIT(); asm volatile("" ::: "memory");
}

__device__ __forceinline__ void p0_prologue(Frame& F) {
    const int gw = F.vcu * 8 + F.wave, NGW = F.G * 8;
    LAS float* wf = (LAS float*)F.lds;
    for (int e = F.tid; e < 8 * DM; e += 512) { const int k = e >> 3, jj = e & 7; wf[jj * DM + k] = F.w_in[(size_t)k * LDW_IN + NPROJ + jj]; }
    __syncthreads();
    bf16* U1 = (bf16*)(F.ws + WS_U1); float* Fp = (float*)(F.ws + WS_F);
    for (int m = gw; m < MROWS; m += NGW) {
        GAS v2u* o8 = (GAS v2u*)(U1 + (size_t)m * DM) + F.lane;
        if (m >= NKEYROWS) {
#pragma unroll
            for (int j = 0; j < 8; ++j) o8[64 * j] = (v2u){0u, 0u};
            continue; }
        const float* xrow = m < TF ? F.x + (size_t)m * DM : F.meta + (size_t)(m - TF) * DM;
        const GAS f32x4* xr = (const GAS f32x4*)xrow + F.lane;
        f32x4 v[8]; float s = 0.f;
#pragma unroll
        for (int j = 0; j < 8; ++j) { v[j] = xr[64 * j]; s += (v[j].x * v[j].x + v[j].y * v[j].y) + (v[j].z * v[j].z + v[j].w * v[j].w); }
        const float rstd = 1.0f / sqrtf(wave_sum(s) * (1.f / DM) + EPS);
        float fa[8] = {0.f, 0.f, 0.f, 0.f, 0.f, 0.f, 0.f, 0.f};
#pragma unroll
        for (int j = 0; j < 8; ++j) { const f32x4 g = *((const GAS f32x4*)F.g1 + F.lane + 64 * j); v[j] = v[j] * rstd * g;
            o8[64 * j] = (v2u){cvtpk(v[j].x, v[j].y), cvtpk(v[j].z, v[j].w)};
#pragma unroll
            for (int jj = 0; jj < 8; ++jj) { const f32x4 w = *(const LAS f32x4*)(wf + jj * DM + 256 * j + 4 * F.lane); fa[jj] += (v[j].x * w.x + v[j].y * w.y) + (v[j].z * w.z + v[j].w * w.w); } }
#pragma unroll
        for (int jj = 0; jj < 8; ++jj) fa[jj] = wave_sum(fa[jj]);
        if (F.lane == 0) {
#pragma unroll
            for (int jj = 0; jj < 8; ++jj) Fp[(size_t)m * 8 + jj] = fa[jj]; }
    }
    { bf16* U2 = (bf16*)(F.ws + WS_U2);
      for (int m = TF + gw; m < MROWS; m += NGW) { GAS v2u* o8 = (GAS v2u*)(U2 + (size_t)m * DM) + F.lane;
#pragma unroll
          for (int j = 0; j < 8; ++j) o8[64 * j] = (v2u){0u, 0u}; } }
    { bf16* HID = (bf16*)(F.ws + WS_HID);
      for (int m = NASSIGN + gw; m < NASSIGN + 384; m += NGW) { GAS v2u* o8 = (GAS v2u*)(HID + (size_t)m * DE) + F.lane; o8[0] = (v2u){0u, 0u}; o8[64] = (v2u){0u, 0u}; } }
    { v4u* RB = (v4u*)(F.ws + WS_RB);
      for (int it = gw * 64 + F.lane; it < 64 * 5 * 64; it += NGW * 64) { const int ln = it & 63, kc = it >> 6, ks = kc / 5, cb = kc % 5, col = 16 * cb + (ln & 15), k0 = 32 * ks + 8 * (ln >> 4);
          float w[8], lo[8]; unsigned hb[4], lb[4];
#pragma unroll
          for (int i = 0; i < 8; ++i) { w[i] = col < 8 ? F.w_coarse[(size_t)(k0 + i) * 8 + col] : (col < 72 ? F.w_fine[(size_t)(k0 + i) * 64 + col - 8] : 0.f); }
#pragma unroll
          for (int i = 0; i < 4; ++i) { hb[i] = cvtpk(w[2 * i], w[2 * i + 1]); lo[2 * i] = w[2 * i] - __uint_as_float(hb[i] << 16); lo[2 * i + 1] = w[2 * i + 1] - __uint_as_float(hb[i] & 0xffff0000u); lb[i] = cvtpk(lo[2 * i], lo[2 * i + 1]); }
          RB[(size_t)(kc * 2 + 0) * 64 + ln] = (v4u){hb[0], hb[1], hb[2], hb[3]}; RB[(size_t)(kc * 2 + 1) * 64 + ln] = (v4u){lb[0], lb[1], lb[2], lb[3]}; } }
    __syncthreads();
    LAS float* scr = (LAS float*)(F.lds + F.wave * 16640);
    bf16* WinT = (bf16*)(F.ws + WS_WIN_T);
    constexpr int I_IN = (DM / 64) * (NPROJ / 64);
    for (int it = gw; it < I_IN; it += NGW) { const int kb = it / (NPROJ / 64), nb = it % (NPROJ / 64); transpose_item(F.w_in, LDW_IN, kb * 64, nb * 64, WinT, DM, nb * 64, scr, F.lane); }
}
__device__ __forceinline__ void wout_transpose(Frame& F, int idx, int nl) {
    LAS float* scr = (LAS float*)(F.lds + F.wave * 16640); bf16* WoutT = (bf16*)(F.ws + WS_WOUT_T);
    constexpr int I_OUT = (DM / 64) * (DM / 64);
    for (int it = idx * 8 + F.wave; it < I_OUT; it += nl * 8) { const int kb = it / (DM / 64), nb = it % (DM / 64); transpose_item(F.w_out, DM, kb * 64, nb * 64, WoutT, DM, nb * 64, scr, F.lane); }
}

__device__ __forceinline__ void cum_scan(Frame& F, int bh) {
    const float* Fp = (const float*)(F.ws + WS_F); float* CUM = (float*)(F.ws + WS_CUM);
    const int b = bh >> 3, h = bh & 7; const float bf = F.b_f[h]; float carry = 0.f;
    for (int c0 = 0; c0 < LPOS; c0 += 64) { const int pos = c0 + F.lane; float v = 0.f;
        if (pos < LPOS) { const int row = pos < NMETA ? ROW_META + pos : b * SEQ + pos - NMETA; const float xv = Fp[(size_t)row * 8 + h] + bf;
            v = (fminf(xv, 0.f) - log1pf(expf(-fabsf(xv)))) * LOG2E; }
#pragma unroll
        for (int o = 1; o < 64; o <<= 1) { const float t = __shfl_up(v, o); if (F.lane >= o) v += t; }
        v += carry;
        if (pos < LPOS) CUM[(size_t)bh * CUMLD + pos] = v;
        carry = __shfl(v, 63); }
}

__device__ __forceinline__ void p5_router(Frame& F) {
    const int ntask = TF / 16;
    const float* H1 = F.out; bf16* U2 = (bf16*)(F.ws + WS_U2); const v4u* RB = (const v4u*)(F.ws + WS_RB);
    int* RE = (int*)(F.ws + WS_ROUTE); int* RP = RE + TF * 2; float* RW = (float*)(RP + TF * 2); int* TOK = (int*)(F.ws + WS_TOK);
    const int tid = opaque_tid(), lane = tid & 63, wave = __builtin_amdgcn_readfirstlane(tid >> 6), tk = wave >> 2, kp = wave & 3;
    LAS float* pacc = (LAS float*)F.lds;
    LAS float* ssp = (LAS float*)(F.lds + 40960);
    LAS float* lg = (LAS float*)(F.lds + 41472) + tk * 16 * 88;
    const int i = lane & 15, kq = lane >> 4;
    for (int base = 0; base < ntask; base += 2 * F.G) {
        const int task = base + 2 * (int)blockIdx.x + tk; const bool live = task < ntask;
        const int row0 = (live ? task : 0) * 16; const float* hrow = H1 + (size_t)(row0 + i) * DM + 8 * kq + 512 * kp;
        float ss = 0.f;
#pragma unroll 8
        for (int ks = 0; ks < 16; ++ks) { const f32x4 a = *(const f32x4*)(hrow + 32 * ks), b = *(const f32x4*)(hrow + 32 * ks + 4);
            ss += (a.x * a.x + a.y * a.y) + (a.z * a.z + a.w * a.w) + (b.x * b.x + b.y * b.y) + (b.z * b.z + b.w * b.w); }
        ss += __shfl_xor(ss, 16); ss += __shfl_xor(ss, 32);
        if (lane < 16) ssp[wave * 16 + i] = ss;
        __syncthreads();
        const float rstd = 1.0f / sqrtf(((ssp[(4 * tk) * 16 + i] + ssp[(4 * tk + 1) * 16 + i]) + (ssp[(4 * tk + 2) * 16 + i] + ssp[(4 * tk + 3) * 16 + i])) * (1.f / DM) + EPS);
        f32x4 acc[5];
#pragma unroll
        for (int cb = 0; cb < 5; ++cb) acc[cb] = (f32x4){0.f, 0.f, 0.f, 0.f};
#pragma unroll 2
        for (int ks = 0; ks < 16; ++ks) { const int kg = 16 * kp + ks;
            const f32x4 a = *(const f32x4*)(hrow + 32 * ks), b = *(const f32x4*)(hrow + 32 * ks + 4);
            const f32x4 ga = *(const f32x4*)(F.g2 + 32 * kg + 8 * kq), gb = *(const f32x4*)(F.g2 + 32 * kg + 8 * kq + 4);
            float u[8] = {a.x * rstd * ga.x, a.y * rstd * ga.y, a.z * rstd * ga.z, a.w * rstd * ga.w, b.x * rstd * gb.x, b.y * rstd * gb.y, b.z * rstd * gb.z, b.w * rstd * gb.w};
            unsigned hb[4], lb[4];
#pragma unroll
            for (int q = 0; q < 4; ++q) { hb[q] = cvtpk(u[2 * q], u[2 * q + 1]); lb[q] = cvtpk(u[2 * q] - __uint_as_float(hb[q] << 16), u[2 * q + 1] - __uint_as_float(hb[q] & 0xffff0000u)); }
            v4u hv = {hb[0], hb[1], hb[2], hb[3]}, lv = {lb[0], lb[1], lb[2], lb[3]};
            if (live) *(v4u*)(U2 + (size_t)(row0 + i) * DM + 32 * kg + 8 * kq) = hv;
            const bf16x8 Ah = *reinterpret_cast<bf16x8*>(&hv), Al = *reinterpret_cast<bf16x8*>(&lv);
#pragma unroll
            for (int cb = 0; cb < 5; ++cb) { v4u bh = RB[(size_t)((kg * 5 + cb) * 2 + 0) * 64 + lane], bl = RB[(size_t)((kg * 5 + cb) * 2 + 1) * 64 + lane];
                const bf16x8 Bh = *reinterpret_cast<bf16x8*>(&bh), Bl = *reinterpret_cast<bf16x8*>(&bl);
                acc[cb] = __builtin_amdgcn_mfma_f32_16x16x32_bf16(Ah, Bh, acc[cb], 0, 0, 0);
                acc[cb] = __builtin_amdgcn_mfma_f32_16x16x32_bf16(Ah, Bl, acc[cb], 0, 0, 0);
                acc[cb] = __builtin_amdgcn_mfma_f32_16x16x32_bf16(Al, Bh, acc[cb], 0, 0, 0); }
        }
#pragma unroll
        for (int cb = 0; cb < 5; ++cb)
#pragma unroll
            for (int j = 0; j < 4; ++j) pacc[(wave * 16 + 4 * kq + j) * 80 + 16 * cb + i] = acc[cb][j];
        __syncthreads();
        if (kp == 0) {
#pragma unroll
            for (int m = 0; m < 20; ++m) { const int idx = lane + 64 * m, r = idx / 80, c = idx - r * 80;
                lg[r * 88 + c] = (pacc[((4 * tk) * 16 + r) * 80 + c] + pacc[((4 * tk + 1) * 16 + r) * 80 + c]) + (pacc[((4 * tk + 2) * 16 + r) * 80 + c] + pacc[((4 * tk + 3) * 16 + r) * 80 + c]); }
            LDS_WAIT(); asm volatile("" ::: "memory");
            if (lane < 16 && live) { const LAS float* L = lg + lane * 88; const int row = row0 + lane;
                float cmax = L[0] + F.b_coarse[0]; int gs = 0; float cv[8]; cv[0] = cmax;
#pragma unroll
                for (int g = 1; g < 8; ++g) { cv[g] = L[g] + F.b_coarse[g]; if (cv[g] > cmax) { cmax = cv[g]; gs = g; } }
                float den = 0.f;
#pragma unroll
                for (int g = 0; g < 8; ++g) den += expf(cv[g] - cmax);
                const float ggate = 1.0f / den;
                float f1 = -__builtin_inff(), f2 = -__builtin_inff(); int i1 = 0, i2 = 0;
#pragma unroll
                for (int jx = 0; jx < 8; ++jx) { const float fv = L[8 + gs * 8 + jx] + F.b_fine[gs * 8 + jx];
                    if (fv > f1) { f2 = f1; i2 = i1; f1 = fv; i1 = jx; } else if (fv > f2) { f2 = fv; i2 = jx; } }
                const float e2 = expf(f2 - f1), w1 = ggate / (1.f + e2), w2 = ggate * e2 / (1.f + e2);
                const int ea = gs * 8 + i1, eb = gs * 8 + i2;
                const int pa = (int)__hip_atomic_fetch_add(F.ctl + CW_CNT + 64 * ea, 1u, RLX_AGENT), pb = (int)__hip_atomic_fetch_add(F.ctl + CW_CNT + 64 * eb, 1u, RLX_AGENT);
                TOK[(size_t)ea * TOKLD + pa] = row * 2; TOK[(size_t)eb * TOKLD + pb] = row * 2 + 1;
                RE[row * 2] = ea; RE[row * 2 + 1] = eb; RP[row * 2] = pa; RP[row * 2 + 1] = pb; RW[row * 2] = w1; RW[row * 2 + 1] = w2; }
        }
        __syncthreads();
    }
}

__device__ __forceinline__ void moe_prefix(Frame& F, int ncs) {
    LAS int* upre = (LAS int*)(F.lds + TPRE_OFF); LAS int* cpre = upre + 80;
    if (F.tid < 64) { const int c = (int)__hip_atomic_load(F.ctl + CW_CNT + 64 * F.tid, RLX_AGENT); int u = ((c + 383) / 384) * ncs, v = c;
#pragma unroll
        for (int o = 1; o < 64; o <<= 1) { const int y = __shfl_up(u, o), z = __shfl_up(v, o); if (F.lane >= o) { u += y; v += z; } }
        upre[F.tid + 1] = u; cpre[F.tid + 1] = v; if (F.tid == 0) { upre[0] = 0; cpre[0] = 0; } }
    __syncthreads();
}

__device__ __forceinline__ void p8_combine(Frame& F) {
    const LAS int* cpre = (const LAS int*)(F.lds + TPRE_OFF) + 80;
    const int* RE = (const int*)(F.ws + WS_ROUTE); const int* RP = RE + TF * 2; const bf16* Y = (const bf16*)(F.ws + WS_Y);
    for (int m = F.vcu * 8 + F.wave; m < TF; m += F.G * 8) {
        const int e0 = RE[m * 2], e1 = RE[m * 2 + 1], p0 = RP[m * 2], p1 = RP[m * 2 + 1];
        const size_t s0 = (size_t)(cpre[e0] + p0), s1 = (size_t)(cpre[e1] + p1);
        GAS f32x4* op = (GAS f32x4*)(F.out + (size_t)m * DM) + 2 * F.lane;
        const GAS v4u* y0 = (const GAS v4u*)(Y + s0 * DM) + F.lane; const GAS v4u* y1 = (const GAS v4u*)(Y + s1 * DM) + F.lane;
#pragma unroll
        for (int j = 0; j < 4; ++j) { f32x4 a = op[128 * j], b = op[128 * j + 1]; const v4u u0 = y0[64 * j], u1 = y1[64 * j];
            a.x += __uint_as_float(u0.x << 16) + __uint_as_float(u1.x << 16); a.y += __uint_as_float(u0.x & 0xffff0000u) + __uint_as_float(u1.x & 0xffff0000u);
            a.z += __uint_as_float(u0.y << 16) + __uint_as_float(u1.y << 16); a.w += __uint_as_float(u0.y & 0xffff0000u) + __uint_as_float(u1.y & 0xffff0000u);
            b.x += __uint_as_float(u0.z << 16) + __uint_as_float(u1.z << 16); b.y += __uint_as_float(u0.z & 0xffff0000u) + __uint_as_float(u1.z & 0xffff0000u);
            b.z += __uint_as_float(u0.w << 16) + __uint_as_float(u1.w << 16); b.w += __uint_as_float(u0.w & 0xffff0000u) + __uint_as_float(u1.w & 0xffff0000u);
            op[128 * j] = a; op[128 * j + 1] = b; }
    }
}

#define XB_TMO      128
#define XB_XCNT(j)  (256  + 64 * (j))
#define XB_XSUB(j)  (1280 + 64 * (j))
#define XB_XGEN(j)  (2304 + 64 * (j))
#define XB_TOP      3328
#define XB_TOPGEN   3392
#define XCD_BAR_WORDS 3456
#define XB_SPIN_CAP (1u << 18)

__device__ __forceinline__ unsigned xb_ld(unsigned* p)              { return __hip_atomic_load(p, __ATOMIC_RELAXED, __HIP_MEMORY_SCOPE_AGENT); }
__device__ __forceinline__ unsigned xb_add(unsigned* p, unsigned v) { return __hip_atomic_fetch_add(p, v, __ATOMIC_RELAXED, __HIP_MEMORY_SCOPE_AGENT); }
__device__ __forceinline__ unsigned xb_xcc_id() { return (unsigned)__builtin_amdgcn_s_getreg((3 << 11) | 20) & 0xFu; }
#define XB_SPIN(cond, bar) do { unsigned _sp = 0; while (cond) { __builtin_amdgcn_s_sleep(1); \
    if ((++_sp & 255u) == 0u) { if (xb_ld(&(bar)[XB_TMO])) break; if (_sp > XB_SPIN_CAP) { atomicAdd(&(bar)[XB_TMO], 1u); break; } } } } while (0)

struct XcdBarrier {
    unsigned* bar; unsigned x;
    volatile LAS unsigned* st;
};

__device__ __forceinline__ XcdBarrier xcd_barrier_post(unsigned* bar, volatile LAS unsigned* st) {
    XcdBarrier b; b.bar = bar; b.x = xb_xcc_id(); b.st = st;
    if (threadIdx.x == 0) (void)xb_add(&bar[XB_XCNT(b.x)], 1u);
    return b;
}
__device__ __forceinline__ void xcd_barrier_complete(unsigned* bar, unsigned x, unsigned& nloc, unsigned& nx) {
    const unsigned G = gridDim.x * gridDim.y * gridDim.z;
    unsigned sum, cnt, mine, sp = 0u;
    for (;;) {
        sum = 0u; cnt = 0u; mine = 0u;
#pragma unroll
        for (unsigned j = 0; j < 16; ++j) { const unsigned c = xb_ld(&bar[XB_XCNT(j)]); sum += c; cnt += (c > 0u) ? 1u : 0u; mine = (j == x) ? c : mine; }
        if (sum == G) break;
        __builtin_amdgcn_s_sleep(1);
        if ((++sp & 255u) == 0u) { if (xb_ld(&bar[XB_TMO])) break; if (sp > XB_SPIN_CAP) { atomicAdd(&bar[XB_TMO], 1u); break; } }
    }
    nloc = mine > 0u ? mine : 1u; nx = cnt > 0u ? cnt : 1u;
}

__device__ __forceinline__ void xcd_barrier(const XcdBarrier& b) {
    asm volatile("s_waitcnt vmcnt(0)" ::: "memory");
    __syncthreads();
    if (threadIdx.x == 0) {
        unsigned* bar = b.bar;
        __builtin_amdgcn_s_waitcnt(0);
        unsigned nloc = b.st[0], nx = b.st[1];
        if (nloc == 0u) { xcd_barrier_complete(bar, b.x, nloc, nx); b.st[0] = nloc; b.st[1] = nx; }
        const unsigned old = xb_add(&bar[XB_XSUB(b.x)], 1u);
        const unsigned gen = old / nloc;
        if (old + 1u == (gen + 1u) * nloc) {
            __builtin_amdgcn_fence(__ATOMIC_RELEASE, "agent");
            asm volatile("s_waitcnt vmcnt(0)" ::: "memory");
            const unsigned og = xb_add(&bar[XB_TOP], 1u);
            const unsigned tg = og / nx;
            if (og + 1u == (tg + 1u) * nx) xb_add(&bar[XB_TOPGEN], 1u);
            else XB_SPIN(xb_ld(&bar[XB_TOPGEN]) == tg, bar);
            __builtin_amdgcn_fence(__ATOMIC_ACQUIRE, "agent");
            xb_add(&bar[XB_XGEN(b.x)], 1u);
            asm volatile("s_waitcnt vmcnt(0)" ::: "memory");
        } else {
            XB_SPIN(xb_ld(&bar[XB_XGEN(b.x)]) == gen, bar);
            __builtin_amdgcn_fence(__ATOMIC_ACQUIRE, "agent");
            asm volatile("s_waitcnt vmcnt(0)" ::: "memory");
        }
    }
    __syncthreads();
}

struct Args { const float* in[18]; float* out; unsigned char* ws; int ph_lo, ph_hi; };
__global__ void __launch_bounds__(512, 2) fwd(Args args) {
    extern __shared__ __attribute__((aligned(16))) unsigned char lds[];
    Frame F;
    F.lds = (LAS unsigned char*)lds; F.ldsg = (char*)lds;
    F.MISC = (volatile LAS unsigned*)(F.lds + MISC_OFF);
    F.tid = threadIdx.x; F.lane = F.tid & 63; F.wave = __builtin_amdgcn_readfirstlane(F.tid >> 6);
    F.G = gridDim.x; { const int bx = blockIdx.x; F.vcu = (F.G % 8 == 0) ? (bx % 8) * (F.G / 8) + bx / 8 : bx; }
    F.ws = args.ws; F.ctl = (gu32*)(args.ws + WS_CTL); F.out = args.out;
    F.x = args.in[0]; F.meta = args.in[1]; F.g1 = args.in[2]; F.w_in = args.in[3]; F.b_f = args.in[4]; F.q_gain = args.in[5]; F.k_gain = args.in[6];
    F.fox_gain = args.in[7]; F.sb_gain = args.in[8]; F.w_out = args.in[9]; F.g2 = args.in[10]; F.w_coarse = args.in[11]; F.b_coarse = args.in[12];
    F.w_fine = args.in[13]; F.b_fine = args.in[14]; F.w1 = args.in[15]; F.w3 = args.in[16]; F.w2 = args.in[17];
    for (int u = F.tid; u < 32; u += 512) F.MISC[u] = 0u;
    __syncthreads();
    const int lo = args.ph_lo, hi = args.ph_hi;
    XcdBarrier bar; bar.bar = (unsigned*)(F.ctl + CW_BAR); bar.x = 0; bar.st = nullptr;
    if (hi - lo > 1) bar = xcd_barrier_post((unsigned*)(F.ctl + CW_BAR), F.MISC + 8);
#define IN(k) (lo <= (k) && (k) < hi)
#define SEAM(k) do { if (IN(k) && IN((k) + 1)) xcd_barrier(bar); } while (0)
    bf16* PROJ = (bf16*)(F.ws + WS_PROJ);


    if (IN(0)) { p0_prologue(F); if (REP_PHASE == 0) { __syncthreads(); p0_prologue(F); } SEAM(0); }

    if (IN(1)) {
        { const int bh = (int)blockIdx.x - (F.G - NB * NH); if (bh >= 0 && F.wave == 0) cum_scan(F, bh); }
        pg8::DenseOrder S; S.init(F.ws + WS_U1, F.ws + WS_WIN_T, MROWS, NPROJ, DM, F.G, (int)blockIdx.x);
        pg8::EpiProj E{PROJ, (float*)(F.ws + WS_SS)};
        pg8::gemm_phase<pg8::EpiProj, pg8::DenseOrder, false>(F.lds, DM, S, E, nullptr);
        { const int rem = S.nwg % F.G, nl = F.G - rem, idx = (int)blockIdx.x - rem; if (rem == 0) wout_transpose(F, (int)blockIdx.x, F.G); else if (idx >= 0) wout_transpose(F, idx, nl); }
        if (REP_PHASE == 1) pg8::gemm_phase<pg8::EpiProj, pg8::DenseOrder, false>(F.lds, DM, S, E, nullptr);
        if (IN(1) && IN(3)) xcd_barrier(bar);
    }

    if (IN(3)) {
        att::Tensors T{PROJ, PROJ + PROJ_TS, PROJ + 2 * PROJ_TS, PROJ + 3 * PROJ_TS, PROJ + 4 * PROJ_TS, PROJ + 5 * PROJ_TS, PROJ + 6 * PROJ_TS,
                       (const float*)(F.ws + WS_SS), (const float*)(F.ws + WS_CUM), F.q_gain, F.k_gain, F.fox_gain, F.sb_gain, (bf16*)(F.ws + WS_MIX)};
        for (int rep = 0; rep < ((REP_PHASE == 3 || REP_PHASE == 31 || REP_PHASE == 32) ? 2 : 1); ++rep)
        for (int w = F.vcu; w < 256; w += F.G) { const int bh = w >> 3, s = w & 7;
            if (REP_PHASE != 32 || rep == 0) att::attn_wave<0>(F.ldsg + F.wave * 16384, T, bh >> 3, bh & 7, s * 256 + F.wave * 32);
            if (REP_PHASE != 31 || rep == 0) att::attn_wave<1>(F.ldsg + F.wave * 16384, T, bh >> 3, bh & 7, (7 - s) * 256 + F.wave * 32);
        }
        __syncthreads();
        SEAM(3);
    }
    if (IN(4)) {
        pg8::DenseOrder S; S.init(F.ws + WS_MIX, F.ws + WS_WOUT_T, TF, DM, DM, F.G, (int)blockIdx.x);
        pg8::EpiOut E{F.x, F.out};
        pg8::gemm_phase<pg8::EpiOut, pg8::DenseOrder, false>(F.lds, DM, S, E, nullptr);
        if (REP_PHASE == 4) pg8::gemm_phase<pg8::EpiOut, pg8::DenseOrder, false>(F.lds, DM, S, E, nullptr);
        SEAM(4);
    }
    if (IN(5)) { p5_router(F); SEAM(5); }

    if (IN(6)) {
        moe_prefix(F, 8);
        const LAS int* upre = (const LAS int*)(F.lds + TPRE_OFF);
        moe::Order S{F.G, F.vcu, 8, upre, upre + 80};
        LAS int* tab = (LAS int*)(F.lds + TAB_OFF); const int* TOK = (const int*)(F.ws + WS_TOK);
        for (int i = 0; i < 8; ++i) { int e, cs, mt, cnt, cbase; if (!S.decode(i, e, cs, mt, cnt, cbase)) break;
            if (F.tid < 384) { const int p = mt * 384 + F.tid; tab[i * 384 + F.tid] = p < cnt ? (TOK[(size_t)e * TOKLD + p] >> 1) : TF; } }
        __syncthreads();
        for (int rep = 0; rep < (REP_PHASE == 6 ? 2 : 1); ++rep)
        moe::phase<DM, true>(F.lds, S, tab, (const char*)(F.ws + WS_U2), F.w1, F.w3, (bf16*)(F.ws + WS_HID));
        SEAM(6);
    }
    if (IN(7)) {
        moe_prefix(F, 16);
        const LAS int* upre = (const LAS int*)(F.lds + TPRE_OFF);
        moe::Order S{F.G, F.vcu, 16, upre, upre + 80};
        LAS float* wtab = (LAS float*)(F.lds + TAB_OFF); const int* TOK = (const int*)(F.ws + WS_TOK); const float* RW = (const float*)(F.ws + WS_ROUTE) + TF * 4;
        for (int i = 0; i < 8; ++i) { int e, cs, mt, cnt, cbase; if (!S.decode(i, e, cs, mt, cnt, cbase)) break;
            if (F.tid < 384) { const int p = mt * 384 + F.tid; wtab[i * 384 + F.tid] = p < cnt ? RW[TOK[(size_t)e * TOKLD + p]] : 0.f; } }
        __syncthreads();
        for (int rep = 0; rep < (REP_PHASE == 7 ? 2 : 1); ++rep)
        moe::phase<DE, false>(F.lds, S, (const LAS int*)wtab, (const char*)(F.ws + WS_HID), F.w2, nullptr, (bf16*)(F.ws + WS_Y));
        SEAM(7);
    }
    if (IN(8)) { moe_prefix(F, 16); p8_combine(F); }
#undef IN
#undef SEAM
}

extern "C" void kernel_launch(void* const* d_in, const int* in_sizes, int n_in, void* d_out, int out_size, void* d_ws, size_t ws_size, hipStream_t stream) {
    static int grid = 0;
    if (grid == 0) {
        if (n_in != 18 || out_size != TF * DM || ws_size < WS_END) { fprintf(stderr, "kernel_launch: unexpected shapes (n_in %d, out %d, ws %zu); nothing launched\n", n_in, out_size, ws_size); grid = -1; return; }
        int dev = 0, cus = 0, per_cu = 0;
        if (hipGetDevice(&dev) != hipSuccess || hipDeviceGetAttribute(&cus, hipDeviceAttributeMultiprocessorCount, dev) != hipSuccess) { grid = -1; return; }
        if (hipFuncSetAttribute((const void*)fwd, hipFuncAttributeMaxDynamicSharedMemorySize, LDS_BYTES) != hipSuccess) { fprintf(stderr, "kernel_launch: hipFuncSetAttribute failed\n"); grid = -1; return; }
        if (hipOccupancyMaxActiveBlocksPerMultiprocessor(&per_cu, (const void*)fwd, 512, LDS_BYTES) != hipSuccess || per_cu < 1) fprintf(stderr, "kernel_launch: occupancy query reports %d\n", per_cu);
        (void)hipGetLastError();
        grid = cus > 0 ? cus : 256;
    }
    if (grid < 0) return;
    (void)hipMemsetAsync((char*)d_ws + WS_CTL, 0, CTL_ZERO_BYTES, stream);
    Args a{};
    for (int i = 0; i < 18; ++i) a.in[i] = (const float*)d_in[i];
    a.out = (float*)d_out; a.ws = (unsigned char*)d_ws;
    constexpr int NL = MK_N_LAUNCHES;
    for (int li = 0; li < NL; ++li) {
        a.ph_lo = (NL == 1) ? 0 : li; a.ph_hi = (NL == 1) ? NPHASE : li + 1;
        hipLaunchKernelGGL(fwd, dim3(grid), dim3(512), LDS_BYTES, stream, a);
    }
}
```

```cpp
#include <hip/hip_runtime.h>
#include <hip/hip_bf16.h>
#include <cstdio>
#include <cstdint>

#ifndef REP_PHASE
#define REP_PHASE -1
#endif
#ifndef MK_N_LAUNCHES
#define MK_N_LAUNCHES 1
#endif

constexpr int DM = 2048, NB = 4, SEQ = 2048, NMETA = 16, HD = 128, NH = 8;
constexpr int TF = NB * SEQ;
constexpr int ROW_META = TF;
constexpr int NKEYROWS = TF + NMETA;
constexpr int MROWS = 8448;
constexpr int NPROJ = 7168, LDW_IN = 7176;
constexpr int NE = 64, DE = 512;
constexpr int LPOS = SEQ + NMETA;
constexpr int CUMLD = 2112;
constexpr float EPS = 1e-6f;
constexpr float LOG2E = 1.4426950408889634f;
constexpr float QSCALE2 = 0.08838834764831845f * 1.4426950408889634f;
constexpr int NPHASE = 9;

constexpr size_t MiB = 1u << 20;
constexpr size_t WS_CTL = 0, CTL_ZERO_BYTES = 1 * MiB;
constexpr size_t WS_WIN_T = 2 * MiB;
constexpr size_t WS_WOUT_T = 30 * MiB;
constexpr size_t WS_U1 = 38 * MiB;
constexpr size_t WS_PROJ = 72 * MiB;
constexpr size_t PROJ_TS = (size_t)MROWS * 1024;
constexpr size_t WS_F = 188 * MiB;
constexpr size_t WS_CUM = 189 * MiB;
constexpr size_t WS_SS = 190 * MiB;
constexpr size_t WS_RK = 194 * MiB;
constexpr size_t WS_MT = 195 * MiB;
constexpr size_t WS_MIX = 196 * MiB;
constexpr size_t WS_U2 = 228 * MiB;
constexpr size_t WS_ROUTE = 262 * MiB;
constexpr size_t WS_TOK = 263 * MiB;
constexpr int TOKLD = 16512;
constexpr size_t WS_RB = 268 * MiB;
constexpr int NASSIGN = TF * 2;
constexpr size_t WS_HID = 272 * MiB;
constexpr size_t WS_Y = 292 * MiB;
constexpr size_t WS_END = 360 * MiB;
constexpr int CW_TMO = 0;
constexpr int CW_CNT = 1024;
constexpr int CW_BAR = 8192;

constexpr int RING_BYTES = 139264;
constexpr int TAB_OFF = RING_BYTES, TAB_BYTES = 8 * 384 * 4;
constexpr int TPRE_OFF = TAB_OFF + TAB_BYTES;
constexpr int MISC_OFF = TPRE_OFF + 1024;
constexpr int LDS_BYTES = MISC_OFF + 128;

#define GAS __attribute__((address_space(1)))
#define LAS __attribute__((address_space(3)))
typedef unsigned short bf16;
typedef unsigned v4u __attribute__((ext_vector_type(4)));
typedef unsigned v2u __attribute__((ext_vector_type(2)));
typedef float f32x4 __attribute__((ext_vector_type(4)));
typedef float f32x2 __attribute__((ext_vector_type(2)));
typedef float f32x16 __attribute__((ext_vector_type(16)));
typedef short bf16x8 __attribute__((ext_vector_type(8)));
typedef short s16x4 __attribute__((ext_vector_type(4)));
typedef GAS unsigned gu32;
#define RLX_AGENT __ATOMIC_RELAXED, __HIP_MEMORY_SCOPE_AGENT
#define LDS_WAIT() asm volatile("s_waitcnt lgkmcnt(0)" ::: "memory")
#define VM_WAIT() asm volatile("s_waitcnt vmcnt(0)" ::: "memory")
__device__ __forceinline__ unsigned cvtpk(float lo, float hi) { unsigned r; asm volatile("v_cvt_pk_bf16_f32 %0, %1, %2" : "=v"(r) : "v"(lo), "v"(hi)); return r; }
__device__ __forceinline__ float bf2f(unsigned short h) { return __uint_as_float(((unsigned)h) << 16); }
__device__ __forceinline__ float wave_sum(float v) {
#pragma unroll
    for (int o = 1; o < 64; o <<= 1) v += __shfl_xor(v, o);
    return v;
}
__device__ __forceinline__ int opaque_tid() { int t = threadIdx.x; asm volatile("" : "+v"(t)); return t; }
__device__ __forceinline__ float fast_exp2(float x) { return __builtin_amdgcn_exp2f(x); }
__device__ __forceinline__ float fast_log2(float x) { return __builtin_amdgcn_logf(x); }
__device__ __forceinline__ float fast_rcp(float x) { return __builtin_amdgcn_rcpf(x); }

namespace pg8 {
#define PG8_LAS __attribute__((address_space(3)))
typedef unsigned short bf16_t;
typedef unsigned u32x4 __attribute__((ext_vector_type(4)));
constexpr int BM = 256, BK = 64, HALF = 128, HTB = HALF * BK * 2, STAGE_BYTES = 8 * HTB, NXCD = 8, WGM = 8;
__host__ __device__ __forceinline__ int lds_byte(int r, int c) { const int st = (r >> 4) * 2 + (c >> 5), rr = r & 15, cc = c & 31, ob = rr * 64 + cc * 2; return st * 1024 + (ob ^ (((ob >> 9) & 1) << 5)); }
__host__ __device__ __forceinline__ void stage_rc(int b, int& R, int& C) { const int st = b / 1024, sb = b % 1024, swz = sb ^ (((sb >> 9) & 1) << 5); R = (st >> 1) * 16 + swz / 64; C = (st & 1) * 32 + (swz % 64) / 2; }
__host__ __device__ __forceinline__ int perm32(int rho) { const int n = rho >> 4, i = rho & 15; return 8 * (i >> 2) + 4 * n + (i & 3); }

struct Unit { int pm, pn, li; const char* A; const char* B; };

struct DenseOrder {
    int nM, nN, nwg, G, c; const char* A; const char* B; size_t tstep;
    __device__ __forceinline__ void init(const void* A_, const void* B_, int M, int N, int K, int G_, int c_) { nM = M / BM; nN = N / BM; nwg = nM * nN; G = G_; c = c_; A = (const char*)A_; B = (const char*)B_; tstep = (size_t)BM * K * 2; }
    __device__ __forceinline__ bool next(int i, Unit& u) const {
        const long L = (long)i * G + c; if (L >= nwg) return false;
        int wgid = (int)L; { const int q = nwg / NXCD, r = nwg % NXCD, xcd = wgid % NXCD, off = wgid / NXCD; wgid = (xcd < r ? xcd * (q + 1) : r * (q + 1) + (xcd - r) * q) + off; }
        const int nig = WGM * nN, gid = wgid / nig, fm = gid * WGM, gsz = (nM - fm) < WGM ? (nM - fm) : WGM;
        u.pm = fm + ((wgid % nig) % gsz); u.pn = (wgid % nig) / gsz; u.li = 0;
        u.A = A + (size_t)u.pm * tstep; u.B = B + (size_t)u.pn * tstep; return true;
    }
};

template <class Epi, class Sched, bool GATHER>
__device__ __forceinline__ void gemm_phase(PG8_LAS unsigned char* lds, const int K, const Sched& S, const Epi& E, const PG8_LAS int* tab) {
    const int tid = opaque_tid(), wid = __builtin_amdgcn_readfirstlane(tid >> 6), lane = tid & 63, wr = wid >> 2, wc = wid & 3, fr = lane & 15, fq = lane >> 4;
    const int nt = K / BK;
    unsigned voffA[2], voffB[2]; int RA[2], CA[2];
#pragma unroll
    for (int i = 0; i < 2; ++i) { int R, C; stage_rc(tid * 16 + i * 8192, R, C); const int Rb = Epi::PERM ? ((R & ~31) + perm32(R & 31)) : R;
        voffA[i] = (unsigned)(R * K + C) * 2u; voffB[i] = (unsigned)(Rb * K + C) * 2u; RA[i] = R; CA[i] = C; }
    const size_t kstep = (size_t)(BK * 2);
    const size_t hstep = (size_t)HALF * K * 2;
    const unsigned ldsw = (unsigned)wid * 1024u;
    const int aoff = lds_byte(wr * 64 + fr, fq * 8), boff = lds_byte(wc * 32 + fr, fq * 8);
    unsigned gA[2][2], gAn[2][2];
#define PG8_SA(b, h) (((b) * 2 + (h)) * HTB)
#define PG8_SB(b, h) ((4 + (b) * 2 + (h)) * HTB)
#define PG8_GL(gptr, ldsoff) __builtin_amdgcn_global_load_lds((const unsigned*)(gptr), (PG8_LAS unsigned*)(lds + (ldsoff)), 16, 0, 0)
#define PG8_STAGE_B(bufoff, gbase) do { _Pragma("unroll") for (int _i = 0; _i < 2; ++_i) PG8_GL((const char*)(gbase) + voffB[_i], (bufoff) + ldsw + _i * 8192); } while (0)
#define PG8_STAGE_A(bufoff, gbase, h, NX) do { _Pragma("unroll") for (int _i = 0; _i < 2; ++_i) { \
        if constexpr (GATHER) { const unsigned _vo = (NX) ? gAn[h][_i] : gA[h][_i]; PG8_GL((const char*)(gbase) + _vo, (bufoff) + ldsw + _i * 8192); } \
        else { PG8_GL((const char*)(gbase) + (size_t)(h) * hstep + voffA[_i], (bufoff) + ldsw + _i * 8192); } } } while (0)
#define PG8_GIDX(dst, li) do { if constexpr (GATHER) { _Pragma("unroll") for (int _h = 0; _h < 2; ++_h) _Pragma("unroll") for (int _i = 0; _i < 2; ++_i) \
        dst[_h][_i] = ((unsigned)tab[(li) * 256 + _h * 128 + RA[_i]] * (unsigned)K + (unsigned)CA[_i]) * 2u; } } while (0)
#define PG8_LDA(dst, b, h) do { _Pragma("unroll") for (int m = 0; m < 4; ++m) _Pragma("unroll") for (int k = 0; k < 2; ++k) dst[m][k] = *(const PG8_LAS bf16x8*)(lds + PG8_SA(b, h) + aoff + m * 2048 + k * 1024); } while (0)
#define PG8_LDB(dst, b, h) do { _Pragma("unroll") for (int n = 0; n < 2; ++n) _Pragma("unroll") for (int k = 0; k < 2; ++k) dst[n][k] = *(const PG8_LAS bf16x8*)(lds + PG8_SB(b, h) + boff + n * 2048 + k * 1024); } while (0)
#define PG8_MMA(ai, bj, At, Bt) do { __builtin_amdgcn_s_setprio(1); _Pragma("unroll") for (int m = 0; m < 4; ++m) _Pragma("unroll") for (int n = 0; n < 2; ++n) _Pragma("unroll") for (int k = 0; k < 2; ++k) \
        acc[ai][bj][m][n] = __builtin_amdgcn_mfma_f32_16x16x32_bf16(Bt[n][k], At[m][k], acc[ai][bj][m][n], 0, 0, 0); __builtin_amdgcn_s_setprio(0); } while (0)
#define PG8_WAIT_V(n) asm volatile("s_waitcnt vmcnt(" #n ")" ::: "memory")
#define PG8_WAIT_L(n) asm volatile("s_waitcnt lgkmcnt(" #n ")" ::: "memory")
#define PG8_BAR __builtin_amdgcn_s_barrier()
#define PG8_SCHED __builtin_amdgcn_sched_barrier(0)
    Unit cur, nxt; int ui = 0;
    if (!S.next(0, cur)) return;
    f32x4 acc[2][2][4][2];
#pragma unroll
    for (int a = 0; a < 2; ++a)
#pragma unroll
        for (int b = 0; b < 2; ++b)
#pragma unroll
            for (int m = 0; m < 4; ++m)
#pragma unroll
                for (int n = 0; n < 2; ++n) acc[a][b][m][n] = (f32x4){0.f, 0.f, 0.f, 0.f};
    bf16x8 At[4][2], B0[2][2], B1[2][2];
    const char* cA = cur.A; const char* cB = cur.B;
    PG8_GIDX(gA, cur.li);
    PG8_STAGE_B(PG8_SB(0, 0), cB); PG8_STAGE_B(PG8_SB(0, 1), cB + hstep); PG8_STAGE_A(PG8_SA(0, 0), cA, 0, false); PG8_STAGE_A(PG8_SA(0, 1), cA, 1, false);
    if (wr == 1) PG8_BAR;
    PG8_WAIT_V(2); PG8_BAR;
    PG8_STAGE_B(PG8_SB(1, 0), cB + kstep); PG8_STAGE_A(PG8_SA(1, 0), cA + kstep, 0, false); PG8_STAGE_B(PG8_SB(1, 1), cB + hstep + kstep);
    PG8_WAIT_V(6); PG8_BAR;
    for (;;) {
        const bool has_next = S.next(ui + 1, nxt);
        const char* nA = has_next ? nxt.A : cA; const char* nB = has_next ? nxt.B : cB;
        if constexpr (GATHER) { if (has_next) { PG8_GIDX(gAn, nxt.li); } else {
#pragma unroll
            for (int _h = 0; _h < 2; ++_h)
#pragma unroll
                for (int _i = 0; _i < 2; ++_i) gAn[_h][_i] = gA[_h][_i]; } }
        for (int t = 0; t < nt; t += 2) {
            const bool last = (t == nt - 2);
            const char* a1 = cA + (size_t)(t + 1) * kstep;
            const char* a2 = last ? nA : cA + (size_t)(t + 2) * kstep; const char* b2 = last ? nB : cB + (size_t)(t + 2) * kstep;
            const char* a3 = a2 + kstep; const char* b3 = b2 + kstep;
            PG8_LDB(B0, 0, 0); PG8_LDB(B1, 0, 1); PG8_SCHED; PG8_LDA(At, 0, 0); PG8_STAGE_A(PG8_SA(1, 1), a1, 1, false);
            PG8_WAIT_V(8); PG8_WAIT_L(0); PG8_BAR; PG8_MMA(0, 0, At, B0); PG8_MMA(0, 1, At, B1); PG8_BAR; PG8_SCHED;
            PG8_LDA(At, 0, 1); PG8_STAGE_B(PG8_SB(0, 0), b2); PG8_STAGE_B(PG8_SB(0, 1), b2 + hstep); PG8_STAGE_A(PG8_SA(0, 0), a2, 0, last);
            PG8_WAIT_V(8); PG8_WAIT_L(0); PG8_BAR; PG8_MMA(1, 0, At, B0); PG8_MMA(1, 1, At, B1); PG8_BAR; PG8_SCHED;
            PG8_LDB(B0, 1, 0); PG8_LDB(B1, 1, 1); PG8_SCHED; PG8_LDA(At, 1, 0); PG8_STAGE_A(PG8_SA(0, 1), a2, 1, last);
            PG8_WAIT_V(8); PG8_WAIT_L(0); PG8_BAR; PG8_MMA(0, 0, At, B0); PG8_MMA(0, 1, At, B1); PG8_BAR; PG8_SCHED;
            PG8_LDA(At, 1, 1); PG8_STAGE_B(PG8_SB(1, 0), b3); PG8_STAGE_B(PG8_SB(1, 1), b3 + hstep); PG8_STAGE_A(PG8_SA(1, 0), a3, 0, last);
            PG8_WAIT_V(8); PG8_WAIT_L(0); PG8_BAR; PG8_MMA(1, 0, At, B0); PG8_MMA(1, 1, At, B1); PG8_BAR; PG8_SCHED;
        }
        if (wr == 0) PG8_BAR;
        E(acc, cur, wr, wc, fr, fq);
        if (!has_next) break;
#pragma unroll
        for (int a = 0; a < 2; ++a)
#pragma unroll
            for (int b = 0; b < 2; ++b)
#pragma unroll
                for (int m = 0; m < 4; ++m)
#pragma unroll
                    for (int n = 0; n < 2; ++n) acc[a][b][m][n] = (f32x4){0.f, 0.f, 0.f, 0.f};
        cur = nxt; cA = nA; cB = nB; ++ui;
        if constexpr (GATHER) {
#pragma unroll
            for (int _h = 0; _h < 2; ++_h)
#pragma unroll
                for (int _i = 0; _i < 2; ++_i) gA[_h][_i] = gAn[_h][_i]; }
        if (wr == 1) PG8_BAR;
    }
    PG8_WAIT_V(0);
    PG8_BAR;
#undef PG8_SA
#undef PG8_SB
#undef PG8_GL
#undef PG8_STAGE_A
#undef PG8_STAGE_B
#undef PG8_GIDX
#undef PG8_LDA
#undef PG8_LDB
#undef PG8_MMA
#undef PG8_WAIT_V
#undef PG8_WAIT_L
#undef PG8_BAR
#undef PG8_SCHED
}

struct EpiProj {
    static constexpr bool PERM = true;
    bf16_t* P; float* SS;
    __device__ __forceinline__ void operator()(const f32x4 (&acc)[2][2][4][2], const Unit& u, int wr, int wc, int fr, int fq) const {
        const int t = u.pn >> 2, colt = (u.pn & 3) * BM;
        bf16_t* base = P + (size_t)t * PROJ_TS;
        const int row0 = u.pm * BM + wr * 64 + fr, col0 = colt + wc * 32 + 8 * fq;
        if (t <= 1) {
#pragma unroll
            for (int ai = 0; ai < 2; ++ai)
#pragma unroll
                for (int m = 0; m < 4; ++m)
#pragma unroll
                    for (int bj = 0; bj < 2; ++bj) {
                        const f32x4 a = acc[ai][bj][m][0], b = acc[ai][bj][m][1];
                        float s = (a[0] * a[0] + a[1] * a[1]) + (a[2] * a[2] + a[3] * a[3]) + (b[0] * b[0] + b[1] * b[1]) + (b[2] * b[2] + b[3] * b[3]);
                        s += __shfl_xor(s, 16); s += __shfl_xor(s, 32);
                        if (fq == 0) SS[(((size_t)t * MROWS + (row0 + ai * HALF + m * 16)) * 8 + ((u.pn & 3) * 2 + bj)) * 4 + wc] = s;
                    }
        }
#pragma unroll
        for (int ai = 0; ai < 2; ++ai)
#pragma unroll
            for (int m = 0; m < 4; ++m) { bf16_t* rowp = base + (size_t)(row0 + ai * HALF + m * 16) * 1024 + col0;
#pragma unroll
                for (int bj = 0; bj < 2; ++bj) { f32x4 v0 = acc[ai][bj][m][0], v1 = acc[ai][bj][m][1];
                    if (t == 3) {
#pragma unroll
                        for (int j = 0; j < 4; ++j) { v0[j] = fast_rcp(1.f + fast_exp2(-v0[j] * LOG2E)); v1[j] = fast_rcp(1.f + fast_exp2(-v1[j] * LOG2E)); } }
                    if (t == 4) { v0 = v0 * QSCALE2; v1 = v1 * QSCALE2; }
                    u32x4 w; w.x = cvtpk(v0[0], v0[1]); w.y = cvtpk(v0[2], v0[3]); w.z = cvtpk(v1[0], v1[1]); w.w = cvtpk(v1[2], v1[3]);
                    *(u32x4*)(rowp + bj * HALF) = w; } }
    }
};
struct EpiOut {
    static constexpr bool PERM = false;
    const float* X; float* O;
    __device__ __forceinline__ void operator()(const f32x4 (&acc)[2][2][4][2], const Unit& u, int wr, int wc, int fr, int fq) const {
        const int row0 = u.pm * BM + wr * 64 + fr, col0 = u.pn * BM + wc * 32 + 4 * fq;
#pragma unroll
        for (int ai = 0; ai < 2; ++ai)
#pragma unroll
            for (int m = 0; m < 4; ++m) { const size_t off = (size_t)(row0 + ai * HALF + m * 16) * DM + col0;
#pragma unroll
                for (int bj = 0; bj < 2; ++bj)
#pragma unroll
                    for (int n = 0; n < 2; ++n) { const f32x4 xv = *(const f32x4*)(X + off + bj * HALF + n * 16); *(f32x4*)(O + off + bj * HALF + n * 16) = xv + acc[ai][bj][m][n]; } }
    }
};
}

namespace moe {
constexpr int MT = 384, BKT = 64, A_BYTES = MT * BKT * 2, B_PITCH = 320, B_BYTES = BKT * B_PITCH;
constexpr int OFF_A = 0, OFF_B = 2 * A_BYTES, STAGE_END = 2 * A_BYTES + 2 * B_BYTES;
typedef short v4i16_t __attribute__((ext_vector_type(4)));
__device__ __forceinline__ void glds16(const void* gsrc, unsigned lds_dst) { unsigned keep;
    asm volatile("s_mov_b32 %0, m0\n\ts_mov_b32 m0, %2\n\ts_nop 0\n\tglobal_load_lds_dwordx4 %1, off\n\ts_mov_b32 m0, %0" : "=&s"(keep) : "v"(gsrc), "s"(lds_dst) : "memory"); }
__device__ __forceinline__ s16x4 vtr(const LAS unsigned char* p) { return __builtin_bit_cast(s16x4, __builtin_amdgcn_ds_read_tr16_b64_v4i16((LAS v4i16_t*)p)); }

struct Order {
    int G, c, ncs; const LAS int* upre; const LAS int* cpre;
    __device__ __forceinline__ bool decode(int i, int& e, int& cs, int& mt, int& cnt, int& cbase) const {
        const int L = i * G + c; if (L >= __builtin_amdgcn_readfirstlane(upre[NE])) return false;
        int lo = 0, hi = NE;
        while (hi - lo > 1) { const int mid = (lo + hi) >> 1; const int v = __builtin_amdgcn_readfirstlane(upre[mid]); if (v <= L) lo = mid; else hi = mid; }
        e = lo; const int u0 = __builtin_amdgcn_readfirstlane(upre[e]), u1 = __builtin_amdgcn_readfirstlane(upre[e + 1]), ntm = (u1 - u0) / ncs, r = L - u0;
        cs = r / ntm; mt = r - cs * ntm; cbase = __builtin_amdgcn_readfirstlane(cpre[e]); cnt = __builtin_amdgcn_readfirstlane(cpre[e + 1]) - cbase; return true;
    }
};

template <int KDIM, bool G1, bool WW>
__device__ __forceinline__ void role_loop(LAS unsigned char* lds, const Order& S, const LAS int* tab, const char* Abase, const float* Wa, const float* Wb, bf16* Out) {
    constexpr int NTK = KDIM / BKT; constexpr int LDB = G1 ? DE : DM;
    const int tid = opaque_tid(), wid = __builtin_amdgcn_readfirstlane(tid >> 6), lane = tid & 63, r32 = lane & 31, hi = lane >> 5, wr = wid >> 1, wc = wid & 1;
    int e, cs, mt, cnt, cbase; if (!S.decode(0, e, cs, mt, cnt, cbase)) return;
    const int wv = wid - 4, tl2 = (wv & 1) * 64 + lane, bk = tl2 >> 4, bc = (wv >> 1) * 64 + (tl2 & 15) * 4;
    const unsigned boffl = (unsigned)(bk * LDB + (tl2 & 15) * 4) * 4u;
    const unsigned bwr = (unsigned)(bk * B_PITCH + bc * 2);
    const unsigned trbv = (unsigned)(uintptr_t)(lds + OFF_B + (8 * hi + ((lane & 15) >> 2)) * B_PITCH + (16 * ((lane >> 4) & 1) + 4 * (lane & 3)) * 2 + wc * 64);
    const unsigned ldsA = (unsigned)(uintptr_t)(lds + OFF_A) + (unsigned)(wid & 3) * 1024u;
    const LAS unsigned char* xa[4];
#pragma unroll
    for (int ks = 0; ks < 4; ++ks) xa[ks] = lds + OFF_A + (32 * wr + r32) * 128 + (((2 * ks + hi) ^ (r32 & 7)) * 16);
#define MOE_BBASE(e_, cs_) ((G1 ? ((wv >> 1) ? Wb : Wa) + (size_t)(e_) * DM * DE + 64 * (cs_) : Wa + (size_t)(e_) * DE * DM + 128 * (cs_) + 64 * (wv >> 1)))
#define MOE_AOFF(dst, ui_, cbase_, mt_) do { if constexpr (!WW) { _Pragma("unroll") for (int q = 0; q < 12; ++q) { const int row = 8 * (4 * q + (wid & 3)) + (lane >> 3); \
        const int arow = G1 ? tab[(ui_) * MT + row] : (cbase_) + MT * (mt_) + row; dst[q] = (unsigned)arow * (unsigned)(KDIM * 2) + (unsigned)(((lane & 7) ^ (row & 7)) * 16); } } } while (0)
    unsigned aoff[12], aoffn[12];
    MOE_AOFF(aoff, 0, cbase, mt);
    const float* bbase = MOE_BBASE(e, cs); const float* bbasen = bbase;
    f32x4 R0[8], R1[8];
    bool has_next = false;
#define MOE_DMA_A(tt, buf) do { if constexpr (!WW) { const bool nx_ = (tt) >= NTK; const int t_ = nx_ ? (has_next ? (tt) - NTK : NTK - 1) : (tt); _Pragma("unroll") for (int q = 0; q < 12; ++q) \
        glds16(Abase + ((nx_ && has_next) ? aoffn[q] : aoff[q]) + (size_t)t_ * (BKT * 2), (unsigned)__builtin_amdgcn_readfirstlane((int)(ldsA + (buf) * A_BYTES + q * 4096))); } } while (0)
#define MOE_LDB(R, tt) do { if constexpr (WW) { const bool nx_ = (tt) >= NTK; const int t_ = nx_ ? (has_next ? (tt) - NTK : NTK - 1) : (tt); const float* bb_ = (nx_ && has_next) ? bbasen : bbase; \
        _Pragma("unroll") for (int i = 0; i < 8; ++i) R[i] = __builtin_nontemporal_load((const f32x4*)((const char*)(bb_ + (size_t)(t_ * BKT + 8 * i) * LDB) + boffl)); } asm volatile("" ::: "memory"); __builtin_amdgcn_sched_barrier(0); } while (0)
#define MOE_WRB(R, buf) do { if constexpr (WW) { asm volatile("s_waitcnt vmcnt(8)" ::: "memory"); _Pragma("unroll") for (int i = 0; i < 8; ++i) *(LAS v2u*)(lds + OFF_B + (buf) * B_BYTES + bwr + i * 8 * B_PITCH) = (v2u){cvtpk(R[i].x, R[i].y), cvtpk(R[i].z, R[i].w)}; } } while (0)
#define MOE_TR4(W0, W1, W2, W3, off) asm volatile("ds_read_b64_tr_b16 %0, %4 offset:%5\n\tds_read_b64_tr_b16 %1, %4 offset:%6\n\tds_read_b64_tr_b16 %2, %4 offset:%7\n\tds_read_b64_tr_b16 %3, %4 offset:%8" \
        : "=&v"(W0), "=&v"(W1), "=&v"(W2), "=&v"(W3) : "v"(trbv), "i"(off), "i"((off) + 4 * B_PITCH), "i"((off) + 128), "i"((off) + 4 * B_PITCH + 128) : "memory")
#define MOE_COMPUTE(buf) do { _Pragma("unroll") for (int ks = 0; ks < 4; ++ks) { \
        s16x4 l0_, h0_, l1_, h1_; bf16x8 xf[3]; \
        MOE_TR4(l0_, h0_, l1_, h1_, (buf) * B_BYTES + ks * 16 * B_PITCH); \
        _Pragma("unroll") for (int j = 0; j < 3; ++j) xf[j] = *(const LAS bf16x8*)(xa[ks] + (buf) * A_BYTES + j * 16384); \
        asm volatile("s_waitcnt lgkmcnt(0)" ::: "memory"); __builtin_amdgcn_sched_barrier(0); \
        const bf16x8 wf0 = (bf16x8){l0_[0], l0_[1], l0_[2], l0_[3], h0_[0], h0_[1], h0_[2], h0_[3]}, wf1 = (bf16x8){l1_[0], l1_[1], l1_[2], l1_[3], h1_[0], h1_[1], h1_[2], h1_[3]}; \
        _Pragma("unroll") for (int j = 0; j < 3; ++j) { acc[j][0] = __builtin_amdgcn_mfma_f32_32x32x16_bf16(wf0, xf[j], acc[j][0], 0, 0, 0); acc[j][1] = __builtin_amdgcn_mfma_f32_32x32x16_bf16(wf1, xf[j], acc[j][1], 0, 0, 0); } } } while (0)
#define MOE_ENDT() do { if constexpr (!WW) asm volatile("s_waitcnt vmcnt(0)" ::: "memory"); LDS_WAIT(); __builtin_amdgcn_s_barrier(); } while (0)
#define MOE_STEP(t, buf, RN) do { MOE_DMA_A((t) + 1, 1 - (buf)); MOE_COMPUTE(buf); MOE_WRB(RN, 1 - (buf)); MOE_LDB(RN, (t) + 3); MOE_ENDT(); } while (0)
    MOE_LDB(R0, 0); MOE_LDB(R1, 1); MOE_DMA_A(0, 0);
    MOE_WRB(R0, 0); MOE_LDB(R0, 2);
    MOE_ENDT();
    for (int ui = 0;; ++ui) {
        int en, csn, mtn, cntn, cbasen; has_next = S.decode(ui + 1, en, csn, mtn, cntn, cbasen);
        if (has_next) { MOE_AOFF(aoffn, ui + 1, cbasen, mtn); bbasen = MOE_BBASE(en, csn); }
        const int rows_valid = cnt - MT * mt;
        f32x16 acc[3][2];
#pragma unroll
        for (int j = 0; j < 3; ++j) { acc[j][0] = f32x16{}; acc[j][1] = f32x16{}; }
        for (int t = 0; t < NTK; t += 2) { MOE_STEP(t, 0, R1); MOE_STEP(t + 1, 1, R0); }
#pragma unroll
        for (int j = 0; j < 3; ++j) { const int row = 32 * (wr + 4 * j) + r32;
            if (row < rows_valid) { const size_t orow = (size_t)(cbase + MT * mt + row);
                if (G1) { bf16* op = Out + orow * DE + 64 * cs + 32 * wc + 4 * hi;
#pragma unroll
                    for (int g = 0; g < 4; ++g) { float h4[4];
#pragma unroll
                        for (int i2 = 0; i2 < 4; ++i2) { const float a = acc[j][0][4 * g + i2], b = acc[j][1][4 * g + i2]; h4[i2] = a * fast_rcp(1.f + fast_exp2(-a * LOG2E)) * b; }
                        *(v2u*)(op + 8 * g) = (v2u){cvtpk(h4[0], h4[1]), cvtpk(h4[2], h4[3])}; } }
                else { const float w = ((const LAS float*)tab)[ui * MT + row]; bf16* op = Out + orow * DM + 128 * cs + 32 * wc + 4 * hi;
#pragma unroll
                    for (int nbi = 0; nbi < 2; ++nbi)
#pragma unroll
                        for (int g = 0; g < 4; ++g) *(v2u*)(op + 64 * nbi + 8 * g) = (v2u){cvtpk(acc[j][nbi][4 * g] * w, acc[j][nbi][4 * g + 1] * w), cvtpk(acc[j][nbi][4 * g + 2] * w, acc[j][nbi][4 * g + 3] * w)}; } } }
        if (!has_next) break;
        e = en; cs = csn; mt = mtn; cnt = cntn; cbase = cbasen; bbase = bbasen;
        if constexpr (!WW) {
#pragma unroll
            for (int q = 0; q < 12; ++q) aoff[q] = aoffn[q]; }
    }
    asm volatile("s_waitcnt vmcnt(0)" ::: "memory");
#undef MOE_BBASE
#undef MOE_AOFF
#undef MOE_DMA_A
#undef MOE_LDB
#undef MOE_WRB
#undef MOE_TR4
#undef MOE_COMPUTE
#undef MOE_ENDT
#undef MOE_STEP
}

template <int KDIM, bool G1>
__device__ __forceinline__ void phase(LAS unsigned char* lds, const Order& S, const LAS int* tab, const char* Abase, const float* Wa, const float* Wb, bf16* Out) {
    __syncthreads();
    if (__builtin_amdgcn_readfirstlane((int)(threadIdx.x >> 6)) >= 4) role_loop<KDIM, G1, true>(lds, S, tab, Abase, Wa, Wb, Out);
    else role_loop<KDIM, G1, false>(lds, S, tab, Abase, Wa, Wb, Out);
    __syncthreads();
}
}

namespace att {
#define KSWZ(row, colB) ((row) * 256 + ((colB) ^ (((row) & 7) << 4)))
#define SBAR() __builtin_amdgcn_sched_barrier(0)
constexpr int SHM_V = 16384, SHM_K = 16384;
constexpr int KS_OFF = 32768, WSF_OFF = 33792, WSF_FLOATS = 1152;
__device__ __forceinline__ int v_st(int k, int c) { const int kk = (k & ~0xC) | ((k & 4) << 1) | ((k & 8) >> 1); return ((kk >> 3) * 4 + (c >> 5)) * 512 + ((kk & 7) * 32 + (c & 31)) * 2; }
__device__ __forceinline__ int v_rd_base(int lane) { return ((lane & 3) << 3) | (((lane >> 2) & 3) << 6) | (((lane >> 4) & 1) << 5) | (((lane >> 5) & 1) << 8); }
constexpr int v_rd_off(int d0, int ks, int half) { return d0 * 512 + ks * 4096 + half * 2048; }
__device__ __forceinline__ int crow(int r, int hi) { return (r & 3) + 8 * (r >> 2) + 4 * hi; }

__device__ __forceinline__ void qkt(f32x16& p0, f32x16& p1, const char* K_lds, int r32, int hi, const bf16x8* qr) {
    p0 = f32x16{}; p1 = f32x16{};
    const char* kb[4];
#pragma unroll
    for (int dd = 0; dd < 4; ++dd) kb[dd] = K_lds + KSWZ(r32, (dd * 16 + hi * 8) * 2);
#pragma unroll
    for (int d0 = 0; d0 < 8; ++d0) { const char* a = kb[d0 & 3] + (d0 >> 2) * 128;
        bf16x8 b0 = *reinterpret_cast<const bf16x8*>(a);
        bf16x8 b1 = *reinterpret_cast<const bf16x8*>(a + 32 * 256);
        p0 = __builtin_amdgcn_mfma_f32_32x32x16_bf16(b0, qr[d0], p0, 0, 0, 0);
        p1 = __builtin_amdgcn_mfma_f32_32x32x16_bf16(b1, qr[d0], p1, 0, 0, 0); }
}
__device__ __forceinline__ void pv_tile(f32x16* o, int vb0, bf16x8 pa0, bf16x8 pa1, bf16x8 pa2, bf16x8 pa3) {
#define TRRD(dst, off) asm volatile("ds_read_b64_tr_b16 %0, %1 offset:%2" : "=&v"(dst) : "v"(vb0), "i"(off) : "memory")
#define PV_D0(d0) do { s16x4 l0, l1, l2, l3, h0, h1, h2, h3; constexpr int b_ = v_rd_off(d0, 0, 0); \
        TRRD(l0, b_); TRRD(h0, b_ + 2048); TRRD(l1, b_ + 4096); TRRD(h1, b_ + 6144); TRRD(l2, b_ + 8192); TRRD(h2, b_ + 10240); TRRD(l3, b_ + 12288); TRRD(h3, b_ + 14336); \
        asm volatile("s_waitcnt lgkmcnt(0)" ::: "memory"); SBAR(); \
        o[d0] = __builtin_amdgcn_mfma_f32_32x32x16_bf16(pa0, (bf16x8){l0[0], l0[1], l0[2], l0[3], h0[0], h0[1], h0[2], h0[3]}, o[d0], 0, 0, 0); \
        o[d0] = __builtin_amdgcn_mfma_f32_32x32x16_bf16(pa1, (bf16x8){l1[0], l1[1], l1[2], l1[3], h1[0], h1[1], h1[2], h1[3]}, o[d0], 0, 0, 0); \
        o[d0] = __builtin_amdgcn_mfma_f32_32x32x16_bf16(pa2, (bf16x8){l2[0], l2[1], l2[2], l2[3], h2[0], h2[1], h2[2], h2[3]}, o[d0], 0, 0, 0); \
        o[d0] = __builtin_amdgcn_mfma_f32_32x32x16_bf16(pa3, (bf16x8){l3[0], l3[1], l3[2], l3[3], h3[0], h3[1], h3[2], h3[3]}, o[d0], 0, 0, 0); } while (0)
    PV_D0(0); PV_D0(1); PV_D0(2); PV_D0(3);
#undef PV_D0
#undef TRRD
}
#define PK4(P, B_, OUT) do { unsigned a0 = cvtpk(P[B_+0], P[B_+1]), a1 = cvtpk(P[B_+2], P[B_+3]); \
        unsigned b0 = cvtpk(P[B_+4], P[B_+5]), b1 = cvtpk(P[B_+6], P[B_+7]); \
        auto r0 = __builtin_amdgcn_permlane32_swap(a0, b0, false, false); auto r1 = __builtin_amdgcn_permlane32_swap(a1, b1, false, false); \
        v4u w = {r0[0], r1[0], r0[1], r1[1]}; OUT = *reinterpret_cast<bf16x8*>(&w); } while (0)

struct Tensors {
    const bf16* QA; const bf16* KA; const bf16* VA; const bf16* GA; const bf16* QB; const bf16* KB; const bf16* VB;
    const float* SS; const float* CUM;
    const float* q_gain; const float* k_gain;
    const float* fox_gain; const float* sb_gain;
    bf16* MIX;
};

template <int TYP>
__device__ __forceinline__ void attn_wave(char* ldsw, const Tensors& T, const int b, const int h, const int f0) {
    const int lane = opaque_tid() & 63, r32 = lane & 31, hi = lane >> 5;
    char* V_lds = ldsw;
    float* ks_rk = (float*)(ldsw + 8192); float* ks_nc = ks_rk + 32;
    float* wsf = (float*)(ldsw + 8192 + 256); float* part = wsf; float* li_l = wsf + 1056; float* rs_l = wsf + 1088;
    const bf16* Qp = TYP == 0 ? T.QA : T.QB; const bf16* Kp = TYP == 0 ? T.KA : T.KB; const bf16* Vp = TYP == 0 ? T.VA : T.VB;
    const int frow0 = b * SEQ + f0;
    const int cbase = (b * NH + h) * CUMLD;
    const int jd = (64 + f0) >> 5;
    bf16x8 qr[8];
#pragma unroll
    for (int d0 = 0; d0 < 8; ++d0) qr[d0] = *reinterpret_cast<const bf16x8*>(Qp + (size_t)(frow0 + r32) * 1024 + h * HD + d0 * 16 + hi * 8);
    float mt2 = 0.f;
    if (TYP == 0) {
        const f32x4 sp = *(const f32x4*)(T.SS + ((size_t)(frow0 + r32) * 8 + h) * 4);
        const float rstd = (1.0f / sqrtf(((sp.x + sp.y) + (sp.z + sp.w)) * (1.f / HD) + EPS)) * QSCALE2;
        float n2 = 0.f;
#pragma unroll
        for (int d0 = 0; d0 < 8; ++d0) { const int db = d0 * 16 + hi * 8;
            const f32x4 ga = *(const f32x4*)(T.q_gain + db), gb = *(const f32x4*)(T.q_gain + db + 4), ka = *(const f32x4*)(T.k_gain + db), kb = *(const f32x4*)(T.k_gain + db + 4);
            const float g8[8] = {ga.x * ka.x, ga.y * ka.y, ga.z * ka.z, ga.w * ka.w, gb.x * kb.x, gb.y * kb.y, gb.z * kb.z, gb.w * kb.w};
            v4u w = *reinterpret_cast<v4u*>(&qr[d0]); unsigned ww[4] = {w.x, w.y, w.z, w.w};
#pragma unroll
            for (int i = 0; i < 4; ++i) { const float lo = __uint_as_float(ww[i] << 16) * rstd * g8[2 * i], hi2 = __uint_as_float(ww[i] & 0xffff0000u) * rstd * g8[2 * i + 1]; n2 += lo * lo + hi2 * hi2; ww[i] = cvtpk(lo, hi2); }
            w = (v4u){ww[0], ww[1], ww[2], ww[3]}; qr[d0] = *reinterpret_cast<bf16x8*>(&w); }
        n2 += __shfl_xor(n2, 32);
        mt2 = sqrtf(n2 * (float)HD);
    }
    const int qp = 64 + f0 + r32;
    float bias_t = 0.f, cum_t = 0.f, Rrun = 0.f, l_reg = 0.f;
    if (TYP == 0) { cum_t = T.CUM[cbase + qp - 48]; bias_t = cum_t - mt2; }
    f32x16 o[4] = {};
    const int vkey = lane >> 4, vcol = (lane & 15) * 8;
    const int vb0 = (int)(uintptr_t)V_lds + v_rd_base(lane);
    for (int j = jd; j >= 1; --j) {
        const int kr0 = (j >= 2) ? b * SEQ + 32 * j - 64 : ROW_META - 16;
        const int krow = (j >= 2 || r32 >= 16) ? kr0 + r32 : ROW_META;
        bf16x8 kf[8], vs[8];
#pragma unroll
        for (int d0 = 0; d0 < 8; ++d0) kf[d0] = *reinterpret_cast<const bf16x8*>(Kp + (size_t)krow * 1024 + h * HD + d0 * 16 + hi * 8);
#pragma unroll
        for (int i = 0; i < 8; ++i) { const int vk = vkey + 4 * i; const int vrow = (j >= 2 || vk >= 16) ? kr0 + vk : ROW_META;
            vs[i] = *reinterpret_cast<const bf16x8*>(Vp + (size_t)vrow * 1024 + h * HD + vcol); }
        float sc = 0.f;
        if (TYP == 0) { const int ki = lane & 31; const int srow = (j >= 2 || ki >= 16) ? kr0 + ki : ROW_META; const int pos = (j >= 2) ? 32 * j - 48 + ki : (ki >= 16 ? ki - 16 : 0);
            if (lane < 32) { const f32x4 sk = *(const f32x4*)(T.SS + (((size_t)MROWS + srow) * 8 + h) * 4); sc = 1.0f / sqrtf(((sk.x + sk.y) + (sk.z + sk.w)) * (1.f / HD) + EPS); }
            else sc = -T.CUM[cbase + pos]; }
#pragma unroll
        for (int i = 0; i < 8; ++i) *(bf16x8*)(V_lds + v_st(vkey + 4 * i, vcol)) = vs[i];
        if (TYP == 0) ks_rk[lane] = sc;
        LDS_WAIT();
        f32x16 p0 = f32x16{};
#pragma unroll
        for (int d0 = 0; d0 < 8; ++d0) p0 = __builtin_amdgcn_mfma_f32_32x32x16_bf16(kf[d0], qr[d0], p0, 0, 0, 0);
        const bool need_mask = (j == jd) || (j == 1);
        const int kp0 = 32 * j + 4 * hi;
        bf16x8 pa0, pa1;
        if (TYP == 0) {
#pragma unroll
            for (int q = 0; q < 4; ++q) { const f32x4 rkv = *(const f32x4*)(ks_rk + 8 * q + 4 * hi), ncv = *(const f32x4*)(ks_nc + 8 * q + 4 * hi);
#pragma unroll
                for (int i = 0; i < 4; ++i) p0[4 * q + i] = fmaf(p0[4 * q + i], rkv[i], ncv[i]) + bias_t; }
            if (need_mask) {
#pragma unroll
                for (int r = 0; r < 16; ++r) { const int kp = kp0 + (r & 3) + 8 * (r >> 2); if (!(kp <= qp && kp >= 48)) p0[r] = -__builtin_inff(); } }
            float ps = 0.f;
#pragma unroll
            for (int r = 0; r < 16; ++r) { p0[r] = fast_exp2(p0[r]); ps += p0[r]; }
            l_reg += ps;
        } else {
            f32x16 k0;
#pragma unroll
            for (int r = 0; r < 16; ++r) { const float z = p0[r], sp = fmaxf(z, 0.f) + fast_log2(1.f + fast_exp2(-fabsf(z))); k0[r] = -sp; p0[r] = z - sp; }
            if (need_mask) {
#pragma unroll
                for (int r = 0; r < 16; ++r) { const int kp = kp0 + (r & 3) + 8 * (r >> 2); if (!(kp < qp && kp >= 48)) { p0[r] = -__builtin_inff(); k0[r] = 0.f; } } }
            float so = 0.f, spi = 0.f;
#pragma unroll
            for (int i = 3; i >= 0; --i) {
                const float g = (k0[4 * i] + k0[4 * i + 1]) + (k0[4 * i + 2] + k0[4 * i + 3]);
                const float spn = spi + __shfl_xor(g, 32);
                const float off = Rrun + so + (hi ? spi : spn);
                const float l3 = off, l2 = l3 + k0[4 * i + 3], l1 = l2 + k0[4 * i + 2], l0 = l1 + k0[4 * i + 1];
                p0[4 * i + 3] = fast_exp2(p0[4 * i + 3] + l3); p0[4 * i + 2] = fast_exp2(p0[4 * i + 2] + l2); p0[4 * i + 1] = fast_exp2(p0[4 * i + 1] + l1); p0[4 * i] = fast_exp2(p0[4 * i] + l0);
                so += g; spi = spn;
            }
            Rrun += so + spi;
        }
        PK4(p0, 0, pa0); PK4(p0, 8, pa1);
        {
#define TRRD(dst, off) asm volatile("ds_read_b64_tr_b16 %0, %1 offset:%2" : "=&v"(dst) : "v"(vb0), "i"(off) : "memory")
#define PV_D0(d0) do { s16x4 l0, l1, h0, h1; constexpr int b_ = v_rd_off(d0, 0, 0); \
            TRRD(l0, b_); TRRD(h0, b_ + 2048); TRRD(l1, b_ + 4096); TRRD(h1, b_ + 6144); \
            asm volatile("s_waitcnt lgkmcnt(0)" ::: "memory"); SBAR(); \
            o[d0] = __builtin_amdgcn_mfma_f32_32x32x16_bf16(pa0, (bf16x8){l0[0], l0[1], l0[2], l0[3], h0[0], h0[1], h0[2], h0[3]}, o[d0], 0, 0, 0); \
            o[d0] = __builtin_amdgcn_mfma_f32_32x32x16_bf16(pa1, (bf16x8){l1[0], l1[1], l1[2], l1[3], h1[0], h1[1], h1[2], h1[3]}, o[d0], 0, 0, 0); } while (0)
            PV_D0(0); PV_D0(1); PV_D0(2); PV_D0(3);
#undef PV_D0
#undef TRRD
        }
        if (j > 1) { bool conv;
            if (TYP == 0) { const float lt = l_reg + __shfl_xor(l_reg, 32); conv = (cum_t + ks_nc[0]) <= fast_log2(lt) - 41.f; }
            else conv = Rrun <= -30.f;
            if (__all(conv)) break; }
    }
    int lane_e = lane, frow_e = frow0;
    asm volatile("" : "+v"(lane_e), "+s"(frow_e));
    const int r32e = lane_e & 31, hie = lane_e >> 5;
    if (TYP == 0) {
        l_reg += __shfl_xor(l_reg, 32);
        if (hie == 0) li_l[r32e] = fast_rcp(l_reg);
        LDS_WAIT();
#pragma unroll
        for (int r = 0; r < 16; ++r) { const float il = li_l[crow(r, hie)];
#pragma unroll
            for (int d0 = 0; d0 < 4; ++d0) o[d0][r] *= il; }
    }
#pragma unroll
    for (int r = 0; r < 16; ++r) { float s = 0.f;
#pragma unroll
        for (int d0 = 0; d0 < 4; ++d0) s += o[d0][r] * o[d0][r];
        part[crow(r, hie) * 33 + r32e] = s; }
    LDS_WAIT();
    { float s = 0.f;
#pragma unroll
      for (int c = 0; c < 16; ++c) s += part[r32e * 33 + hie * 16 + c];
      s += __shfl_xor(s, 32);
      if (hie == 0) rs_l[r32e] = 1.0f / sqrtf(s * (1.f / HD) + EPS); }
    LDS_WAIT();
    const float* gain = (TYP == 0 ? T.fox_gain : T.sb_gain) + h * HD;
    float gn[4];
#pragma unroll
    for (int d0 = 0; d0 < 4; ++d0) gn[d0] = gain[d0 * 32 + r32e];
    unsigned short* stg = (unsigned short*)V_lds;
    if (TYP == 0) {
#pragma unroll
        for (int i = 0; i < 8; ++i) { const int c = lane_e + 64 * i, row = c >> 4, ch = c & 15;
            *(v4u*)(stg + row * 128 + ch * 8) = *(const v4u*)(T.GA + (size_t)(frow_e + row) * 1024 + h * HD + ch * 8); }
        LDS_WAIT();
#pragma unroll
        for (int r = 0; r < 16; ++r) { const int orow = crow(r, hie);
#pragma unroll
            for (int d0 = 0; d0 < 4; ++d0) o[d0][r] *= bf2f(stg[orow * 128 + d0 * 32 + r32e]); }
        LDS_WAIT();
    }
#pragma unroll
    for (int r = 0; r < 16; ++r) { const int orow = crow(r, hie); const float rs = rs_l[orow];
#pragma unroll
        for (int d0 = 0; d0 < 4; ++d0) { const float v = o[d0][r] * rs * gn[d0]; const float vn = __shfl_xor(v, 1);
            if ((r32e & 1) == 0) *(unsigned*)(stg + orow * 128 + d0 * 32 + r32e) = cvtpk(v, vn); } }
    LDS_WAIT();
#pragma unroll
    for (int i = 0; i < 8; ++i) { const int c = lane_e + 64 * i, row = c >> 4, ch = c & 15;
        *(v4u*)(T.MIX + (size_t)(frow_e + row) * DM + TYP * 1024 + h * HD + ch * 8) = *(const v4u*)(stg + row * 128 + ch * 8); }
    LDS_WAIT();
}
#undef PK4
#undef SBAR
#undef KSWZ
}

struct Frame {
    LAS unsigned char* lds; char* ldsg;
    volatile LAS unsigned* MISC;
    gu32* ctl;
    int tid, lane, wave, vcu, G;
    unsigned char* ws;
    const float *x, *meta, *g1, *w_in, *b_f, *q_gain, *k_gain, *fox_gain, *sb_gain, *w_out, *g2, *w_coarse, *b_coarse, *w_fine, *b_fine, *w1, *w3, *w2;
    float* out;
};

__device__ __forceinline__ void transpose_item(const float* W, size_t ldw, int k0, int n0, bf16* WT, size_t Kd, size_t drow0, LAS float* scr, int lane) {
    { const int r = lane >> 4, c4 = (lane & 15) * 4; const float* src = W + (size_t)(k0 + r) * ldw + n0 + c4; LAS float* dst = scr + r * 65 + c4;
#pragma unroll
      for (int hlf = 0; hlf < 2; ++hlf) { f32x4 v[8];
#pragma unroll
          for (int i = 0; i < 8; ++i) v[i] = *(const f32x4*)(src + (size_t)(4 * (8 * hlf + i)) * ldw);
#pragma unroll
          for (int i = 0; i < 8; ++i) { LAS float* d = dst + 4 * (8 * hlf + i) * 65; d[0] = v[i].x; d[1] = v[i].y; d[2] = v[i].z; d[3] = v[i].w; } } }
    LDS_WAIT(); asm volatile("" ::: "memory");
    const int c = lane & 7;
#pragma unroll
    for (int j = 0; j < 8; ++j) { const int n = (lane >> 3) + 8 * j; const LAS float* s = scr + (8 * c) * 65 + n;
        v4u o; o.x = cvtpk(s[0 * 65], s[1 * 65]); o.y = cvtpk(s[2 * 65], s[3 * 65]); o.z = cvtpk(s[4 * 65], s[5 * 65]); o.w = cvtpk(s[6 * 65], s[7 * 65]);
        *(GAS v4u*)(WT + (drow0 + n) * Kd + k0 + 8 * c) = o; }
    LDS_WAIT(); asm volatile("" ::: "memory");
}

__device__ __forceinline__ void p0_prologue(Frame& F) {
    const int gw = F.vcu * 8 + F.wave, NGW = F.G * 8;
    LAS float* wf = (LAS float*)F.lds;
    { f32x4 t8[8];
#pragma unroll
      for (int i = 0; i < 8; ++i) { const int c = F.tid + 512 * i, k = c >> 1, hf = c & 1; t8[i] = *(const f32x4*)(F.w_in + (size_t)k * LDW_IN + NPROJ + 4 * hf); }
#pragma unroll
      for (int i = 0; i < 8; ++i) { const int c = F.tid + 512 * i, k = c >> 1, hf = c & 1; wf[(4 * hf + 0) * DM + k] = t8[i].x; wf[(4 * hf + 1) * DM + k] = t8[i].y; wf[(4 * hf + 2) * DM + k] = t8[i].z; wf[(4 * hf + 3) * DM + k] = t8[i].w; } }
    __syncthreads();
    bf16* U1 = (bf16*)(F.ws + WS_U1); float* Fp = (float*)(F.ws + WS_F);
    for (int m = gw; m < MROWS; m += NGW) {
        GAS v2u* o8 = (GAS v2u*)(U1 + (size_t)m * DM) + F.lane;
        if (m >= NKEYROWS) {
#pragma unroll
            for (int j = 0; j < 8; ++j) o8[64 * j] = (v2u){0u, 0u};
            continue; }
        const float* xrow = m < TF ? F.x + (size_t)m * DM : F.meta + (size_t)(m - TF) * DM;
        const GAS f32x4* xr = (const GAS f32x4*)xrow + F.lane;
        f32x4 v[8]; float s = 0.f;
#pragma unroll
        for (int j = 0; j < 8; ++j) { v[j] = xr[64 * j]; s += (v[j].x * v[j].x + v[j].y * v[j].y) + (v[j].z * v[j].z + v[j].w * v[j].w); }
        const float rstd = 1.0f / sqrtf(wave_sum(s) * (1.f / DM) + EPS);
        float fa[8] = {0.f, 0.f, 0.f, 0.f, 0.f, 0.f, 0.f, 0.f};
#pragma unroll
        for (int j = 0; j < 8; ++j) { const f32x4 g = *((const GAS f32x4*)F.g1 + F.lane + 64 * j); v[j] = v[j] * rstd * g;
            o8[64 * j] = (v2u){cvtpk(v[j].x, v[j].y), cvtpk(v[j].z, v[j].w)};
#pragma unroll
            for (int jj = 0; jj < 8; ++jj) { const f32x4 w = *(const LAS f32x4*)(wf + jj * DM + 256 * j + 4 * F.lane); fa[jj] += (v[j].x * w.x + v[j].y * w.y) + (v[j].z * w.z + v[j].w * w.w); } }
#pragma unroll
        for (int jj = 0; jj < 8; ++jj) fa[jj] = wave_sum(fa[jj]);
        if (F.lane == 0) {
#pragma unroll
            for (int jj = 0; jj < 8; ++jj) Fp[(size_t)m * 8 + jj] = fa[jj]; }
    }
    { bf16* U2 = (bf16*)(F.ws + WS_U2);
      for (int m = TF + gw; m < MROWS; m += NGW) { GAS v2u* o8 = (GAS v2u*)(U2 + (size_t)m * DM) + F.lane;
#pragma unroll
          for (int j = 0; j < 8; ++j) o8[64 * j] = (v2u){0u, 0u}; } }
    { bf16* HID = (bf16*)(F.ws + WS_HID);
      for (int m = NASSIGN + gw; m < NASSIGN + 384; m += NGW) { GAS v2u* o8 = (GAS v2u*)(HID + (size_t)m * DE) + F.lane; o8[0] = (v2u){0u, 0u}; o8[64] = (v2u){0u, 0u}; } }
    { v4u* RB = (v4u*)(F.ws + WS_RB);
      for (int it = gw * 64 + F.lane; it < 64 * 5 * 64; it += NGW * 64) { const int ln = it & 63, kc = it >> 6, ks = kc / 5, cb = kc % 5, col = 16 * cb + (ln & 15), k0 = 32 * ks + 8 * (ln >> 4);
          float w[8], lo[8]; unsigned hb[4], lb[4];
#pragma unroll
          for (int i = 0; i < 8; ++i) { w[i] = col < 8 ? F.w_coarse[(size_t)(k0 + i) * 8 + col] : (col < 72 ? F.w_fine[(size_t)(k0 + i) * 64 + col - 8] : 0.f); }
#pragma unroll
          for (int i = 0; i < 4; ++i) { hb[i] = cvtpk(w[2 * i], w[2 * i + 1]); lo[2 * i] = w[2 * i] - __uint_as_float(hb[i] << 16); lo[2 * i + 1] = w[2 * i + 1] - __uint_as_float(hb[i] & 0xffff0000u); lb[i] = cvtpk(lo[2 * i], lo[2 * i + 1]); }
          RB[(size_t)(kc * 2 + 0) * 64 + ln] = (v4u){hb[0], hb[1], hb[2], hb[3]}; RB[(size_t)(kc * 2 + 1) * 64 + ln] = (v4u){lb[0], lb[1], lb[2], lb[3]}; } }
    __syncthreads();
    LAS float* scr = (LAS float*)(F.lds + F.wave * 16640);
    bf16* WinT = (bf16*)(F.ws + WS_WIN_T);
    constexpr int I_IN = (DM / 64) * (NPROJ / 64);
    for (int it = gw; it < I_IN; it += NGW) { const int kb = it / (NPROJ / 64), nb = it % (NPROJ / 64); transpose_item(F.w_in, LDW_IN, kb * 64, nb * 64, WinT, DM, nb * 64, scr, F.lane); }
}
__device__ __forceinline__ void wout_transpose(Frame& F, int idx, int nl) {
    LAS float* scr = (LAS float*)(F.lds + F.wave * 16640); bf16* WoutT = (bf16*)(F.ws + WS_WOUT_T);
    constexpr int I_OUT = (DM / 64) * (DM / 64);
    for (int it = idx * 8 + F.wave; it < I_OUT; it += nl * 8) { const int kb = it / (DM / 64), nb = it % (DM / 64); transpose_item(F.w_out, DM, kb * 64, nb * 64, WoutT, DM, nb * 64, scr, F.lane); }
}

__device__ __forceinline__ void cum_scan(Frame& F, int bh) {
    const float* Fp = (const float*)(F.ws + WS_F); float* CUM = (float*)(F.ws + WS_CUM);
    const int b = bh >> 3, h = bh & 7; const float bf = F.b_f[h]; float carry = 0.f;
    for (int c0 = 0; c0 < LPOS; c0 += 64) { const int pos = c0 + F.lane; float v = 0.f;
        if (pos < LPOS) { const int row = pos < NMETA ? ROW_META + pos : b * SEQ + pos - NMETA; const float xv = Fp[(size_t)row * 8 + h] + bf;
            v = (fminf(xv, 0.f) - log1pf(expf(-fabsf(xv)))) * LOG2E; }
#pragma unroll
        for (int o = 1; o < 64; o <<= 1) { const float t = __shfl_up(v, o); if (F.lane >= o) v += t; }
        v += carry;
        if (pos < LPOS) CUM[(size_t)bh * CUMLD + pos] = v;
        carry = __shfl(v, 63); }
}

__device__ __forceinline__ void p5_router(Frame& F) {
    const int ntask = TF / 16;
    const float* H1 = F.out; bf16* U2 = (bf16*)(F.ws + WS_U2); const v4u* RB = (const v4u*)(F.ws + WS_RB);
    int* RE = (int*)(F.ws + WS_ROUTE); int* RP = RE + TF * 2; float* RW = (float*)(RP + TF * 2); int* TOK = (int*)(F.ws + WS_TOK);
    const int tid = opaque_tid(), lane = tid & 63, wave = __builtin_amdgcn_readfirstlane(tid >> 6), tk = wave >> 2, kp = wave & 3;
    LAS float* pacc = (LAS float*)F.lds;
    LAS float* ssp = (LAS float*)(F.lds + 40960);
    LAS float* lg = (LAS float*)(F.lds + 41472) + tk * 16 * 88;
    const int i = lane & 15, kq = lane >> 4;
    for (int base = 0; base < ntask; base += 2 * F.G) {
        const int task = base + 2 * (int)blockIdx.x + tk; const bool live = task < ntask;
        const int row0 = (live ? task : 0) * 16; const float* hrow = H1 + (size_t)(row0 + i) * DM + 8 * kq + 512 * kp;
        float ss = 0.f;
#pragma unroll 8
        for (int ks = 0; ks < 16; ++ks) { const f32x4 a = *(const f32x4*)(hrow + 32 * ks), b = *(const f32x4*)(hrow + 32 * ks + 4);
            ss += (a.x * a.x + a.y * a.y) + (a.z * a.z + a.w * a.w) + (b.x * b.x + b.y * b.y) + (b.z * b.z + b.w * b.w); }
        ss += __shfl_xor(ss, 16); ss += __shfl_xor(ss, 32);
        if (lane < 16) ssp[wave * 16 + i] = ss;
        __syncthreads();
        const float rstd = 1.0f / sqrtf(((ssp[(4 * tk) * 16 + i] + ssp[(4 * tk + 1) * 16 + i]) + (ssp[(4 * tk + 2) * 16 + i] + ssp[(4 * tk + 3) * 16 + i])) * (1.f / DM) + EPS);
        f32x4 acc[5];
#pragma unroll
        for (int cb = 0; cb < 5; ++cb) acc[cb] = (f32x4){0.f, 0.f, 0.f, 0.f};
#pragma unroll 2
        for (int ks = 0; ks < 16; ++ks) { const int kg = 16 * kp + ks;
            const f32x4 a = *(const f32x4*)(hrow + 32 * ks), b = *(const f32x4*)(hrow + 32 * ks + 4);
            const f32x4 ga = *(const f32x4*)(F.g2 + 32 * kg + 8 * kq), gb = *(const f32x4*)(F.g2 + 32 * kg + 8 * kq + 4);
            float u[8] = {a.x * rstd * ga.x, a.y * rstd * ga.y, a.z * rstd * ga.z, a.w * rstd * ga.w, b.x * rstd * gb.x, b.y * rstd * gb.y, b.z * rstd * gb.z, b.w * rstd * gb.w};
            unsigned hb[4], lb[4];
#pragma unroll
            for (int q = 0; q < 4; ++q) { hb[q] = cvtpk(u[2 * q], u[2 * q + 1]); lb[q] = cvtpk(u[2 * q] - __uint_as_float(hb[q] << 16), u[2 * q + 1] - __uint_as_float(hb[q] & 0xffff0000u)); }
            v4u hv = {hb[0], hb[1], hb[2], hb[3]}, lv = {lb[0], lb[1], lb[2], lb[3]};
            if (live) *(v4u*)(U2 + (size_t)(row0 + i) * DM + 32 * kg + 8 * kq) = hv;
            const bf16x8 Ah = *reinterpret_cast<bf16x8*>(&hv), Al = *reinterpret_cast<bf16x8*>(&lv);
#pragma unroll
            for (int cb = 0; cb < 5; ++cb) { v4u bh = RB[(size_t)((kg * 5 + cb) * 2 + 0) * 64 + lane], bl = RB[(size_t)((kg * 5 + cb) * 2 + 1) * 64 + lane];
                const bf16x8 Bh = *reinterpret_cast<bf16x8*>(&bh), Bl = *reinterpret_cast<bf16x8*>(&bl);
                acc[cb] = __builtin_amdgcn_mfma_f32_16x16x32_bf16(Ah, Bh, acc[cb], 0, 0, 0);
                acc[cb] = __builtin_amdgcn_mfma_f32_16x16x32_bf16(Ah, Bl, acc[cb], 0, 0, 0);
                acc[cb] = __builtin_amdgcn_mfma_f32_16x16x32_bf16(Al, Bh, acc[cb], 0, 0, 0); }
        }
#pragma unroll
        for (int cb = 0; cb < 5; ++cb)
#pragma unroll
            for (int j = 0; j < 4; ++j) pacc[(wave * 16 + 4 * kq + j) * 80 + 16 * cb + i] = acc[cb][j];
        __syncthreads();
        if (kp == 0) {
#pragma unroll
            for (int m = 0; m < 20; ++m) { const int idx = lane + 64 * m, r = idx / 80, c = idx - r * 80;
                lg[r * 88 + c] = (pacc[((4 * tk) * 16 + r) * 80 + c] + pacc[((4 * tk + 1) * 16 + r) * 80 + c]) + (pacc[((4 * tk + 2) * 16 + r) * 80 + c] + pacc[((4 * tk + 3) * 16 + r) * 80 + c]); }
            LDS_WAIT(); asm volatile("" ::: "memory");
            if (lane < 16 && live) { const LAS float* L = lg + lane * 88; const int row = row0 + lane;
                float cmax = L[0] + F.b_coarse[0]; int gs = 0; float cv[8]; cv[0] = cmax;
#pragma unroll
                for (int g = 1; g < 8; ++g) { cv[g] = L[g] + F.b_coarse[g]; if (cv[g] > cmax) { cmax = cv[g]; gs = g; } }
                float den = 0.f;
#pragma unroll
                for (int g = 0; g < 8; ++g) den += expf(cv[g] - cmax);
                const float ggate = 1.0f / den;
                float f1 = -__builtin_inff(), f2 = -__builtin_inff(); int i1 = 0, i2 = 0;
#pragma unroll
                for (int jx = 0; jx < 8; ++jx) { const float fv = L[8 + gs * 8 + jx] + F.b_fine[gs * 8 + jx];
                    if (fv > f1) { f2 = f1; i2 = i1; f1 = fv; i1 = jx; } else if (fv > f2) { f2 = fv; i2 = jx; } }
                const float e2 = expf(f2 - f1), w1 = ggate / (1.f + e2), w2 = ggate * e2 / (1.f + e2);
                const int ea = gs * 8 + i1, eb = gs * 8 + i2;
                const int pa = (int)__hip_atomic_fetch_add(F.ctl + CW_CNT + 64 * ea, 1u, RLX_AGENT), pb = (int)__hip_atomic_fetch_add(F.ctl + CW_CNT + 64 * eb, 1u, RLX_AGENT);
                TOK[(size_t)ea * TOKLD + pa] = row * 2; TOK[(size_t)eb * TOKLD + pb] = row * 2 + 1;
                RE[row * 2] = ea; RE[row * 2 + 1] = eb; RP[row * 2] = pa; RP[row * 2 + 1] = pb; RW[row * 2] = w1; RW[row * 2 + 1] = w2; }
        }
        __syncthreads();
    }
}

__device__ __forceinline__ void moe_prefix(Frame& F, int ncs) {
    LAS int* upre = (LAS int*)(F.lds + TPRE_OFF); LAS int* cpre = upre + 80;
    if (F.tid < 64) { const int c = (int)__hip_atomic_load(F.ctl + CW_CNT + 64 * F.tid, RLX_AGENT); int u = ((c + 383) / 384) * ncs, v = c;
#pragma unroll
        for (int o = 1; o < 64; o <<= 1) { const int y = __shfl_up(u, o), z = __shfl_up(v, o); if (F.lane >= o) { u += y; v += z; } }
        upre[F.tid + 1] = u; cpre[F.tid + 1] = v; if (F.tid == 0) { upre[0] = 0; cpre[0] = 0; } }
    __syncthreads();
}

__device__ __forceinline__ void p8_combine(Frame& F) {
    const LAS int* cpre = (const LAS int*)(F.lds + TPRE_OFF) + 80;
    const int* RE = (const int*)(F.ws + WS_ROUTE); const int* RP = RE + TF * 2; const bf16* Y = (const bf16*)(F.ws + WS_Y);
    for (int m = F.vcu * 8 + F.wave; m < TF; m += F.G * 8) {
        const int e0 = RE[m * 2], e1 = RE[m * 2 + 1], p0 = RP[m * 2], p1 = RP[m * 2 + 1];
        const size_t s0 = (size_t)(cpre[e0] + p0), s1 = (size_t)(cpre[e1] + p1);
        GAS f32x4* op = (GAS f32x4*)(F.out + (size_t)m * DM) + 2 * F.lane;
        const GAS v4u* y0 = (const GAS v4u*)(Y + s0 * DM) + F.lane; const GAS v4u* y1 = (const GAS v4u*)(Y + s1 * DM) + F.lane;
#pragma unroll
        for (int j = 0; j < 4; ++j) { f32x4 a = op[128 * j], b = op[128 * j + 1]; const v4u u0 = y0[64 * j], u1 = y1[64 * j];
            a.x += __uint_as_float(u0.x << 16) + __uint_as_float(u1.x << 16); a.y += __uint_as_float(u0.x & 0xffff0000u) + __uint_as_float(u1.x & 0xffff0000u);
            a.z += __uint_as_float(u0.y << 16) + __uint_as_float(u1.y << 16); a.w += __uint_as_float(u0.y & 0xffff0000u) + __uint_as_float(u1.y & 0xffff0000u);
            b.x += __uint_as_float(u0.z << 16) + __uint_as_float(u1.z << 16); b.y += __uint_as_float(u0.z & 0xffff0000u) + __uint_as_float(u1.z & 0xffff0000u);
            b.z += __uint_as_float(u0.w << 16) + __uint_as_float(u1.w << 16); b.w += __uint_as_float(u0.w & 0xffff0000u) + __uint_as_float(u1.w & 0xffff0000u);
            op[128 * j] = a; op[128 * j + 1] = b; }
    }
}

#define XB_TMO      128
#define XB_XCNT(j)  (256  + 64 * (j))
#define XB_XSUB(j)  (1280 + 64 * (j))
#define XB_XGEN(j)  (2304 + 64 * (j))
#define XB_TOP      3328
#define XB_TOPGEN   3392
#define XCD_BAR_WORDS 3456
#define XB_SPIN_CAP (1u << 18)

__device__ __forceinline__ unsigned xb_ld(unsigned* p)              { return __hip_atomic_load(p, __ATOMIC_RELAXED, __HIP_MEMORY_SCOPE_AGENT); }
__device__ __forceinline__ unsigned xb_add(unsigned* p, unsigned v) { return __hip_atomic_fetch_add(p, v, __ATOMIC_RELAXED, __HIP_MEMORY_SCOPE_AGENT); }
__device__ __forceinline__ unsigned xb_xcc_id() { return (unsigned)__builtin_amdgcn_s_getreg((3 << 11) | 20) & 0xFu; }
#define XB_SPIN(cond, bar) do { unsigned _sp = 0; while (cond) { __builtin_amdgcn_s_sleep(1); \
    if ((++_sp & 255u) == 0u) { if (xb_ld(&(bar)[XB_TMO])) break; if (_sp > XB_SPIN_CAP) { atomicAdd(&(bar)[XB_TMO], 1u); break; } } } } while (0)

struct XcdBarrier {
    unsigned* bar; unsigned x;
    volatile LAS unsigned* st;
};

__device__ __forceinline__ XcdBarrier xcd_barrier_post(unsigned* bar, volatile LAS unsigned* st) {
    XcdBarrier b; b.bar = bar; b.x = xb_xcc_id(); b.st = st;
    if (threadIdx.x == 0) (void)xb_add(&bar[XB_XCNT(b.x)], 1u);
    return b;
}
__device__ __forceinline__ void xcd_barrier_complete(unsigned* bar, unsigned x, unsigned& nloc, unsigned& nx) {
    const unsigned G = gridDim.x * gridDim.y * gridDim.z;
    unsigned sum, cnt, mine, sp = 0u;
    for (;;) {
        sum = 0u; cnt = 0u; mine = 0u;
#pragma unroll
        for (unsigned j = 0; j < 16; ++j) { const unsigned c = xb_ld(&bar[XB_XCNT(j)]); sum += c; cnt += (c > 0u) ? 1u : 0u; mine = (j == x) ? c : mine; }
        if (sum == G) break;
        __builtin_amdgcn_s_sleep(1);
        if ((++sp & 255u) == 0u) { if (xb_ld(&bar[XB_TMO])) break; if (sp > XB_SPIN_CAP) { atomicAdd(&bar[XB_TMO], 1u); break; } }
    }
    nloc = mine > 0u ? mine : 1u; nx = cnt > 0u ? cnt : 1u;
}

__device__ __forceinline__ void xcd_barrier(const XcdBarrier& b) {
    asm volatile("s_waitcnt vmcnt(0)" ::: "memory");
    __syncthreads();
    if (threadIdx.x == 0) {
        unsigned* bar = b.bar;
        __builtin_amdgcn_s_waitcnt(0);
        unsigned nloc = b.st[0], nx = b.st[1];
        if (nloc == 0u) { xcd_barrier_complete(bar, b.x, nloc, nx); b.st[0] = nloc; b.st[1] = nx; }
        const unsigned old = xb_add(&bar[XB_XSUB(b.x)], 1u);
        const unsigned gen = old / nloc;
        if (old + 1u == (gen + 1u) * nloc) {
            __builtin_amdgcn_fence(__ATOMIC_RELEASE, "agent");
            asm volatile("s_waitcnt vmcnt(0)" ::: "memory");
            const unsigned og = xb_add(&bar[XB_TOP], 1u);
            const unsigned tg = og / nx;
            if (og + 1u == (tg + 1u) * nx) xb_add(&bar[XB_TOPGEN], 1u);
            else XB_SPIN(xb_ld(&bar[XB_TOPGEN]) == tg, bar);
            __builtin_amdgcn_fence(__ATOMIC_ACQUIRE, "agent");
            xb_add(&bar[XB_XGEN(b.x)], 1u);
            asm volatile("s_waitcnt vmcnt(0)" ::: "memory");
        } else {
            XB_SPIN(xb_ld(&bar[XB_XGEN(b.x)]) == gen, bar);
            __builtin_amdgcn_fence(__ATOMIC_ACQUIRE, "agent");
            asm volatile("s_waitcnt vmcnt(0)" ::: "memory");
        }
    }
    __syncthreads();
}

struct Args { const float* in[18]; float* out; unsigned char* ws; int ph_lo, ph_hi; };
__global__ void __launch_bounds__(512, 2) fwd(Args args) {
    extern __shared__ __attribute__((aligned(16))) unsigned char lds[];
    Frame F;
    F.lds = (LAS unsigned char*)lds; F.ldsg = (char*)lds;
    F.MISC = (volatile LAS unsigned*)(F.lds + MISC_OFF);
    F.tid = threadIdx.x; F.lane = F.tid & 63; F.wave = __builtin_amdgcn_readfirstlane(F.tid >> 6);
    F.G = gridDim.x; { const int bx = blockIdx.x; F.vcu = (F.G % 8 == 0) ? (bx % 8) * (F.G / 8) + bx / 8 : bx; }
    F.ws = args.ws; F.ctl = (gu32*)(args.ws + WS_CTL); F.out = args.out;
    F.x = args.in[0]; F.meta = args.in[1]; F.g1 = args.in[2]; F.w_in = args.in[3]; F.b_f = args.in[4]; F.q_gain = args.in[5]; F.k_gain = args.in[6];
    F.fox_gain = args.in[7]; F.sb_gain = args.in[8]; F.w_out = args.in[9]; F.g2 = args.in[10]; F.w_coarse = args.in[11]; F.b_coarse = args.in[12];
    F.w_fine = args.in[13]; F.b_fine = args.in[14]; F.w1 = args.in[15]; F.w3 = args.in[16]; F.w2 = args.in[17];
    for (int u = F.tid; u < 32; u += 512) F.MISC[u] = 0u;
    __syncthreads();
    const int lo = args.ph_lo, hi = args.ph_hi;
    XcdBarrier bar; bar.bar = (unsigned*)(F.ctl + CW_BAR); bar.x = 0; bar.st = nullptr;
    if (hi - lo > 1) bar = xcd_barrier_post((unsigned*)(F.ctl + CW_BAR), F.MISC + 8);
#define IN(k) (lo <= (k) && (k) < hi)
#define SEAM(k) do { if (IN(k) && IN((k) + 1)) xcd_barrier(bar); } while (0)
    bf16* PROJ = (bf16*)(F.ws + WS_PROJ);


    if (IN(0)) { p0_prologue(F); if (REP_PHASE == 0) { __syncthreads(); p0_prologue(F); } SEAM(0); }

    if (IN(1)) {
        { const int bh = (int)blockIdx.x - (F.G - NB * NH); if (bh >= 0 && F.wave == 0) cum_scan(F, bh); }
        pg8::DenseOrder S; S.init(F.ws + WS_U1, F.ws + WS_WIN_T, MROWS, NPROJ, DM, F.G, (int)blockIdx.x);
        pg8::EpiProj E{PROJ, (float*)(F.ws + WS_SS)};
        pg8::gemm_phase<pg8::EpiProj, pg8::DenseOrder, false>(F.lds, DM, S, E, nullptr);
        { const int rem = S.nwg % F.G, nl = F.G - rem, idx = (int)blockIdx.x - rem; if (rem == 0) wout_transpose(F, (int)blockIdx.x, F.G); else if (idx >= 0) wout_transpose(F, idx, nl); }
        if (REP_PHASE == 1) pg8::gemm_phase<pg8::EpiProj, pg8::DenseOrder, false>(F.lds, DM, S, E, nullptr);
        if (IN(1) && IN(3)) xcd_barrier(bar);
    }

    if (IN(3)) {
        att::Tensors T{PROJ, PROJ + PROJ_TS, PROJ + 2 * PROJ_TS, PROJ + 3 * PROJ_TS, PROJ + 4 * PROJ_TS, PROJ + 5 * PROJ_TS, PROJ + 6 * PROJ_TS,
                       (const float*)(F.ws + WS_SS), (const float*)(F.ws + WS_CUM), F.q_gain, F.k_gain, F.fox_gain, F.sb_gain, (bf16*)(F.ws + WS_MIX)};
        for (int rep = 0; rep < ((REP_PHASE == 3 || REP_PHASE == 31 || REP_PHASE == 32) ? 2 : 1); ++rep)
        for (int w = F.vcu; w < 256; w += F.G) { const int bh = w >> 3, s = w & 7;
            if (REP_PHASE != 32 || rep == 0) att::attn_wave<0>(F.ldsg + F.wave * 16384, T, bh >> 3, bh & 7, s * 256 + F.wave * 32);
            if (REP_PHASE != 31 || rep == 0) att::attn_wave<1>(F.ldsg + F.wave * 16384, T, bh >> 3, bh & 7, (7 - s) * 256 + F.wave * 32);
        }
        __syncthreads();
        SEAM(3);
    }
    if (IN(4)) {
        pg8::DenseOrder S; S.init(F.ws + WS_MIX, F.ws + WS_WOUT_T, TF, DM, DM, F.G, (int)blockIdx.x);
        pg8::EpiOut E{F.x, F.out};
        pg8::gemm_phase<pg8::EpiOut, pg8::DenseOrder, false>(F.lds, DM, S, E, nullptr);
        if (REP_PHASE == 4) pg8::gemm_phase<pg8::EpiOut, pg8::DenseOrder, false>(F.lds, DM, S, E, nullptr);
        SEAM(4);
    }
    if (IN(5)) { p5_router(F); SEAM(5); }

    if (IN(6)) {
        moe_prefix(F, 8);
        const LAS int* upre = (const LAS int*)(F.lds + TPRE_OFF);
        moe::Order S{F.G, F.vcu, 8, upre, upre + 80};
        LAS int* tab = (LAS int*)(F.lds + TAB_OFF); const int* TOK = (const int*)(F.ws + WS_TOK);
        for (int i = 0; i < 8; ++i) { int e, cs, mt, cnt, cbase; if (!S.decode(i, e, cs, mt, cnt, cbase)) break;
            if (F.tid < 384) { const int p = mt * 384 + F.tid; tab[i * 384 + F.tid] = p < cnt ? (TOK[(size_t)e * TOKLD + p] >> 1) : TF; } }
        __syncthreads();
        for (int rep = 0; rep < (REP_PHASE == 6 ? 2 : 1); ++rep)
        moe::phase<DM, true>(F.lds, S, tab, (const char*)(F.ws + WS_U2), F.w1, F.w3, (bf16*)(F.ws + WS_HID));
        SEAM(6);
    }
    if (IN(7)) {
        moe_prefix(F, 16);
        const LAS int* upre = (const LAS int*)(F.lds + TPRE_OFF);
        moe::Order S{F.G, F.vcu, 16, upre, upre + 80};
        LAS float* wtab = (LAS float*)(F.lds + TAB_OFF); const int* TOK = (const int*)(F.ws + WS_TOK); const float* RW = (const float*)(F.ws + WS_ROUTE) + TF * 4;
        for (int i = 0; i < 8; ++i) { int e, cs, mt, cnt, cbase; if (!S.decode(i, e, cs, mt, cnt, cbase)) break;
            if (F.tid < 384) { const int p = mt * 384 + F.tid; wtab[i * 384 + F.tid] = p < cnt ? RW[TOK[(size_t)e * TOKLD + p]] : 0.f; } }
        __syncthreads();
        for (int rep = 0; rep < (REP_PHASE == 7 ? 2 : 1); ++rep)
        moe::phase<DE, false>(F.lds, S, (const LAS int*)wtab, (const char*)(F.ws + WS_HID), F.w2, nullptr, (bf16*)(F.ws + WS_Y));
        SEAM(7);
    }
    if (IN(8)) { moe_prefix(F, 16); p8_combine(F); }
#undef IN
#undef SEAM
}

extern "C" void kernel_launch(void* const* d_in, const int* in_sizes, int n_in, void* d_out, int out_size, void* d_ws, size_t ws_size, hipStream_t stream) {
    static int grid = 0;
    if (grid == 0) {
        if (n_in != 18 || out_size != TF * DM || ws_size < WS_END) { fprintf(stderr, "kernel_launch: unexpected shapes (n_in %d, out %d, ws %zu); nothing launched\n", n_in, out_size, ws_size); grid = -1; return; }
        int dev = 0, cus = 0, per_cu = 0;
        if (hipGetDevice(&dev) != hipSuccess || hipDeviceGetAttribute(&cus, hipDeviceAttributeMultiprocessorCount, dev) != hipSuccess) { grid = -1; return; }
        if (hipFuncSetAttribute((const void*)fwd, hipFuncAttributeMaxDynamicSharedMemorySize, LDS_BYTES) != hipSuccess) { fprintf(stderr, "kernel_launch: hipFuncSetAttribute failed\n"); grid = -1; return; }
        if (hipOccupancyMaxActiveBlocksPerMultiprocessor(&per_cu, (const void*)fwd, 512, LDS_BYTES) != hipSuccess || per_cu < 1) fprintf(stderr, "kernel_launch: occupancy query reports %d\n", per_cu);
        (void)hipGetLastError();
        grid = cus > 0 ? cus : 256;
    }
    if (grid < 0) return;
    (void)hipMemsetAsync((char*)d_ws + WS_CTL, 0, CTL_ZERO_BYTES, stream);
    Args a{};
    for (int i = 0; i < 18; ++i) a.in[i] = (const float*)d_in[i];
    a.out = (float*)d_out; a.ws = (unsigned char*)d_ws;
    constexpr int NL = MK_N_LAUNCHES;
    for (int li = 0; li < NL; ++li) {
        a.ph_lo = (NL == 1) ? 0 : li; a.ph_hi = (NL == 1) ? NPHASE : li + 1;
        hipLaunchKernelGGL(fwd, dim3(grid), dim3(512), LDS_BYTES, stream, a);
    }
}
```
